# Optimizing an MI355X kernel written in HIP

```python
import jax, jax.numpy as jnp
from jax import lax
import numpy as np

D_MODEL = 1024
BATCH = 8
SEQ = 4096
DEPTH = 2

CTX_LEN = 256
GRID_W = 64

HEAD_DIM = 128
N_Q_HEADS = 4
N_KV_HEADS = 2
REP = N_Q_HEADS // N_KV_HEADS
ATTN_W = N_Q_HEADS * HEAD_DIM
KV_W = N_KV_HEADS * HEAD_DIM
AXIS_DIM = HEAD_DIM // 2
ROPE_THETA = 10000.0
Q_BLOCK = 128
SCONV_W = 256
SCONV_K = 3
FOURIER_W = 256
FOURIER_GROUPS = 4
FOURIER_GROUP_W = FOURIER_W // FOURIER_GROUPS
CONF_W = 256
CONF_K = 31
MIX_W = ATTN_W + SCONV_W + FOURIER_W + CONF_W
Q_END = ATTN_W
K_END = Q_END + KV_W
V_END = K_END + KV_W
IN_W = V_END + 3 * SCONV_W + FOURIER_W + 2 * CONF_W
N_EXPERTS = 32
TOP_K = 4
D_FF = D_MODEL
SWIGLU_LIMIT = 7.0
SWIGLU_ALPHA = 1.702
N_MOD = 6
EPS = 1e-6

kernel_name = 'hybrid_parallel_groups_flow_backbone'


def rms_norm(x, g):
    xf = x.astype(jnp.float32)
    y = xf * lax.rsqrt(jnp.mean(xf * xf, axis=-1, keepdims=True) + EPS)
    return (y * g.astype(jnp.float32)).astype(x.dtype)


def layer_norm(x, g, b):
    xf = x.astype(jnp.float32)
    mu = jnp.mean(xf, axis=-1, keepdims=True)
    var = jnp.mean(jnp.square(xf - mu), axis=-1, keepdims=True)
    y = (xf - mu) * lax.rsqrt(var + EPS)
    return (y * g.astype(jnp.float32) + b.astype(jnp.float32)).astype(x.dtype)


def modulate(h, shift, scale):
    return h * (1 + scale) + shift


def axial_rope_tables(rows, dtype):
    row = jnp.broadcast_to(jnp.arange(rows, dtype=jnp.float32)[:, None], (rows, GRID_W)).reshape(-1)
    col = jnp.broadcast_to(jnp.arange(GRID_W, dtype=jnp.float32)[None, :], (rows, GRID_W)).reshape(-1)
    inv_freq = ROPE_THETA ** (-jnp.arange(AXIS_DIM // 2, dtype=jnp.float32) * 2.0 / AXIS_DIM)
    ar = row[:, None] * inv_freq
    ac = col[:, None] * inv_freq
    ang = jnp.concatenate([ar, ar, ac, ac], axis=-1)
    return jnp.cos(ang).astype(dtype), jnp.sin(ang).astype(dtype)


def rotate_half_axial(x):
    xr = x.reshape(x.shape[:-1] + (2, 2, AXIS_DIM // 2))
    x1 = xr[..., 0, :]
    x2 = xr[..., 1, :]
    return jnp.stack([-x2, x1], axis=-2).reshape(x.shape)


def apply_rope(x, cos, sin):
    return x * cos[None, :, None, :] + rotate_half_axial(x) * sin[None, :, None, :]


def split_heads(t, n_heads):
    return t.reshape(t.shape[:-1] + (n_heads, HEAD_DIM))


def attend(qg, k, v):
    s = jnp.einsum('bqgrd,bkgd->bgrqk', qg, k, preferred_element_type=jnp.float32) * (HEAD_DIM ** -0.5)
    p = jax.nn.softmax(s, axis=-1)
    return jnp.einsum('bgrqk,bkgd->bqgrd', p.astype(v.dtype), v)


def block_attention(q, k, v):
    b_, s_ = q.shape[0], q.shape[1]
    n_blk = s_ // Q_BLOCK
    qb = jnp.moveaxis(q.reshape(b_, n_blk, Q_BLOCK, N_KV_HEADS, REP, HEAD_DIM), 1, 0)
    o = lax.map(lambda qblk: attend(qblk, k, v), qb)
    return jnp.moveaxis(o, 0, 1).reshape(b_, s_, ATTN_W)


def depthwise_conv(x, w):
    k_w, ch = w.shape
    return lax.conv_general_dilated(
        x, w[:, None, :], window_strides=(1,), padding=[(k_w // 2, k_w // 2)],
        dimension_numbers=('NWC', 'WIO', 'NWC'), feature_group_count=ch)


def fourier_mix(f):
    b_, s_, _ = f.shape
    fg = f.reshape(b_, s_, FOURIER_GROUPS, FOURIER_GROUP_W).astype(jnp.float32)
    y = jnp.fft.fft2(fg, axes=(1, 3), norm='ortho').real
    return y.reshape(b_, s_, FOURIER_W).astype(f.dtype)


def local_mixers(u_loc, sconv_w, conf_dw_w, conf_dw_b, conf_ln_g, conf_ln_b):
    sb, sc, sx, fo, cf = jnp.split(
        u_loc, [SCONV_W, 2 * SCONV_W, 3 * SCONV_W, 3 * SCONV_W + FOURIER_W], axis=-1)
    y_sconv = sb * depthwise_conv(sc * sx, sconv_w)
    y_four = fourier_mix(fo)
    a, g = jnp.split(cf, 2, axis=-1)
    d = depthwise_conv(a * jax.nn.sigmoid(g), conf_dw_w) + conf_dw_b
    y_conf = jax.nn.silu(layer_norm(d, conf_ln_g, conf_ln_b))
    return jnp.concatenate([y_sconv, y_four, y_conf], axis=-1)


def moe(h, router_w, router_b, w_up, b_up, w_down, b_down):
    shape = h.shape
    ht = h.reshape(-1, D_MODEL)
    logits = (ht @ router_w).astype(jnp.float32) + router_b.astype(jnp.float32)
    top_vals, top_idx = lax.top_k(logits, TOP_K)
    probs = jax.nn.softmax(top_vals, axis=-1)
    combine = jnp.sum(jax.nn.one_hot(top_idx, N_EXPERTS, dtype=jnp.float32) * probs[..., None], axis=1)
    out = jnp.zeros((ht.shape[0], D_MODEL), jnp.float32)
    for e in range(N_EXPERTS):
        gu = ht @ w_up[e] + b_up[e]
        gate = jnp.minimum(gu[:, ::2], SWIGLU_LIMIT)
        lin = jnp.clip(gu[:, 1::2], -SWIGLU_LIMIT, SWIGLU_LIMIT)
        act = gate * jax.nn.sigmoid(SWIGLU_ALPHA * gate) * (lin + 1)
        y = act @ w_down[e] + b_down[e]
        out = out + combine[:, e:e + 1] * y.astype(jnp.float32)
    return out.astype(h.dtype).reshape(shape)


def hybrid_layer(x, xc, c_act, cc_act, cos, sin, w_mod, b_mod, norm_mix, norm_ffn, w_in,
                 q_norm, k_norm, sconv_w, conf_dw_w, conf_dw_b, conf_ln_g, conf_ln_b, w_out,
                 router_w, router_b, w_up, b_up, w_down, b_down, update_ctx):
    b_, s_ = x.shape[0], x.shape[1]
    s_c = xc.shape[1]
    sh1, sc1, g1, sh2, sc2, g2 = jnp.split((c_act @ w_mod + b_mod)[:, None, :], N_MOD, axis=-1)
    csh1, csc1, cg1, csh2, csc2, cg2 = jnp.split((cc_act @ w_mod + b_mod)[None, None, :], N_MOD, axis=-1)

    h = modulate(rms_norm(x, norm_mix), sh1, sc1)
    hc = modulate(rms_norm(xc, norm_mix), csh1, csc1)
    u = h @ w_in
    if update_ctx:
        uc = hc @ w_in
        uc_kv = uc[..., Q_END:V_END]
    else:
        uc_kv = hc @ w_in[:, Q_END:V_END]
    kc = rms_norm(split_heads(uc_kv[..., :KV_W], N_KV_HEADS), k_norm)
    vc = split_heads(uc_kv[..., KV_W:], N_KV_HEADS)
    q = apply_rope(rms_norm(split_heads(u[..., :Q_END], N_Q_HEADS), q_norm), cos, sin)
    k = apply_rope(rms_norm(split_heads(u[..., Q_END:K_END], N_KV_HEADS), k_norm), cos, sin)
    v = split_heads(u[..., K_END:V_END], N_KV_HEADS)
    k_all = jnp.concatenate([kc, k], axis=1)
    v_all = jnp.concatenate([vc, v], axis=1)
    y_attn = block_attention(q, k_all, v_all)
    y = jnp.concatenate(
        [y_attn, local_mixers(u[..., V_END:], sconv_w, conf_dw_w, conf_dw_b, conf_ln_g, conf_ln_b)],
        axis=-1) @ w_out
    x = x + g1 * y
    h2 = modulate(rms_norm(x, norm_ffn), sh2, sc2)

    if update_ctx:
        qc = rms_norm(split_heads(uc[..., :Q_END], N_Q_HEADS), q_norm)
        yc_attn = attend(qc.reshape(b_, s_c, N_KV_HEADS, REP, HEAD_DIM), kc, vc).reshape(b_, s_c, ATTN_W)
        yc = jnp.concatenate(
            [yc_attn, local_mixers(uc[..., V_END:], sconv_w, conf_dw_w, conf_dw_b, conf_ln_g, conf_ln_b)],
            axis=-1) @ w_out
        xc = xc + cg1 * yc
        h2c = modulate(rms_norm(xc, norm_ffn), csh2, csc2)
        ff = moe(jnp.concatenate([h2, h2c], axis=1), router_w, router_b, w_up, b_up, w_down, b_down)
        x = x + g2 * ff[:, :s_]
        xc = xc + cg2 * ff[:, s_:]
    else:
        x = x + g2 * moe(h2, router_w, router_b, w_up, b_up, w_down, b_down)
    return x, xc


def setup_inputs(seed: int = 0) -> dict:
    key = jax.random.key(seed)
    ks = jax.random.split(key, 24)
    L = DEPTH

    def nrm(k, shape, s):
        return s * jax.random.normal(k, shape, jnp.float32)

    return {
        'x': nrm(ks[0], (BATCH, SEQ, D_MODEL), 1.0),
        'c': nrm(ks[1], (BATCH, D_MODEL), 1.0),
        'ctx': nrm(ks[2], (BATCH, CTX_LEN, D_MODEL), 1.0),
        'c_ctx': nrm(ks[3], (D_MODEL,), 1.0),
        'w_mod': nrm(ks[4], (L, D_MODEL, N_MOD * D_MODEL), 0.5 * D_MODEL ** -0.5),
        'b_mod': nrm(ks[5], (L, N_MOD * D_MODEL), 0.01),
        'norm_mix': 1.0 + nrm(ks[6], (L, D_MODEL), 0.05),
        'norm_ffn': 1.0 + nrm(ks[7], (L, D_MODEL), 0.05),
        'w_in': nrm(ks[8], (L, D_MODEL, IN_W), D_MODEL ** -0.5),
        'q_norm': 1.0 + nrm(ks[9], (L, HEAD_DIM), 0.05),
        'k_norm': 1.0 + nrm(ks[10], (L, HEAD_DIM), 0.05),
        'sconv_w': nrm(ks[11], (L, SCONV_K, SCONV_W), SCONV_K ** -0.5),
        'conf_dw_w': nrm(ks[12], (L, CONF_K, CONF_W), CONF_K ** -0.5),
        'conf_dw_b': nrm(ks[13], (L, CONF_W), 0.01),
        'conf_ln_g': 1.0 + nrm(ks[14], (L, CONF_W), 0.05),
        'conf_ln_b': nrm(ks[15], (L, CONF_W), 0.01),
        'w_out': nrm(ks[16], (L, MIX_W, D_MODEL), MIX_W ** -0.5),
        'router_w': nrm(ks[17], (L, D_MODEL, N_EXPERTS), D_MODEL ** -0.5),
        'router_b': nrm(ks[18], (L, N_EXPERTS), 0.01),
        'w_up': nrm(ks[19], (L, N_EXPERTS, D_MODEL, 2 * D_FF), D_MODEL ** -0.5),
        'b_up': nrm(ks[20], (L, N_EXPERTS, 2 * D_FF), 0.01),
        'w_down': nrm(ks[21], (L, N_EXPERTS, D_FF, D_MODEL), D_FF ** -0.5),
        'b_down': nrm(ks[22], (L, N_EXPERTS, D_MODEL), 0.01),
        'final_norm': 1.0 + nrm(ks[23], (D_MODEL,), 0.05),
    }


def reference(x, c, ctx, c_ctx, w_mod, b_mod, norm_mix, norm_ffn, w_in, q_norm, k_norm,
              sconv_w, conf_dw_w, conf_dw_b, conf_ln_g, conf_ln_b, w_out, router_w, router_b,
              w_up, b_up, w_down, b_down, final_norm):
    rows = x.shape[1] // GRID_W
    cos, sin = axial_rope_tables(rows, x.dtype)
    c_act = jax.nn.silu(c)
    cc_act = jax.nn.silu(c_ctx)
    xc = ctx
    for l in range(DEPTH):
        x, xc = hybrid_layer(
            x, xc, c_act, cc_act, cos, sin, w_mod[l], b_mod[l], norm_mix[l], norm_ffn[l], w_in[l],
            q_norm[l], k_norm[l], sconv_w[l], conf_dw_w[l], conf_dw_b[l], conf_ln_g[l], conf_ln_b[l],
            w_out[l], router_w[l], router_b[l], w_up[l], b_up[l], w_down[l], b_down[l],
            update_ctx=(l < DEPTH - 1))
    return rms_norm(x, final_norm)
```

```cpp
#include <hip/hip_runtime.h>
#include <cstdio>
#include <cstdint>

#ifndef MK_ONE_LAUNCH
#define MK_ONE_LAUNCH 1
#endif

#ifndef REP_P0
#define REP_P0 1
#endif
#ifndef REP_NORM1
#define REP_NORM1 1
#endif
#ifndef REP_PREP
#define REP_PREP 1
#endif
#ifndef REP_N2
#define REP_N2 1
#endif
#ifndef REP_ROUTE
#define REP_ROUTE 1
#endif
#ifndef REP_COMB
#define REP_COMB 1
#endif
#ifndef REP_GEMM
#define REP_GEMM 1
#endif
#ifndef REP_ATTN
#define REP_ATTN 1
#endif
#ifndef REP_MOE
#define REP_MOE 1
#endif
#define LAS __attribute__((address_space(3)))
#define GAS __attribute__((address_space(1)))
typedef unsigned short bf16_t;
typedef short bf16x8 __attribute__((ext_vector_type(8)));
typedef short s16x4 __attribute__((ext_vector_type(4)));
typedef float f32x2 __attribute__((ext_vector_type(2)));
typedef float f32x4 __attribute__((ext_vector_type(4)));
typedef float f32x8 __attribute__((ext_vector_type(8)));
typedef float f32x16 __attribute__((ext_vector_type(16)));
typedef unsigned u32x2 __attribute__((ext_vector_type(2)));
typedef unsigned u32x4 __attribute__((ext_vector_type(4)));

constexpr int DM = 1024, BATCH = 8, SEQ = 4096, CTXL = 256, DEPTH = 2;
constexpr int NLAT = BATCH * SEQ, NCTX = BATCH * CTXL, NTOK = NLAT + NCTX;
constexpr int IN_W = 2560, MIX_W = 1280, NE = 32, TOPK = 4, DFF = 1024;
constexpr int SKV = CTXL + SEQ;
constexpr int NMOD = 6 * DM;
constexpr int MPAD = (NTOK * TOPK / 256 + NE) * 256;
constexpr float EPS = 1e-6f;
constexpr int NWG = 256, NTHR = 512, NWAVES = 8;

constexpr size_t MiB = 1u << 20;
constexpr size_t WS_CTL = 0, CTL_ZERO_BYTES = 1 * MiB;
constexpr size_t WS_MODS = 1 * MiB;
constexpr size_t WS_CNT = 2 * MiB;
constexpr size_t WS_EOFF = WS_CNT + 64 * 1024;
constexpr size_t WS_TOKE = 3 * MiB;
constexpr size_t WS_TOKP = 4 * MiB;
constexpr size_t WS_TOKPOS = 5 * MiB;
constexpr size_t WS_ROWW = 6 * MiB;
constexpr size_t WS_ROWTOK = 7 * MiB;
constexpr size_t WS_WIN = 8 * MiB;
constexpr size_t WS_WOUT = 18 * MiB;
constexpr size_t WS_WUP = 24 * MiB;
constexpr size_t WS_WDN = 152 * MiB;
constexpr size_t WS_H8 = 216 * MiB;
constexpr size_t WS_HA8 = 252 * MiB;
constexpr size_t WS_WIN8 = 288 * MiB;
constexpr size_t WS_HA = 408 * MiB;
constexpr size_t WS_XA = 476 * MiB;
constexpr size_t WS_XB = 612 * MiB;
constexpr size_t WS_S = 748 * MiB;
constexpr size_t WS_U = WS_S;
constexpr size_t WS_QB = WS_S + 170 * MiB;
constexpr size_t WS_KB = WS_S + 204 * MiB;
constexpr size_t WS_VB = WS_S + 221 * MiB;
constexpr size_t WS_MIX = WS_S + 238 * MiB;
constexpr size_t WS_F2 = WS_S + 323 * MiB;
constexpr size_t WS_ACT = WS_S + 360 * MiB;
constexpr size_t WS_YR = WS_S;
constexpr size_t WS_END = WS_S + 648 * MiB;
static_assert(WS_F2 + (size_t)NTOK * 512 * 2 <= WS_ACT && WS_YR + (size_t)MPAD * 1024 * 2 <= WS_ACT && WS_H8 + (size_t)NTOK * 1024 <= WS_HA && WS_WDN + 2ull * 32 * 1024 * 1024 <= WS_H8, "ws map");
constexpr float YR_SCALE = 16.f, YR_INV = 1.f / 16.f;
constexpr float W8_SCALE = 64.f, W8_INV = 1.f / 64.f;

constexpr int LDS_BYTES = 163840;
constexpr int LDS_LTOK = 131072;
constexpr int LDS_TAB = 159744;
constexpr int LDS_TAB_NMT = 700;
constexpr int LDS_CTL = 163584;
constexpr int LDS_FREE = 159744;

typedef float f32x2_t_ __attribute__((ext_vector_type(2)));
typedef __bf16 bf16x2_t_ __attribute__((ext_vector_type(2)));
__device__ __forceinline__ unsigned f2bf(float f) { const __bf16 b = (__bf16)f; return (unsigned)__builtin_bit_cast(unsigned short, b); }
__device__ __forceinline__ unsigned pk2(float lo, float hi) { const f32x2_t_ v = {lo, hi}; const bf16x2_t_ b = __builtin_convertvector(v, bf16x2_t_); return __builtin_bit_cast(unsigned, b); }
__device__ __forceinline__ float bf2f(unsigned h) { return __builtin_bit_cast(float, h << 16); }
__device__ __forceinline__ float bflo(unsigned w) { return __builtin_bit_cast(float, w << 16); }
__device__ __forceinline__ float bfhi(unsigned w) { return __builtin_bit_cast(float, w & 0xffff0000u); }
template <int M> __device__ __forceinline__ float xor_swz(float v) { return __builtin_bit_cast(float, __builtin_amdgcn_ds_swizzle(__builtin_bit_cast(int, v), (M << 10) | 0x1f)); }
__device__ __forceinline__ float xor32(float v, bool upper) { auto r = __builtin_amdgcn_permlane32_swap(__float_as_uint(v), __float_as_uint(v), false, false); return __uint_as_float(upper ? r[0] : r[1]); }
__device__ __forceinline__ float wave_sum(float v) {
    v += xor_swz<1>(v); v += xor_swz<2>(v); v += xor_swz<4>(v); v += xor_swz<8>(v); v += xor_swz<16>(v);
    auto r = __builtin_amdgcn_permlane32_swap(__float_as_uint(v), __float_as_uint(v), false, false);
    return __uint_as_float(r[0]) + __uint_as_float(r[1]);
}
__device__ __forceinline__ float sigmoidf_(float x) { return __builtin_amdgcn_rcpf(1.f + __builtin_amdgcn_exp2f(x * -1.4426950408889634f)); }
__device__ __forceinline__ void sincos_rev(float rev, float& sn, float& cs) { const float fr = __builtin_amdgcn_fractf(rev); sn = __builtin_amdgcn_sinf(fr); cs = __builtin_amdgcn_cosf(fr); }
__device__ __forceinline__ int tok_bidx(int t) { return t < NLAT ? (t >> 12) : 8; }
#define LDS_WAIT() asm volatile("s_waitcnt lgkmcnt(0)" ::: "memory")

__device__ __forceinline__ int ptid_w(int wv) { unsigned m = ~0u; asm volatile("" : "+s"(m)); int l = (int)__builtin_amdgcn_mbcnt_hi(m, __builtin_amdgcn_mbcnt_lo(m, 0u)); asm volatile("" : "+v"(l)); return (wv << 6) | l; }

namespace pg8 {
#define PG8_LAS __attribute__((address_space(3)))
constexpr int BM = 256, BK = 64, HALF = 128, HTB = HALF * BK * 2, STAGE_BYTES = 8 * HTB;
__host__ __device__ __forceinline__ int lds_byte(int r, int c) { const int st = (r >> 4) * 2 + (c >> 5), rr = r & 15, cc = c & 31, ob = rr * 64 + cc * 2; return st * 1024 + (ob ^ (((ob >> 9) & 1) << 5)); }
__host__ __device__ __forceinline__ void stage_rc(int b, int& R, int& C) { const int st = b / 1024, sb = b % 1024, swz = sb ^ (((sb >> 9) & 1) << 5); R = (st >> 1) * 16 + swz / 64; C = (st & 1) * 32 + (swz % 64) / 2; }
__host__ __device__ __forceinline__ int perm32(int rho) { const int n = rho >> 4, i = rho & 15; return 8 * (i >> 2) + 4 * n + (i & 3); }
__host__ __device__ __forceinline__ int perm64(int R) { return (R >> 5) * 64 + ((R >> 2) & 3) * 16 + ((R >> 4) & 1) * 4 + (R & 3); }
struct Unit { int pm, pn; };
struct Gemm { const void* A; const void* Bt; int Kb; };
__device__ __forceinline__ unsigned cvt_pk_bf16(float lo, float hi) { unsigned r; asm volatile("v_cvt_pk_bf16_f32 %0, %1, %2" : "=v"(r) : "v"(lo), "v"(hi)); return r; }
typedef int v8i __attribute__((ext_vector_type(8)));
typedef int v4i __attribute__((ext_vector_type(4)));
__device__ __forceinline__ v8i cat8(bf16x8 a, bf16x8 b) { const v4i x = __builtin_bit_cast(v4i, a), y = __builtin_bit_cast(v4i, b); return (v8i){x[0], x[1], x[2], x[3], y[0], y[1], y[2], y[3]}; }
__device__ __forceinline__ unsigned cvt4_fp8(float a, float b, float c, float d) { int r = 0; r = __builtin_amdgcn_cvt_pk_fp8_f32(a, b, r, false); r = __builtin_amdgcn_cvt_pk_fp8_f32(c, d, r, true); return (unsigned)r; }

template <int nN>
__device__ __forceinline__ void tile_order(int L, int nM, int& pm, int& pn) {
    const int nwg = nM * nN; int wgid = L;
    { const int q = nwg >> 3, r = nwg & 7, xcd = wgid & 7, off = wgid >> 3; wgid = (xcd < r ? xcd * (q + 1) : r * (q + 1) + (xcd - r) * q) + off; }
    constexpr int nig = 8 * nN; const int gid = wgid / nig, fm = gid * 8, gsz = (nM - fm) < 8 ? (nM - fm) : 8, rem = wgid - gid * nig;
    if (gsz == 8) { pm = fm + (rem & 7); pn = rem >> 3; } else { pn = rem / gsz; pm = fm + (rem - pn * gsz); }
}

template <bool FP8, class Epi, class Sched>
__device__ __forceinline__ void gemm_phase(PG8_LAS unsigned char* lds, const Gemm g, const Sched& S, const Epi& E, const int tid) {
    const int wid = __builtin_amdgcn_readfirstlane(tid >> 6), lane = tid & 63, wr = wid >> 2, wc = wid & 3, fr = lane & 15, fq = lane >> 4;
    const int Kb = g.Kb, nt = Kb / (BK * 2);
    constexpr bool GATHER = Sched::GATHER;
    unsigned voffA[2], voffB[2]; int rcA[2];
#pragma unroll
    for (int i = 0; i < 2; ++i) { int R, C; stage_rc(tid * 16 + i * 8192, R, C); const int Rb = Epi::PERM == 2 ? perm64(R) : Epi::PERM ? ((R & ~31) + perm32(R & 31)) : R;
        voffA[i] = (unsigned)(R * Kb + C * 2); voffB[i] = (unsigned)(Rb * Kb + C * 2); rcA[i] = (R << 8) | (C * 2); }
    unsigned gc[2][2];
#define PG8_GOFF(uidx) do { if constexpr (GATHER) { _Pragma("unroll") for (int h_ = 0; h_ < 2; ++h_) _Pragma("unroll") for (int i_ = 0; i_ < 2; ++i_) \
        gc[h_][i_] = (unsigned)S.ltok[(uidx) * 256 + h_ * 128 + (rcA[i_] >> 8)] * (unsigned)Kb + (unsigned)(rcA[i_] & 255); } } while (0)
#define PG8_STAGE_A(bufoff, kptr, half) do { if constexpr (GATHER) PG8_STAGE(bufoff, kptr, gc[half]); else PG8_STAGE(bufoff, (kptr) + (half) * hstep, voffA); } while (0)
    const size_t kstep = (size_t)(BK * 2);
    const size_t hstep = (size_t)HALF * Kb;
    const size_t tstep = 2 * hstep;
    const size_t hstepB = Epi::PERM == 2 ? (size_t)8 * Kb : hstep;
    const unsigned ldsw = (unsigned)wid * 1024u;
    const int aoff = lds_byte(wr * 64 + fr, fq * 8), boff = lds_byte(wc * 32 + fr, fq * 8);
#define PG8_SA(b, h) (((b) * 2 + (h)) * HTB)
#define PG8_SB(b, h) ((4 + (b) * 2 + (h)) * HTB)
#define PG8_STAGE(bufoff, gbase, voff) do { _Pragma("unroll") for (int _i = 0; _i < 2; ++_i) { unsigned _vo = (voff)[_i]; asm volatile("" : "+v"(_vo));   \
        __builtin_amdgcn_global_load_lds((const unsigned*)((const char*)(gbase) + _vo), (PG8_LAS unsigned*)(lds + (bufoff) + ldsw + _i * 8192), 16, 0, 0); } } while (0)
#define PG8_LDA(dst, b, h) do { _Pragma("unroll") for (int m = 0; m < 4; ++m) _Pragma("unroll") for (int k = 0; k < 2; ++k) dst[m][k] = *(const PG8_LAS bf16x8*)(lds + PG8_SA(b, h) + aoff + m * 2048 + k * 1024); } while (0)
#define PG8_LDB(dst, b, h) do { _Pragma("unroll") for (int n = 0; n < 2; ++n) _Pragma("unroll") for (int k = 0; k < 2; ++k) dst[n][k] = *(const PG8_LAS bf16x8*)(lds + PG8_SB(b, h) + boff + n * 2048 + k * 1024); } while (0)
#define PG8_MMA(ai, bj, At, Bt) do { __builtin_amdgcn_s_setprio(1); _Pragma("unroll") for (int m = 0; m < 4; ++m) _Pragma("unroll") for (int n = 0; n < 2; ++n) { \
        if constexpr (FP8) acc[ai][bj][m][n] = __builtin_amdgcn_mfma_scale_f32_16x16x128_f8f6f4(cat8(Bt[n][0], Bt[n][1]), cat8(At[m][0], At[m][1]), acc[ai][bj][m][n], 0, 0, 0, 0, 0, 0); \
        else { _Pragma("unroll") for (int k = 0; k < 2; ++k) acc[ai][bj][m][n] = __builtin_amdgcn_mfma_f32_16x16x32_bf16(Bt[n][k], At[m][k], acc[ai][bj][m][n], 0, 0, 0); } } \
        __builtin_amdgcn_s_setprio(0); } while (0)
#define PG8_WAIT_V(n) asm volatile("s_waitcnt vmcnt(" #n ")" ::: "memory")
#define PG8_WAIT_L(n) asm volatile("s_waitcnt lgkmcnt(" #n ")" ::: "memory")
#define PG8_BAR __builtin_amdgcn_s_barrier()
#define PG8_SCHED __builtin_amdgcn_sched_barrier(0)
    Unit cur, nxt; int ui = 0;
    if (!S.next(0, cur)) return;
    f32x4 acc[2][2][4][2];
#pragma unroll
    for (int a = 0; a < 2; ++a)
#pragma unroll
        for (int b = 0; b < 2; ++b)
#pragma unroll
            for (int m = 0; m < 4; ++m)
#pragma unroll
                for (int n = 0; n < 2; ++n) acc[a][b][m][n] = (f32x4){0.f, 0.f, 0.f, 0.f};
    bf16x8 At[4][2], B0[2][2], B1[2][2];
    const char* cA = (const char*)g.A + (GATHER ? (size_t)0 : (size_t)cur.pm * tstep); const char* cB = (const char*)g.Bt + (size_t)cur.pn * tstep;
    PG8_GOFF(0);
    PG8_STAGE(PG8_SB(0, 0), cB, voffB); PG8_STAGE(PG8_SB(0, 1), cB + hstepB, voffB); PG8_STAGE_A(PG8_SA(0, 0), cA, 0); PG8_STAGE_A(PG8_SA(0, 1), cA, 1);
    if (wr == 1) PG8_BAR;
    PG8_WAIT_V(2); PG8_BAR;
    PG8_STAGE(PG8_SB(1, 0), cB + kstep, voffB); PG8_STAGE_A(PG8_SA(1, 0), cA + kstep, 0); PG8_STAGE(PG8_SB(1, 1), cB + hstepB + kstep, voffB);
    PG8_WAIT_V(6); PG8_BAR;
    for (;;) {
        const bool has_next = S.next(ui + 1, nxt);
        const char* nA = (has_next && !GATHER) ? (const char*)g.A + (size_t)nxt.pm * tstep : cA; const char* nB = has_next ? (const char*)g.Bt + (size_t)nxt.pn * tstep : cB;
        for (int t = 0; t < nt; t += 2) {
            const bool last = (t == nt - 2);
            const char* a1 = cA + (size_t)(t + 1) * kstep;
            const char* a2 = last ? nA : cA + (size_t)(t + 2) * kstep; const char* b2 = last ? nB : cB + (size_t)(t + 2) * kstep;
            const char* a3 = a2 + kstep; const char* b3 = b2 + kstep;
            PG8_LDB(B0, 0, 0); PG8_LDB(B1, 0, 1); PG8_SCHED; PG8_LDA(At, 0, 0); PG8_STAGE_A(PG8_SA(1, 1), a1, 1); if (last && has_next) PG8_GOFF(ui + 1);
            PG8_WAIT_V(8); PG8_WAIT_L(0); PG8_BAR; PG8_MMA(0, 0, At, B0); PG8_MMA(0, 1, At, B1); PG8_BAR; PG8_SCHED;
            PG8_LDA(At, 0, 1); PG8_STAGE(PG8_SB(0, 0), b2, voffB); PG8_STAGE(PG8_SB(0, 1), b2 + hstepB, voffB); PG8_STAGE_A(PG8_SA(0, 0), a2, 0);
            PG8_WAIT_V(8); PG8_WAIT_L(0); PG8_BAR; PG8_MMA(1, 0, At, B0); PG8_MMA(1, 1, At, B1); PG8_BAR; PG8_SCHED;
            PG8_LDB(B0, 1, 0); PG8_LDB(B1, 1, 1); PG8_SCHED; PG8_LDA(At, 1, 0); PG8_STAGE_A(PG8_SA(0, 1), a2, 1);
            PG8_WAIT_V(8); PG8_WAIT_L(0); PG8_BAR; PG8_MMA(0, 0, At, B0); PG8_MMA(0, 1, At, B1); PG8_BAR; PG8_SCHED;
            PG8_LDA(At, 1, 1); PG8_STAGE(PG8_SB(1, 0), b3, voffB); PG8_STAGE(PG8_SB(1, 1), b3 + hstepB, voffB); PG8_STAGE_A(PG8_SA(1, 0), a3, 0);
            PG8_WAIT_V(8); PG8_WAIT_L(0); PG8_BAR; PG8_MMA(1, 0, At, B0); PG8_MMA(1, 1, At, B1); PG8_BAR; PG8_SCHED;
        }
        if (wr == 0) PG8_BAR;
        { const int l2 = ptid_w(wid) & 63; E(acc, cur, wr, wc, l2 & 15, l2 >> 4); }
        if (!has_next) break;
#pragma unroll
        for (int a = 0; a < 2; ++a)
#pragma unroll
            for (int b = 0; b < 2; ++b)
#pragma unroll
                for (int m = 0; m < 4; ++m)
#pragma unroll
                    for (int n = 0; n < 2; ++n) acc[a][b][m][n] = (f32x4){0.f, 0.f, 0.f, 0.f};
        cur = nxt; cA = nA; cB = nB; ++ui;
        if (wr == 1) PG8_BAR;
    }
    PG8_WAIT_V(0);
    PG8_BAR;
#undef PG8_SA
#undef PG8_SB
#undef PG8_STAGE
#undef PG8_STAGE_A
#undef PG8_GOFF
#undef PG8_LDA
#undef PG8_LDB
#undef PG8_MMA
#undef PG8_WAIT_V
#undef PG8_WAIT_L
#undef PG8_BAR
#undef PG8_SCHED
}

struct EpiStoreBf16 {
    static constexpr int PERM = 2;
    bf16_t* O; int ldc; float sc;
    __device__ __forceinline__ void operator()(const f32x4 (&acc)[2][2][4][2], const Unit& u, int wr, int wc, int fr, int fq) const {
        const int row0 = u.pm * BM + wr * 64 + fr, col0 = u.pn * BM + wc * 64 + 16 * fq;
#pragma unroll
        for (int ai = 0; ai < 2; ++ai)
#pragma unroll
            for (int m = 0; m < 4; ++m) { bf16_t* rowp = O + (size_t)(row0 + ai * HALF + m * 16) * ldc + col0;
#pragma unroll
                for (int bj = 0; bj < 2; ++bj) { const f32x4 v0 = acc[ai][bj][m][0] * sc, v1 = acc[ai][bj][m][1] * sc;
                    u32x4 w; w.x = cvt_pk_bf16(v0[0], v0[1]); w.y = cvt_pk_bf16(v0[2], v0[3]); w.z = cvt_pk_bf16(v1[0], v1[1]); w.w = cvt_pk_bf16(v1[2], v1[3]);
                    *(u32x4*)(rowp + bj * 8) = w; } }
    }
};
template <bool XBF16>
struct EpiResidual {
    static constexpr int PERM = 2;
    const void* xlat; const void* xctx; bf16_t* out; const float* gate;
    __device__ __forceinline__ void operator()(const f32x4 (&acc)[2][2][4][2], const Unit& u, int wr, int wc, int fr, int fq) const {
        const int row0 = u.pm * BM + wr * 64 + fr, col0 = u.pn * BM + wc * 64 + 16 * fq;
        const int bidx = (u.pm < NLAT / 256) ? (u.pm >> 4) : 8;
        const float* gp = gate + (size_t)bidx * NMOD + col0;
        f32x4 gv[2][2];
#pragma unroll
        for (int bj = 0; bj < 2; ++bj)
#pragma unroll
            for (int n = 0; n < 2; ++n) gv[bj][n] = *(const f32x4*)(gp + bj * 8 + 4 * n);
#pragma unroll
        for (int ai = 0; ai < 2; ++ai)
#pragma unroll
            for (int m = 0; m < 4; ++m) { const int row = row0 + ai * HALF + m * 16;
                bf16_t* orow = out + (size_t)row * DM + col0;
#pragma unroll
                for (int bj = 0; bj < 2; ++bj) { f32x4 x0, x1;
                    if constexpr (XBF16) { const bf16_t* xr = (row < NLAT ? (const bf16_t*)xlat + (size_t)row * DM : (const bf16_t*)xctx + (size_t)(row - NLAT) * DM) + col0 + bj * 8;
                        const u32x4 xb = *(const u32x4*)xr; x0 = (f32x4){bflo(xb.x), bfhi(xb.x), bflo(xb.y), bfhi(xb.y)}; x1 = (f32x4){bflo(xb.z), bfhi(xb.z), bflo(xb.w), bfhi(xb.w)}; }
                    else { const float* xr = (row < NLAT ? (const float*)xlat + (size_t)row * DM : (const float*)xctx + (size_t)(row - NLAT) * DM) + col0 + bj * 8;
                        x0 = *(const f32x4*)xr; x1 = *(const f32x4*)(xr + 4); }
                    const f32x4 v0 = x0 + gv[bj][0] * acc[ai][bj][m][0], v1 = x1 + gv[bj][1] * acc[ai][bj][m][1];
                    u32x4 w; w.x = cvt_pk_bf16(v0[0], v0[1]); w.y = cvt_pk_bf16(v0[2], v0[3]); w.z = cvt_pk_bf16(v1[0], v1[1]); w.w = cvt_pk_bf16(v1[2], v1[3]);
                    *(u32x4*)(orow + bj * 8) = w; } }
    }
};
struct EpiSwiGLU {
    static constexpr int PERM = 1;
    unsigned char* O; const float* bup;
    __device__ __forceinline__ void operator()(const f32x4 (&acc)[2][2][4][2], const Unit& u, int wr, int wc, int fr, int fq) const {
        const int e = u.pn >> 3, pnl = u.pn & 7;
        const int row0 = u.pm * BM + wr * 64 + fr, ac0 = pnl * 128 + wc * 32 + 8 * fq;
        const float* bp = bup + (size_t)e * 2048 + 2 * ac0;
        f32x4 bb[4];
#pragma unroll
        for (int q = 0; q < 4; ++q) bb[q] = *(const f32x4*)(bp + 4 * q);
        f32x2 bg[4], bl[4];
#pragma unroll
        for (int p = 0; p < 4; ++p) { bg[p] = (f32x2){bb[p][0], bb[p][2]}; bl[p] = (f32x2){bb[p][1] + 1.f, bb[p][3] + 1.f}; }
        unsigned char* cbase = O + (size_t)(row0 + (fq & 1) * 16) * DFF + (ac0 - 8 * (fq & 1));
#pragma unroll
        for (int ai = 0; ai < 2; ++ai)
#pragma unroll
            for (int mp = 0; mp < 2; ++mp) { u32x2 wq[2];
#pragma unroll
                for (int mi = 0; mi < 2; ++mi) { const int m = 2 * mp + mi;
                    float r[8];
#pragma unroll
                    for (int p = 0; p < 4; ++p) { const int n = p >> 1, i0 = (p & 1) * 2;
                        f32x2 gt = (f32x2){acc[ai][0][m][n][i0], acc[ai][0][m][n][i0 + 1]} * W8_INV + bg[p];
                        f32x2 ln = (f32x2){acc[ai][1][m][n][i0], acc[ai][1][m][n][i0 + 1]} * W8_INV + bl[p];
                        gt.x = fminf(gt.x, 7.f); gt.y = fminf(gt.y, 7.f);
                        ln.x = __builtin_amdgcn_fmed3f(ln.x, -6.f, 8.f); ln.y = __builtin_amdgcn_fmed3f(ln.y, -6.f, 8.f);
                        const f32x2 ex = gt * (-1.702f * 1.4426950408889634f);
                        f32x2 dn = (f32x2){__builtin_amdgcn_exp2f(ex.x), __builtin_amdgcn_exp2f(ex.y)} + 1.f;
                        dn.x = __builtin_amdgcn_rcpf(dn.x); dn.y = __builtin_amdgcn_rcpf(dn.y);
                        const f32x2 rr = (gt * dn) * ln;
                        r[2 * p] = rr.x; r[2 * p + 1] = rr.y; }
                    wq[mi].x = cvt4_fp8(r[0], r[1], r[2], r[3]); wq[mi].y = cvt4_fp8(r[4], r[5], r[6], r[7]); }
                const auto s0 = __builtin_amdgcn_permlane16_swap(wq[0].x, wq[1].x, false, false), s1 = __builtin_amdgcn_permlane16_swap(wq[0].y, wq[1].y, false, false);
                u32x4 w; w.x = s0[0]; w.y = s1[0]; w.z = s0[1]; w.w = s1[1];
                *(u32x4*)(cbase + (size_t)(ai * HALF + mp * 32) * DFF) = w; }
    }
};
struct EpiDown {
    static constexpr int PERM = 2;
    unsigned char* O; const float* bdn; const float* roww;
    __device__ __forceinline__ void operator()(const f32x4 (&acc)[2][2][4][2], const Unit& u, int wr, int wc, int fr, int fq) const {
        const int e = u.pn >> 2, pnl = u.pn & 3;
        const int row0 = u.pm * BM + wr * 64 + fr, col0 = pnl * BM + wc * 64 + 16 * fq;
        const float* bp = bdn + (size_t)e * DM + col0;
        f32x4 bv[2][2];
#pragma unroll
        for (int bj = 0; bj < 2; ++bj)
#pragma unroll
            for (int n = 0; n < 2; ++n) bv[bj][n] = *(const f32x4*)(bp + 8 * bj + 4 * n);
        float rwv[2][4];
#pragma unroll
        for (int ai = 0; ai < 2; ++ai)
#pragma unroll
            for (int m = 0; m < 4; ++m) rwv[ai][m] = roww[row0 + ai * HALF + m * 16] * YR_SCALE;
#pragma unroll
        for (int ai = 0; ai < 2; ++ai)
#pragma unroll
            for (int m = 0; m < 4; ++m) { const int row = row0 + ai * HALF + m * 16; const float w_ = rwv[ai][m];
                const f32x4 v0 = (acc[ai][0][m][0] * W8_INV + bv[0][0]) * w_, v1 = (acc[ai][0][m][1] * W8_INV + bv[0][1]) * w_;
                const f32x4 v2 = (acc[ai][1][m][0] * W8_INV + bv[1][0]) * w_, v3 = (acc[ai][1][m][1] * W8_INV + bv[1][1]) * w_;
                u32x4 w; w.x = cvt4_fp8(v0[0], v0[1], v0[2], v0[3]); w.y = cvt4_fp8(v1[0], v1[1], v1[2], v1[3]); w.z = cvt4_fp8(v2[0], v2[1], v2[2], v2[3]); w.w = cvt4_fp8(v3[0], v3[1], v3[2], v3[3]);
                *(u32x4*)(O + (size_t)row * DM + col0) = w; }
    }
};

template <int NS>
struct SchedSub {
    static constexpr bool GATHER = false; const LAS int* ltok = nullptr;
    int G, c, first, cfirst, nctx; bool rev;
    __device__ __forceinline__ bool next(int i, Unit& u) const {
        const int L = i * G + (rev ? G - 1 - c : c);
        if (L < 128 * NS) { int j; tile_order<NS>(L, 128, u.pm, j); u.pn = first + j; return true; }
        const int r = L - 128 * NS; if (r >= 8 * nctx) return false;
        const int q = (nctx == 2) ? (r >> 1) : (nctx == 4) ? (r >> 2) : (r / 6);
        u.pm = 128 + q; u.pn = cfirst + (r - q * nctx); return true;
    }
};
template <int nN>
struct SchedGrid {
    static constexpr bool GATHER = false; const LAS int* ltok = nullptr;
    int G, c, nM;
    __device__ __forceinline__ bool next(int i, Unit& u) const {
        const int L = i * G + c; if (L >= nM * nN) return false;
        tile_order<nN>(L, nM, u.pm, u.pn); return true;
    }
};
template <int nN, bool GATHER_>
struct SchedMoe {
    static constexpr bool GATHER = GATHER_;
    int G, c, nMt; const LAS int* tile_e; const LAS int* ltok;
    __device__ __forceinline__ bool next(int i, Unit& u) const {
        const int L = i * G + c; if (L >= nMt * nN) return false;
        int pm, pn; tile_order<nN>(L, nMt, pm, pn);
        const int e = __builtin_amdgcn_readfirstlane(tile_e[pm]);
        u.pm = pm; u.pn = e * nN + pn; return true;
    }
};
}

namespace att { __device__ __forceinline__ unsigned cvtpk(float lo, float hi) { unsigned r; asm volatile("v_cvt_pk_bf16_f32 %0, %1, %2" : "=v"(r) : "v"(lo), "v"(hi)); return r; } }
namespace att8 {
typedef int v8i __attribute__((ext_vector_type(8)));
typedef int v4i __attribute__((ext_vector_type(4)));
constexpr int NW = 8, QBLK = 32, KVBLK = 64;
constexpr float SCALE = 0.088388347648318440f;
constexpr float QSC = SCALE * 1.4426950408889634f;
constexpr float THR = 3.f;
constexpr float THR2 = THR * 1.4426950408889634f;
constexpr int NSLOT = 4, SLOT = 8192;
constexpr int OFF_K = 0, OFF_V = NSLOT * SLOT, OFF_WS = 2 * NSLOT * SLOT, OFF_OST = OFF_WS + 2048;
static_assert(OFF_OST + 8 * 8704 <= 163840 - 256, "att8 LDS");
__device__ __forceinline__ int crow(int r, int hi) { return (r & 3) + 8 * (r >> 2) + 4 * hi; }
__host__ __device__ __forceinline__ int kpos(int k) { const int kk = k & 31, up = k >> 5, hi = (kk >> 2) & 1, r = (kk & 3) + 4 * (kk >> 3); return 32 * hi + 16 * up + r; }
__device__ __forceinline__ v8i ld32(const char* p) { const v4i a = *(const v4i*)p, b = *(const v4i*)(p + 16); return (v8i){a[0], a[1], a[2], a[3], b[0], b[1], b[2], b[3]}; }
__device__ __forceinline__ f32x16 mma8(v8i a, v8i b, f32x16 c) { return __builtin_amdgcn_mfma_scale_f32_32x32x64_f8f6f4(a, b, c, 0, 0, 0, 0, 0, 0); }

template <bool FIRST>
__device__ __forceinline__ void partialSM(f32x16& p0, f32x16& p1, f32x16& negm, float& alpha) {
  float pmax = p0[0]; for (int r = 1; r < 16; ++r) pmax = fmaxf(pmax, p0[r]); for (int r = 0; r < 16; ++r) pmax = fmaxf(pmax, p1[r]);
  { auto rr = __builtin_amdgcn_permlane32_swap(__float_as_uint(pmax), __float_as_uint(pmax), false, false);
    pmax = fmaxf(__uint_as_float(rr[0]), __uint_as_float(rr[1])); }
  const float d = pmax - 4.f;
  if (!FIRST && __builtin_expect(__all(d <= THR2), 1)) alpha = 1.f;
  else { const float dl = FIRST ? d : fmaxf(d, 0.f); alpha = __builtin_amdgcn_exp2f(-dl);
    for (int r = 0; r < 16; ++r) { p0[r] -= dl; p1[r] -= dl; negm[r] -= dl; } }
  for (int r = 0; r < 16; ++r) p0[r] = __builtin_amdgcn_exp2f(p0[r]);
}
__device__ __forceinline__ void finishA(f32x16& p1) { for (int r = 0; r < 16; ++r) p1[r] = __builtin_amdgcn_exp2f(p1[r]); }
__device__ __forceinline__ void finishB(f32x16& p0, f32x16& p1, v8i& pa, float& lsum) {
  { float t0 = p0[0] + p1[0], t1 = p0[1] + p1[1], t2 = p0[2] + p1[2], t3 = p0[3] + p1[3];
#pragma unroll
    for (int r = 4; r < 16; r += 4) { t0 += p0[r] + p1[r]; t1 += p0[r + 1] + p1[r + 1]; t2 += p0[r + 2] + p1[r + 2]; t3 += p0[r + 3] + p1[r + 3]; }
    lsum += (t0 + t1) + (t2 + t3); }
#pragma unroll
  for (int w = 0; w < 4; ++w) { int a = pa[w], b = pa[4 + w];
    a = __builtin_amdgcn_cvt_pk_fp8_f32(p0[4 * w], p0[4 * w + 1], a, false); a = __builtin_amdgcn_cvt_pk_fp8_f32(p0[4 * w + 2], p0[4 * w + 3], a, true);
    b = __builtin_amdgcn_cvt_pk_fp8_f32(p1[4 * w], p1[4 * w + 1], b, false); b = __builtin_amdgcn_cvt_pk_fp8_f32(p1[4 * w + 2], p1[4 * w + 3], b, true);
    pa[w] = a; pa[4 + w] = b; }
}
struct KFrag { v8i a0, a1, a2, a3; };
__device__ __forceinline__ v8i ld2(const char* p, int o0, int o1) { const v4i a = *(const v4i*)(p + o0), b = *(const v4i*)(p + o1); return (v8i){a[0], a[1], a[2], a[3], b[0], b[1], b[2], b[3]}; }
__device__ __forceinline__ void kf_load(KFrag& f, const char* Ks, const int (&ka)[4]) {
  f.a0 = ld2(Ks, ka[0], ka[1]); f.a1 = ld2(Ks + 4096, ka[0], ka[1]); f.a2 = ld2(Ks, ka[2], ka[3]); f.a3 = ld2(Ks + 4096, ka[2], ka[3]);
}
__device__ __forceinline__ void qkt(f32x16& p0, f32x16& p1, const f32x16& negm, const KFrag& f, const v8i* qr) {
  p0 = mma8(f.a0, qr[0], negm); p1 = mma8(f.a1, qr[0], negm); p0 = mma8(f.a2, qr[1], p0); p1 = mma8(f.a3, qr[1], p1);
}
struct VFrag { v8i b0, b1, b2, b3; };
__device__ __forceinline__ void pv_load(VFrag& f, const char* Vs, const int (&va)[2]) {
  f.b0 = ld2(Vs, va[0], va[1]); f.b1 = ld2(Vs + 2048, va[0], va[1]); f.b2 = ld2(Vs + 4096, va[0], va[1]); f.b3 = ld2(Vs + 6144, va[0], va[1]);
}
__device__ __forceinline__ void pv(f32x16* o, const VFrag& f, v8i pa) {
  o[0] = mma8(pa, f.b0, o[0]); o[1] = mma8(pa, f.b1, o[1]); o[2] = mma8(pa, f.b2, o[2]); o[3] = mma8(pa, f.b3, o[3]);
}
template <int LDQ, int LDO>
__device__ __forceinline__ void attn_body(const unsigned char* __restrict__ Qb, const unsigned char* __restrict__ Kh, const unsigned char* __restrict__ VTh, bf16_t* __restrict__ Ob, int seq, char* lds, const int tid) {
  const int wid = tid >> 6, lane = tid & 63, r32 = lane & 31, hi = lane >> 5;
  char* V_lds = lds + OFF_V; char* K_lds = lds + OFF_K;
  float* ws = (float*)(lds + OFF_WS) + wid * 64; float* al_l = ws + 32;
  f32x16 o[4] = {}; float lsum = 0.f; v8i qr[2]; f32x16 negm;
#pragma unroll
  for (int r = 0; r < 16; ++r) negm[r] = 0.f;
  { const char* Qw = (const char*)Qb + (long)(wid * QBLK + r32) * LDQ + 32 * hi;
#pragma unroll
    for (int st = 0; st < 2; ++st) qr[st] = ld32(Qw + 64 * st); }
  unsigned kgoff, vgoff;
  { const int kr = wid * 8 + (lane >> 3), vr = wid * 16 + (lane >> 2);
    kgoff = (unsigned)(kr * 128 + (((lane & 7) ^ ((kr >> 1) & 7)) << 4)); vgoff = (unsigned)(vr * 64 + (((lane & 3) ^ ((vr >> 2) & 3)) << 4)); }
  int ka[4], va[2];
  { const int xk = (r32 >> 1) & 7, xv = (r32 >> 2) & 3;
#pragma unroll
    for (int c = 0; c < 4; ++c) ka[c] = r32 * 128 + (((4 * (c >> 1) + 2 * hi + (c & 1)) ^ xk) << 4);
#pragma unroll
    for (int c = 0; c < 2; ++c) va[c] = r32 * 64 + (((2 * hi + c) ^ xv) << 4); }
  const unsigned ldsw = (unsigned)__builtin_amdgcn_readfirstlane(wid) * 1024u;
#define DMA(t) do { const int t_ = (t); const unsigned so_ = (unsigned)(t_ & (NSLOT - 1)) * SLOT + ldsw; unsigned ko_ = kgoff, vo_ = vgoff; asm volatile("" : "+v"(ko_), "+v"(vo_)); \
    __builtin_amdgcn_global_load_lds((const unsigned*)(Kh + (size_t)t_ * SLOT + ko_), (LAS unsigned*)(lds + OFF_K + so_), 16, 0, 0); \
    __builtin_amdgcn_global_load_lds((const unsigned*)(VTh + (size_t)t_ * SLOT + vo_), (LAS unsigned*)(lds + OFF_V + so_), 16, 0, 0); } while (0)
#define WAITV2() asm volatile("s_waitcnt vmcnt(2)" ::: "memory")
#define BARX() __builtin_amdgcn_s_barrier()
#define RESC(a) do { if (__any((a) < 1.f)) { if (hi == 0) al_l[r32] = (a); asm volatile("s_waitcnt lgkmcnt(0)" ::: "memory"); \
    lsum *= (a); for (int r = 0; r < 16; ++r) { const float f_ = al_l[crow(r, hi)]; for (int d = 0; d < 4; ++d) o[d][r] *= f_; } } } while (0)
#define SBAR8() __builtin_amdgcn_sched_barrier(0)
  f32x16 pA0, pA1, pB0, pB1; float alA, alB; v8i pa = {}; const int NT = seq / KVBLK;
  DMA(0); DMA(1); WAITV2(); BARX();
  KFrag kf; kf_load(kf, K_lds, ka); qkt(pA0, pA1, negm, kf, qr); partialSM<true>(pA0, pA1, negm, alA);
  DMA(2 < NT ? 2 : NT - 1); WAITV2(); BARX();
  VFrag vf;
#define STEP(pN0, pN1, pO0, pO1, jj, alN) do { const int j_ = (jj); \
    SBAR8(); kf_load(kf, K_lds + (j_ & (NSLOT - 1)) * SLOT, ka); SBAR8(); \
    finishA(pO1); SBAR8(); \
    qkt(pN0, pN1, negm, kf, qr); SBAR8(); \
    pv_load(vf, V_lds + ((j_ - 1) & (NSLOT - 1)) * SLOT, va); SBAR8(); \
    finishB(pO0, pO1, pa, lsum); SBAR8(); \
    DMA(j_ + 2 < NT ? j_ + 2 : NT - 1); SBAR8();     \
    pv(o, vf, pa); partialSM<false>(pN0, pN1, negm, alN); \
    RESC(alN); WAITV2(); BARX(); } while (0)
  for (int j = 1; j + 1 < NT; j += 2) {
    STEP(pB0, pB1, pA0, pA1, j, alB);
    STEP(pA0, pA1, pB0, pB1, j + 1, alA);
  }
  STEP(pB0, pB1, pA0, pA1, NT - 1, alB);
  pv_load(vf, V_lds + ((NT - 1) & (NSLOT - 1)) * SLOT, va);
  finishA(pB1); finishB(pB0, pB1, pa, lsum); SBAR8();
  pv(o, vf, pa);
#undef STEP
  float rli[16];
  { auto rr = __builtin_amdgcn_permlane32_swap(__float_as_uint(lsum), __float_as_uint(lsum), false, false);
    const float rl = __builtin_amdgcn_rcpf(__uint_as_float(rr[0]) + __uint_as_float(rr[1]));
    if (hi == 0) al_l[r32] = rl; asm volatile("s_waitcnt lgkmcnt(0)" ::: "memory");
#pragma unroll
    for (int r = 0; r < 16; ++r) rli[r] = al_l[crow(r, hi)]; }
  { char* ost = lds + OFF_OST + wid * (32 * 272);
#pragma unroll
    for (int r = 0; r < 16; ++r) { const int orow = crow(r, hi);
#pragma unroll
      for (int d0 = 0; d0 < 4; ++d0) *(bf16_t*)(ost + orow * 272 + (d0 * 32 + r32) * 2) = (bf16_t)att::cvtpk(o[d0][r] * rli[r], 0.f); }
    asm volatile("s_waitcnt lgkmcnt(0)" ::: "memory");
    bf16_t* Ow = Ob + (long)(wid * QBLK) * LDO;
#pragma unroll
    for (int i = 0; i < 8; ++i) { const int idx = lane + 64 * i, row = idx >> 4, ch = idx & 15;
      *(u32x4*)(Ow + (long)row * LDO + ch * 8) = *(const u32x4*)(ost + row * 272 + ch * 16); } }
  asm volatile("s_waitcnt vmcnt(0)" ::: "memory");
  __syncthreads();
#undef DMA
#undef WAITV2
#undef BARX
#undef RESC
#undef SBAR8
}
}

#define XB_TMO      128
#define XB_XCNT(j)  (256  + 64 * (j))
#define XB_XSUB(j)  (1280 + 64 * (j))
#define XB_XGEN(j)  (2304 + 64 * (j))
#define XB_TOP      3328
#define XB_TOPGEN   3392
#define XCD_BAR_WORDS 3456
#define XB_SPIN_CAP (1u << 18)
__device__ __forceinline__ unsigned xb_ld(unsigned* p)              { return __hip_atomic_load(p, __ATOMIC_RELAXED, __HIP_MEMORY_SCOPE_AGENT); }
__device__ __forceinline__ unsigned xb_add(unsigned* p, unsigned v) { return __hip_atomic_fetch_add(p, v, __ATOMIC_RELAXED, __HIP_MEMORY_SCOPE_AGENT); }
__device__ __forceinline__ unsigned xb_xcc_id() { return (unsigned)__builtin_amdgcn_s_getreg((3 << 11) | 20) & 0xFu; }
#define XB_SPIN(cond, bar) do { unsigned _sp = 0; while (cond) { __builtin_amdgcn_s_sleep(1); \
    if ((++_sp & 255u) == 0u) { if (xb_ld(&(bar)[XB_TMO])) break; if (_sp > XB_SPIN_CAP) { atomicAdd(&(bar)[XB_TMO], 1u); break; } } } } while (0)
struct XcdBarrier { unsigned* bar; unsigned x; volatile LAS unsigned* st; };
__device__ __forceinline__ XcdBarrier xcd_barrier_post(unsigned* bar, volatile LAS unsigned* st) {
    XcdBarrier b; b.bar = bar; b.x = xb_xcc_id(); b.st = st;
    if (threadIdx.x == 0) (void)xb_add(&bar[XB_XCNT(b.x)], 1u);
    return b;
}
__device__ __forceinline__ void xcd_barrier_complete(unsigned* bar, unsigned x, unsigned& nloc, unsigned& nx) {
    const unsigned G = gridDim.x * gridDim.y * gridDim.z;
    unsigned sum, cnt, mine, sp = 0u;
    for (;;) {
        sum = 0u; cnt = 0u; mine = 0u;
#pragma unroll
        for (unsigned j = 0; j < 16; ++j) { const unsigned c = xb_ld(&bar[XB_XCNT(j)]); sum += c; cnt += (c > 0u) ? 1u : 0u; mine = (j == x) ? c : mine; }
        if (sum == G) break;
        __builtin_amdgcn_s_sleep(1);
        if ((++sp & 255u) == 0u) { if (xb_ld(&bar[XB_TMO])) break; if (sp > XB_SPIN_CAP) { atomicAdd(&bar[XB_TMO], 1u); break; } }
    }
    nloc = mine > 0u ? mine : 1u; nx = cnt > 0u ? cnt : 1u;
}
template <class Work>
__device__ __forceinline__ void xcd_barrier(const XcdBarrier& b, Work work) {
    asm volatile("s_waitcnt vmcnt(0)" ::: "memory");
    __syncthreads();
    if (threadIdx.x >= 64) work((int)threadIdx.x - 64, (int)blockDim.x - 64);
    if (threadIdx.x == 0) {
        unsigned* bar = b.bar;
        __builtin_amdgcn_s_waitcnt(0);
        unsigned nloc = b.st[0], nx = b.st[1];
        if (nloc == 0u) { xcd_barrier_complete(bar, b.x, nloc, nx); b.st[0] = nloc; b.st[1] = nx; }
        const unsigned old = xb_add(&bar[XB_XSUB(b.x)], 1u);
        const unsigned gen = old / nloc;
        if (old + 1u == (gen + 1u) * nloc) {
            __builtin_amdgcn_fence(__ATOMIC_RELEASE, "agent");
            asm volatile("s_waitcnt vmcnt(0)" ::: "memory");
            const unsigned og = xb_add(&bar[XB_TOP], 1u);
            const unsigned tg = og / nx;
            if (og + 1u == (tg + 1u) * nx) xb_add(&bar[XB_TOPGEN], 1u);
            else XB_SPIN(xb_ld(&bar[XB_TOPGEN]) == tg, bar);
            __builtin_amdgcn_fence(__ATOMIC_ACQUIRE, "agent");
            asm volatile("s_waitcnt vmcnt(0)" ::: "memory");
        } else {
            XB_SPIN(xb_ld(&bar[XB_TOPGEN]) == gen, bar);
            __builtin_amdgcn_fence(__ATOMIC_ACQUIRE, "agent");
            asm volatile("s_waitcnt vmcnt(0)" ::: "memory");
        }
    }
    __syncthreads();
}

__device__ __forceinline__ unsigned char* opq(unsigned char* p) { asm volatile("" : "+s"(p)); return p; }
struct Args { const float* in[24]; float* out; unsigned char* ws; int ph_lo, ph_hi; };
__device__ __forceinline__ Args load_args() {
#if defined(__HIP_DEVICE_COMPILE__)
    auto kp = __builtin_amdgcn_kernarg_segment_ptr();
    asm volatile("" : "+s"(kp));
    return *(const __attribute__((address_space(4))) Args*)kp;
#else
    return Args{};
#endif
}
enum { I_X = 0, I_C, I_CTX, I_CCTX, I_WMOD, I_BMOD, I_NMIX, I_NFFN, I_WIN, I_QN, I_KN, I_SCW, I_CDW, I_CDB, I_CLG, I_CLB, I_WOUT, I_RW, I_RB, I_WUP, I_BUP, I_WDN, I_BDN, I_FN };

__device__ __forceinline__ void p0_mods_unit(int unit, const float* w_mod, const float* b_mod, float* mods, const LAS float* act, LAS float* red, int tid) {
    const int l = unit / 384, col0 = (unit % 384) * 16, col = tid & 15, kg = tid >> 4;
    float acc[9];
#pragma unroll
    for (int r = 0; r < 9; ++r) acc[r] = 0.f;
    const float* wp = w_mod + ((size_t)l * DM + kg * 32) * NMOD + col0 + col;
#pragma unroll 16
    for (int k = 0; k < 32; ++k) { const float w = wp[(size_t)k * NMOD];
#pragma unroll
        for (int r = 0; r < 9; ++r) acc[r] += act[r * DM + kg * 32 + k] * w; }
#pragma unroll
    for (int r = 0; r < 9; ++r) red[(kg * 9 + r) * 16 + col] = acc[r];
    __syncthreads();
    if (tid < 9 * 16) { const int r = tid >> 4, cc = tid & 15; float sm = 0.f;
#pragma unroll
        for (int g = 0; g < 32; ++g) sm += red[(g * 9 + r) * 16 + cc];
        mods[((size_t)l * 9 + r) * NMOD + col0 + cc] = sm + b_mod[(size_t)l * NMOD + col0 + cc]; }
    __syncthreads();
}
struct MapId { __device__ __forceinline__ int operator()(int n) const { return n; } };
struct MapUp { __device__ __forceinline__ int operator()(int n) const { const int a = n >> 1, j = n & 1; return ((a >> 7) << 8) + (j << 7) + (a & 127); } };
template <class NMap>
__device__ __forceinline__ void p0_transpose_item8(const float* W, int K, int N, unsigned char* WT, LAS float* scr, int kb, int nb, int lane, NMap nmap) {
    const int k0 = 64 * kb, n0 = 64 * nb;
    { const int kq = lane >> 4, n4 = (lane & 15) * 4;
#pragma unroll
        for (int i = 0; i < 16; ++i) { const f32x4 v = __builtin_nontemporal_load((const f32x4*)(W + (size_t)(k0 + 4 * i + kq) * N + n0 + n4));
            LAS float* d = scr + (4 * i + kq) * 65 + n4; d[0] = v.x; d[1] = v.y; d[2] = v.z; d[3] = v.w; } }
    LDS_WAIT(); asm volatile("" ::: "memory");
    const int c = lane & 3, rs = lane >> 2;
#pragma unroll
    for (int j = 0; j < 4; ++j) { const int nl = rs + 16 * j; const LAS float* s = scr + (16 * c) * 65 + nl;
        u32x4 o;
        o.x = pg8::cvt4_fp8(s[0 * 65] * W8_SCALE, s[1 * 65] * W8_SCALE, s[2 * 65] * W8_SCALE, s[3 * 65] * W8_SCALE); o.y = pg8::cvt4_fp8(s[4 * 65] * W8_SCALE, s[5 * 65] * W8_SCALE, s[6 * 65] * W8_SCALE, s[7 * 65] * W8_SCALE);
        o.z = pg8::cvt4_fp8(s[8 * 65] * W8_SCALE, s[9 * 65] * W8_SCALE, s[10 * 65] * W8_SCALE, s[11 * 65] * W8_SCALE); o.w = pg8::cvt4_fp8(s[12 * 65] * W8_SCALE, s[13 * 65] * W8_SCALE, s[14 * 65] * W8_SCALE, s[15 * 65] * W8_SCALE);
        *(u32x4*)(WT + (size_t)nmap(n0 + nl) * K + k0 + 16 * c) = o; }
    LDS_WAIT(); asm volatile("" ::: "memory");
}
template <class NMap>
__device__ __forceinline__ void p0_transpose_item(const float* W, int K, int N, bf16_t* WT, LAS float* scr, int kb, int nb, int lane, NMap nmap) {
    const int k0 = 64 * kb, n0 = 64 * nb;
    { const int kq = lane >> 4, n4 = (lane & 15) * 4;
#pragma unroll
        for (int i = 0; i < 16; ++i) { const f32x4 v = __builtin_nontemporal_load((const f32x4*)(W + (size_t)(k0 + 4 * i + kq) * N + n0 + n4));
            LAS float* d = scr + (4 * i + kq) * 65 + n4; d[0] = v.x; d[1] = v.y; d[2] = v.z; d[3] = v.w; } }
    LDS_WAIT(); asm volatile("" ::: "memory");
    const int c = lane & 7, rs = lane >> 3;
#pragma unroll
    for (int j = 0; j < 8; ++j) { const int nl = rs + 8 * j; const LAS float* s = scr + (8 * c) * 65 + nl;
        u32x4 o; o.x = pk2(s[0 * 65], s[1 * 65]); o.y = pk2(s[2 * 65], s[3 * 65]); o.z = pk2(s[4 * 65], s[5 * 65]); o.w = pk2(s[6 * 65], s[7 * 65]);
        *(u32x4*)(WT + (size_t)nmap(n0 + nl) * K + k0 + 8 * c) = o; }
    LDS_WAIT(); asm volatile("" ::: "memory");
}
constexpr int P0_IT_IN = 16 * 40, P0_IT_IN8 = 16 * 16, P0_IT_OUT = 20 * 16, P0_IT_UP = 16 * 32, P0_IT_DN = 16 * 16, P0_IT_LAYER = P0_IT_IN + P0_IT_IN8 + P0_IT_OUT + NE * P0_IT_UP + NE * P0_IT_DN;
constexpr int P0_ITEMS = DEPTH * P0_IT_LAYER, P0_DEFER = NE * P0_IT_DN;
__device__ __forceinline__ void p0_items(const Args& a, LAS unsigned char* lds, int gw, int NGW, int it_lo, int it_hi, int tid);
__device__ __forceinline__ void p0_prologue(const Args& a, LAS unsigned char* lds, int wg, int tid) {
    const int lane = tid & 63, wave = tid >> 6;
    unsigned char* ws = a.ws;
    {
        LAS float* act = (LAS float*)lds; LAS float* red = (LAS float*)(lds + 9 * DM * 4);
        for (int i = tid; i < 9 * DM; i += NTHR) { const int r = i >> 10, k = i & 1023; const float v = (r < 8) ? a.in[I_C][r * DM + k] : a.in[I_CCTX][k]; act[i] = v * sigmoidf_(v); }
        __syncthreads();
        for (int u = wg; u < 768; u += NWG) p0_mods_unit(u, a.in[I_WMOD], a.in[I_BMOD], (float*)(ws + WS_MODS), act, red, tid);
    }
    p0_items(a, lds, wg * NWAVES + wave, NWG * NWAVES, 0, P0_ITEMS - P0_DEFER, tid);
}
__device__ __forceinline__ void p0_items(const Args& a, LAS unsigned char* lds, int gw, int NGW, int it_lo, int it_hi, int tid) {
    const int lane = tid & 63, wave = tid >> 6;
    unsigned char* ws = a.ws;
    LAS float* scr = (LAS float*)(lds + wave * 16640);
    constexpr int IT_IN = P0_IT_IN, IT_IN8 = P0_IT_IN8, IT_OUT = P0_IT_OUT, IT_UP = P0_IT_UP, IT_DN = P0_IT_DN, IT_LAYER = P0_IT_LAYER;
    for (int it = it_lo + gw; it < it_hi; it += NGW) {
        const int l = it / IT_LAYER; int r = it % IT_LAYER;
        if (r < IT_IN) { p0_transpose_item(a.in[I_WIN] + (size_t)l * DM * IN_W, DM, IN_W, (bf16_t*)(ws + WS_WIN) + (size_t)l * IN_W * DM, scr, r / 40, r % 40, lane, MapId()); continue; } r -= IT_IN;
        if (r < IT_IN8) { p0_transpose_item8(a.in[I_WIN] + (size_t)l * DM * IN_W, DM, IN_W, (unsigned char*)(ws + WS_WIN8) + (size_t)l * IN_W * DM, scr, r / 16, r % 16, lane, MapId()); continue; } r -= IT_IN8;
        if (r < IT_OUT) { p0_transpose_item(a.in[I_WOUT] + (size_t)l * MIX_W * DM, MIX_W, DM, (bf16_t*)(ws + WS_WOUT) + (size_t)l * DM * MIX_W, scr, r / 16, r % 16, lane, MapId()); continue; } r -= IT_OUT;
        if (r < NE * IT_UP) { const int e = r / IT_UP, q = r % IT_UP;
            p0_transpose_item8(a.in[I_WUP] + ((size_t)l * NE + e) * DM * 2048, DM, 2048, (unsigned char*)(ws + WS_WUP) + ((size_t)l * NE + e) * 2048 * DM, scr, q / 32, q % 32, lane, MapUp()); continue; } r -= NE * IT_UP;
        { const int e = r / IT_DN, q = r % IT_DN;
            p0_transpose_item8(a.in[I_WDN] + ((size_t)l * NE + e) * DFF * DM, DFF, DM, (unsigned char*)(ws + WS_WDN) + ((size_t)l * NE + e) * DM * DFF, scr, q / 16, q % 16, lane, MapId()); }
    }
}

__device__ __forceinline__ void ph_norm1(const float* xlat, const float* xctx, const float* gain, const float* mods_l, bf16_t* HA, unsigned char* HA8, int gw, int NGW, int lane) {
    const int k0 = 16 * lane;
    for (int t0 = gw * 2; t0 < NTOK; t0 += NGW * 2) {
        f32x4 v[2][4]; float ss[2];
#pragma unroll
        for (int r = 0; r < 2; ++r) { const int t = t0 + r; const float* xr = (t < NLAT) ? xlat + (size_t)t * DM : xctx + (size_t)(t - NLAT) * DM;
#pragma unroll
            for (int j = 0; j < 4; ++j) v[r][j] = *(const f32x4*)(xr + k0 + 4 * j); }
#pragma unroll
        for (int r = 0; r < 2; ++r) { float q = 0.f;
#pragma unroll
            for (int j = 0; j < 4; ++j) q += v[r][j].x * v[r][j].x + v[r][j].y * v[r][j].y + v[r][j].z * v[r][j].z + v[r][j].w * v[r][j].w;
            ss[r] = q; }
#pragma unroll
        for (int r = 0; r < 2; ++r) { const int t = t0 + r; const float* mp = mods_l + (size_t)tok_bidx(t) * NMOD;
            const float rstd = rsqrtf(wave_sum(ss[r]) * (1.f / DM) + EPS);
            u32x4 ho[2]; unsigned h8[4];
#pragma unroll
            for (int j = 0; j < 4; ++j) { const int k = k0 + 4 * j;
                const f32x4 g = *(const f32x4*)(gain + k), sh = *(const f32x4*)(mp + k), sc = *(const f32x4*)(mp + DM + k);
                const f32x4 y = (v[r][j] * rstd * g) * (sc + 1.f) + sh;
                ho[j >> 1][(j & 1) * 2] = pk2(y.x, y.y); ho[j >> 1][(j & 1) * 2 + 1] = pk2(y.z, y.w); h8[j] = pg8::cvt4_fp8(y.x, y.y, y.z, y.w); }
            *(u32x4*)(HA + (size_t)t * DM + k0) = ho[0]; *(u32x4*)(HA + (size_t)t * DM + k0 + 8) = ho[1];
            *(u32x4*)(HA8 + (size_t)t * DM + k0) = (u32x4){h8[0], h8[1], h8[2], h8[3]}; }
    }
}

__device__ __forceinline__ u32x2 qk_row(u32x4 X, const float (&g)[8], const float (&gp)[8], bool rot, float sgn, const LAS f32x2* rp) {
    float x[8] = {bflo(X.x), bfhi(X.x), bflo(X.y), bfhi(X.y), bflo(X.z), bfhi(X.z), bflo(X.w), bfhi(X.w)};
    float ss = 0.f;
#pragma unroll
    for (int i = 0; i < 8; ++i) ss += x[i] * x[i];
    ss += xor_swz<1>(ss); ss += xor_swz<2>(ss); ss += xor_swz<4>(ss); ss += xor_swz<8>(ss);
    const float rstd = rsqrtf(ss * (1.f / 128.f) + EPS);
    u32x4 P;
    P.x = (unsigned)__builtin_amdgcn_ds_swizzle((int)X.x, (4 << 10) | 0x1f); P.y = (unsigned)__builtin_amdgcn_ds_swizzle((int)X.y, (4 << 10) | 0x1f);
    P.z = (unsigned)__builtin_amdgcn_ds_swizzle((int)X.z, (4 << 10) | 0x1f); P.w = (unsigned)__builtin_amdgcn_ds_swizzle((int)X.w, (4 << 10) | 0x1f);
    const float px[8] = {bflo(P.x), bfhi(P.x), bflo(P.y), bfhi(P.y), bflo(P.z), bfhi(P.z), bflo(P.w), bfhi(P.w)};
    float o[8];
    if (rot) {
#pragma unroll
        for (int i = 0; i < 8; ++i) { const f32x2 cssn = rp[i]; o[i] = (x[i] * rstd * g[i]) * cssn.x + sgn * (px[i] * rstd * gp[i]) * cssn.y; }
    } else {
#pragma unroll
        for (int i = 0; i < 8; ++i) o[i] = x[i] * rstd * g[i];
    }
    u32x2 r; r.x = pg8::cvt4_fp8(o[0], o[1], o[2], o[3]); r.y = pg8::cvt4_fp8(o[4], o[5], o[6], o[7]); return r;
}
__device__ __forceinline__ void ph_qkv(int l, const Args& a, LAS unsigned char* lds, int wg, int tid) {
    const int lane = tid & 63, wave = tid >> 6;
    unsigned char* ws = a.ws;
    const bf16_t* U = (const bf16_t*)(ws + WS_U);
    unsigned char* QB = ws + WS_QB; unsigned char* KB = ws + WS_KB; unsigned char* VT = ws + WS_VB;
    LAS f32x2* rope = (LAS f32x2*)lds;
    for (int i = tid; i < 64 * 32; i += NTHR) { const int p = i >> 5, f = i & 31;
        const float inv = __builtin_amdgcn_exp2f(-(float)f * (2.0f / 64.0f) * 13.287712379549449f);
        float sn, cs; sincos_rev((float)p * inv * 0.15915494309189535f, sn, cs); rope[i] = (f32x2){cs, sn}; }
    __syncthreads();
    const bool last = (l == DEPTH - 1);
    const int j16 = lane & 15, d0 = j16 * 8, axis = j16 >> 3, fi0 = (j16 & 3) * 8;
    const float sgn = ((j16 >> 2) & 1) ? 1.f : -1.f;
    const float* qn = a.in[I_QN] + l * 128; const float* kn = a.in[I_KN] + l * 128;
    float qg[8], qgp[8], kg[8], kgp[8];
#pragma unroll
    for (int i = 0; i < 8; ++i) { qg[i] = qn[d0 + i] * att8::QSC; qgp[i] = qn[(d0 ^ 32) + i] * att8::QSC; kg[i] = kn[d0 + i]; kgp[i] = kn[(d0 ^ 32) + i]; }
#pragma unroll 2
    for (int t = wg * NWAVES + wave; t < NTOK; t += NWG * NWAVES) {
        const bool isctx = t >= NLAT;
        const int b = isctx ? (t - NLAT) >> 8 : t >> 12, sp = isctx ? (t - NLAT) & 255 : t & 4095, krow = isctx ? sp : CTXL + sp;
        const bool doq = !(last && isctx);
        const bf16_t* up = U + (size_t)t * IN_W;
        u32x4 A = {0u, 0u, 0u, 0u}; if (doq) A = *(const u32x4*)(up + 8 * lane);
        u32x4 B = {0u, 0u, 0u, 0u}; if (lane < 32) B = *(const u32x4*)(up + 512 + 8 * lane);
        const LAS f32x2* rp = rope + (axis ? (sp & 63) : (sp >> 6)) * 32 + fi0;
        const u32x2 qo = qk_row(A, qg, qgp, !isctx, sgn, rp);
        if (doq) *(u32x2*)(QB + (size_t)t * 512 + 8 * lane) = qo;
        const u32x2 ko = qk_row(B, kg, kgp, !isctx, sgn, rp);
        if (lane < 32) *(u32x2*)(KB + ((size_t)(b * 2 + (lane >> 4)) * SKV + krow) * 128 + d0) = ko;
    }
    __syncthreads();
    LAS unsigned char* T = (LAS unsigned char*)lds;
    for (int u = wg; u < BATCH * 2 * (SKV / 64); u += NWG) {
        const int b = u / (2 * (SKV / 64)), rem = u % (2 * (SKV / 64)), kvh = rem / (SKV / 64), tile = rem % (SKV / 64);
        { const int key = tid & 63, dch = (tid >> 6) * 16, kr = tile * 64 + key;
            const size_t tok = (kr < CTXL) ? (size_t)NLAT + b * CTXL + kr : (size_t)b * SEQ + (kr - CTXL);
            const bf16_t* src = U + tok * IN_W + 768 + kvh * 128 + dch;
            const u32x4 v0 = *(const u32x4*)src, v1 = *(const u32x4*)(src + 8);
            const unsigned w0 = pg8::cvt4_fp8(bflo(v0.x), bfhi(v0.x), bflo(v0.y), bfhi(v0.y)), w1 = pg8::cvt4_fp8(bflo(v0.z), bfhi(v0.z), bflo(v0.w), bfhi(v0.w));
            const unsigned w2 = pg8::cvt4_fp8(bflo(v1.x), bfhi(v1.x), bflo(v1.y), bfhi(v1.y)), w3 = pg8::cvt4_fp8(bflo(v1.z), bfhi(v1.z), bflo(v1.w), bfhi(v1.w));
            LAS unsigned char* dst = T + dch * 64 + att8::kpos(key);
#pragma unroll
            for (int i = 0; i < 4; ++i) { dst[(i) * 64] = (unsigned char)(w0 >> (8 * i)); dst[(4 + i) * 64] = (unsigned char)(w1 >> (8 * i)); dst[(8 + i) * 64] = (unsigned char)(w2 >> (8 * i)); dst[(12 + i) * 64] = (unsigned char)(w3 >> (8 * i)); } }
        __syncthreads();
        *(u32x4*)(VT + ((size_t)(b * 2 + kvh) * (SKV / 64) + tile) * 8192 + tid * 16) = *(const LAS u32x4*)(T + tid * 16);
        __syncthreads();
    }
}

constexpr int CV_GLU = 0, CV_D = 32768, CV_END = CV_D + 32 * 256 * 4;
__device__ __forceinline__ void ph_conv_tiles(int l, const Args& a, LAS unsigned char* lds, int wg, int tid) {
    unsigned char* ws = a.ws;
    const bf16_t* U = (const bf16_t*)(ws + WS_U); bf16_t* MIX = (bf16_t*)(ws + WS_MIX);
    const float* cdw = a.in[I_CDW] + (size_t)l * 31 * 256; const float* cdb = a.in[I_CDB] + l * 256;
    const float* clg = a.in[I_CLG] + l * 256; const float* clb = a.in[I_CLB] + l * 256; const float* scw = a.in[I_SCW] + (size_t)l * 3 * 256;
    LAS unsigned* glu = (LAS unsigned*)(lds + CV_GLU);
    LAS float* dbuf = (LAS float*)(lds + CV_D);
    const int cp = tid & 127, tg = tid >> 7;
    const int hw = tid >> 5, l32 = tid & 31;
    f32x2 w[31];
#pragma unroll
    for (int j = 0; j < 31; ++j) w[j] = *(const f32x2*)(cdw + j * 256 + 2 * cp);
    const f32x2 cbias = *(const f32x2*)(cdb + 2 * cp);
    const int ntiles = (l == DEPTH - 1) ? NLAT / 32 : NTOK / 32;
    u32x4 ra[4], rg[4];
#define CV_LOAD(TT) do { const int t0_ = (TT) * 32; const bool ic_ = t0_ >= NLAT; const int sq_ = ic_ ? (t0_ - NLAT) & 255 : t0_ & 4095, sl_ = ic_ ? CTXL : SEQ; \
        _Pragma("unroll") for (int i = 0; i < 4; ++i) { const int id = tid + NTHR * i, j = id >> 5, c8 = (id & 31) * 8, sj = sq_ - 15 + j; \
            ra[i] = (u32x4){0u, 0u, 0u, 0u}; rg[i] = ra[i]; \
            if (id < 62 * 32 && sj >= 0 && sj < sl_) { const bf16_t* up = U + (size_t)(t0_ - 15 + j) * IN_W + 2048 + c8; ra[i] = *(const u32x4*)up; rg[i] = *(const u32x4*)(up + 256); } } } while (0)
    if (wg < ntiles) CV_LOAD(wg);
    for (int tt = wg; tt < ntiles; tt += NWG) {
        const int t0 = tt * 32; const bool isctx = t0 >= NLAT;
        const int s0p = isctx ? (t0 - NLAT) & 255 : t0 & 4095, slen = isctx ? CTXL : SEQ;
#pragma unroll
        for (int i = 0; i < 4; ++i) { const int id = tid + NTHR * i;
            if (id < 62 * 32) { u32x4 o;
                o.x = pk2(bflo(ra[i].x) * sigmoidf_(bflo(rg[i].x)), bfhi(ra[i].x) * sigmoidf_(bfhi(rg[i].x))); o.y = pk2(bflo(ra[i].y) * sigmoidf_(bflo(rg[i].y)), bfhi(ra[i].y) * sigmoidf_(bfhi(rg[i].y)));
                o.z = pk2(bflo(ra[i].z) * sigmoidf_(bflo(rg[i].z)), bfhi(ra[i].z) * sigmoidf_(bfhi(rg[i].z))); o.w = pk2(bflo(ra[i].w) * sigmoidf_(bflo(rg[i].w)), bfhi(ra[i].w) * sigmoidf_(bfhi(rg[i].w)));
                *(LAS u32x4*)(glu + id * 4) = o; } }
        __syncthreads();
        if (tt + NWG < ntiles) CV_LOAD(tt + NWG);
        {
            f32x2 acc[8];
#pragma unroll
            for (int o = 0; o < 8; ++o) acc[o] = cbias;
#pragma unroll
            for (int jj = 0; jj < 38; ++jj) { const unsigned gv = glu[(tg * 8 + jj) * 128 + cp]; const f32x2 v = {bflo(gv), bfhi(gv)};
#pragma unroll
                for (int o = 0; o < 8; ++o) { const int k = jj - o; if (k >= 0 && k < 31) acc[o] += w[k] * v; } }
#pragma unroll
            for (int o = 0; o < 8; ++o) *(LAS f32x2*)(dbuf + (tg * 8 + o) * 256 + 2 * cp) = acc[o];
        }
        {
            const int c8 = (tid & 31) * 8;
#pragma unroll
            for (int q = 0; q < 2; ++q) { const int tl = (tid >> 5) + 16 * q, sj = s0p + tl; const bf16_t* up = U + (size_t)(t0 + tl) * IN_W + c8;
                u32x4 cv[3], xv[3];
#pragma unroll
                for (int d = 0; d < 3; ++d) { cv[d] = (u32x4){0u, 0u, 0u, 0u}; xv[d] = cv[d];
                    if (sj + d - 1 >= 0 && sj + d - 1 < slen) { cv[d] = *(const u32x4*)(up + (d - 1) * IN_W + 1280); xv[d] = *(const u32x4*)(up + (d - 1) * IN_W + 1536); } }
                const u32x4 bv = *(const u32x4*)(up + 1024);
                const f32x4 w0a = *(const f32x4*)(scw + c8), w0b = *(const f32x4*)(scw + c8 + 4), w1a = *(const f32x4*)(scw + 256 + c8), w1b = *(const f32x4*)(scw + 256 + c8 + 4), w2a = *(const f32x4*)(scw + 512 + c8), w2b = *(const f32x4*)(scw + 512 + c8 + 4);
                const float wt[3][8] = {{w0a.x, w0a.y, w0a.z, w0a.w, w0b.x, w0b.y, w0b.z, w0b.w}, {w1a.x, w1a.y, w1a.z, w1a.w, w1b.x, w1b.y, w1b.z, w1b.w}, {w2a.x, w2a.y, w2a.z, w2a.w, w2b.x, w2b.y, w2b.z, w2b.w}};
                float acc[8];
#pragma unroll
                for (int i = 0; i < 8; ++i) acc[i] = 0.f;
#pragma unroll
                for (int d = 0; d < 3; ++d) { const unsigned cw[4] = {cv[d].x, cv[d].y, cv[d].z, cv[d].w}, xw[4] = {xv[d].x, xv[d].y, xv[d].z, xv[d].w};
#pragma unroll
                    for (int i = 0; i < 4; ++i) { acc[2 * i] += wt[d][2 * i] * (bflo(cw[i]) * bflo(xw[i])); acc[2 * i + 1] += wt[d][2 * i + 1] * (bfhi(cw[i]) * bfhi(xw[i])); } }
                const unsigned bw[4] = {bv.x, bv.y, bv.z, bv.w}; u32x4 o;
                o.x = pk2(bflo(bw[0]) * acc[0], bfhi(bw[0]) * acc[1]); o.y = pk2(bflo(bw[1]) * acc[2], bfhi(bw[1]) * acc[3]); o.z = pk2(bflo(bw[2]) * acc[4], bfhi(bw[2]) * acc[5]); o.w = pk2(bflo(bw[3]) * acc[6], bfhi(bw[3]) * acc[7]);
                *(u32x4*)(MIX + (size_t)(t0 + tl) * MIX_W + 512 + c8) = o; }
        }
        __syncthreads();
#pragma unroll
        for (int q = 0; q < 2; ++q) { const int tok = hw * 2 + q;
            const f32x4 v0 = *(const LAS f32x4*)(dbuf + tok * 256 + l32 * 8), v1 = *(const LAS f32x4*)(dbuf + tok * 256 + l32 * 8 + 4);
            float sm = (v0.x + v0.y + v0.z + v0.w) + (v1.x + v1.y + v1.z + v1.w);
            sm += xor_swz<1>(sm); sm += xor_swz<2>(sm); sm += xor_swz<4>(sm); sm += xor_swz<8>(sm); sm += xor_swz<16>(sm);
            const float mean = sm * (1.f / 256.f);
            const f32x4 d0 = v0 - mean, d1 = v1 - mean;
            float vs = (d0.x * d0.x + d0.y * d0.y + d0.z * d0.z + d0.w * d0.w) + (d1.x * d1.x + d1.y * d1.y + d1.z * d1.z + d1.w * d1.w);
            vs += xor_swz<1>(vs); vs += xor_swz<2>(vs); vs += xor_swz<4>(vs); vs += xor_swz<8>(vs); vs += xor_swz<16>(vs);
            const float rstd = rsqrtf(vs * (1.f / 256.f) + EPS);
            const f32x4 g0 = *(const f32x4*)(clg + l32 * 8), g1 = *(const f32x4*)(clg + l32 * 8 + 4), b0 = *(const f32x4*)(clb + l32 * 8), b1 = *(const f32x4*)(clb + l32 * 8 + 4);
            f32x4 y0 = d0 * rstd * g0 + b0, y1 = d1 * rstd * g1 + b1;
            y0.x *= sigmoidf_(y0.x); y0.y *= sigmoidf_(y0.y); y0.z *= sigmoidf_(y0.z); y0.w *= sigmoidf_(y0.w);
            y1.x *= sigmoidf_(y1.x); y1.y *= sigmoidf_(y1.y); y1.z *= sigmoidf_(y1.z); y1.w *= sigmoidf_(y1.w);
            u32x4 o; o.x = pk2(y0.x, y0.y); o.y = pk2(y0.z, y0.w); o.z = pk2(y1.x, y1.y); o.w = pk2(y1.z, y1.w);
            *(u32x4*)(MIX + (size_t)(t0 + tok) * MIX_W + 1024 + l32 * 8) = o; }
    }
#undef CV_LOAD
    __syncthreads();
}

constexpr int FM_LD = 72;
constexpr int FM_WC = 0, FM_WS = 9216, FM_WSN = 18432, FM_X = 27648, FM_GRE = 36864, FM_GIM = 46080, FM_AT = 27648  , FM_OUT = 55296  , FM_OUT3 = 64512  , FM_TW = FM_OUT3 + 2 * 9216  , FM_END = FM_TW + 1024;
__device__ __forceinline__ void fm_tables(LAS unsigned char* lds, int tid) {
    LAS bf16_t* Wc = (LAS bf16_t*)(lds + FM_WC); LAS bf16_t* Ws = (LAS bf16_t*)(lds + FM_WS); LAS bf16_t* Wsn = (LAS bf16_t*)(lds + FM_WSN);
    for (int i = tid; i < 4096; i += NTHR) { const int r = i >> 6, c = i & 63; float sn, cs; sincos_rev((float)((r * c) & 63) * (1.f / 64.f), sn, cs);
        Wc[r * FM_LD + c] = (bf16_t)f2bf(cs); Ws[r * FM_LD + c] = (bf16_t)f2bf(sn); Wsn[r * FM_LD + c] = (bf16_t)f2bf(-sn); }
    __syncthreads();
}
template <bool BSWZ = false>
__device__ __forceinline__ void fm_mm(f32x16& acc, const LAS bf16_t* A, int ar0, const LAS bf16_t* Bt, int br0, int lane) {
    const int r = lane & 31, h = lane >> 5;
#pragma unroll
    for (int k0 = 0; k0 < 64; k0 += 16) {
        const int kg = (k0 >> 3) + h, kb = BSWZ ? ((kg ^ (((br0 + r) >> 3) & 7)) << 3) : (kg << 3);
        const bf16x8 av = *(const LAS bf16x8*)(A + (ar0 + r) * FM_LD + k0 + 8 * h), bv = *(const LAS bf16x8*)(Bt + (br0 + r) * FM_LD + kb);
        acc = __builtin_amdgcn_mfma_f32_32x32x16_bf16(av, bv, acc, 0, 0, 0); }
}
__device__ __forceinline__ int fm_crow(int reg, int h) { return (reg & 3) + 8 * (reg >> 2) + 4 * h; }
template <bool CTXM>
__device__ __forceinline__ void fm12_unit(int unit, const bf16_t* U, bf16_t* F2, LAS unsigned char* lds, int tid) {
    const LAS bf16_t* Wc = (const LAS bf16_t*)(lds + FM_WC); const LAS bf16_t* Ws = (const LAS bf16_t*)(lds + FM_WS); const LAS bf16_t* Wsn = (const LAS bf16_t*)(lds + FM_WSN);
    LAS bf16_t* X = (LAS bf16_t*)(lds + FM_X); LAS bf16_t* Gre = (LAS bf16_t*)(lds + FM_GRE); LAS bf16_t* Gim = (LAS bf16_t*)(lds + FM_GIM);
    int b, g, s2;
    if (!CTXM) { b = unit >> 8; g = (unit >> 6) & 3; s2 = unit & 63; } else { b = unit >> 4; g = (unit >> 2) & 3; s2 = unit & 3; }
    const int lane = tid & 63, wave = tid >> 6, r = lane & 31, h = lane >> 5, part = wave >> 2, tr = (wave >> 1) & 1, tc = wave & 1;
    { const int s1 = tid >> 3, c8 = (tid & 7) * 8;
        const size_t tok = CTXM ? (size_t)NLAT + b * CTXL + (s1 >> 4) * 64 + s2 * 16 + (s1 & 15) : (size_t)b * SEQ + s1 * 64 + s2;
        *(LAS u32x4*)(X + s1 * FM_LD + c8) = *(const u32x4*)(U + tok * IN_W + 1792 + g * 64 + c8); }
    __syncthreads();
    {
        f32x16 acc = {};
        fm_mm(acc, X, tr * 32, part ? Wsn : Wc, tc * 32, lane);
        LAS bf16_t* GT = part ? Gim : Gre;
#pragma unroll
        for (int q = 0; q < 4; ++q) { u32x2 o; o.x = pk2(acc[4 * q], acc[4 * q + 1]); o.y = pk2(acc[4 * q + 2], acc[4 * q + 3]);
            *(LAS u32x2*)(GT + (tc * 32 + r) * FM_LD + tr * 32 + 8 * q + 4 * h) = o; }
    }
    __syncthreads();
    if constexpr (!CTXM) {
    {
        f32x16 acc = {};
        fm_mm(acc, Wc, tr * 32, part ? Gim : Gre, tc * 32, lane);
        fm_mm(acc, part ? Wsn : Ws, tr * 32, part ? Gre : Gim, tc * 32, lane);
        LAS bf16_t* OUT = (LAS bf16_t*)(lds + FM_OUT) + part * 64 * FM_LD;
#pragma unroll
        for (int reg = 0; reg < 16; ++reg) OUT[(tr * 32 + fm_crow(reg, h)) * FM_LD + tc * 32 + r] = (bf16_t)f2bf(acc[reg]);
    }
    __syncthreads();
#pragma unroll
    for (int i = 0; i < 2; ++i) { const int c = tid + NTHR * i, k1 = c >> 4, pt = (c >> 3) & 1, mch = (c & 7) * 8;
        *(u32x4*)(F2 + ((((size_t)(b * 4 + g) * 64 + k1) * 64 + s2) * 2 + pt) * 64 + mch) = *(const LAS u32x4*)((LAS bf16_t*)(lds + FM_OUT) + (pt * 64 + k1) * FM_LD + mch); }
    } else {
        const int k1 = tid >> 7, s2l = (tid >> 3) & 15, m0 = (tid & 7) * 8;
        float re[8], im[8];
#pragma unroll
        for (int q = 0; q < 8; ++q) { re[q] = 0.f; im[q] = 0.f; }
#pragma unroll
        for (int s1 = 0; s1 < 4; ++s1) { const int idx = (16 * s1 * k1) & 63; const float wr = bf2f(Wc[FM_LD + idx]), wi = bf2f(Ws[FM_LD + idx]);
#pragma unroll
            for (int q = 0; q < 8; ++q) { const float gr = bf2f(Gre[(m0 + q) * FM_LD + s1 * 16 + s2l]), gi = bf2f(Gim[(m0 + q) * FM_LD + s1 * 16 + s2l]); re[q] += wr * gr + wi * gi; im[q] += wr * gi - wi * gr; } }
        bf16_t* dst = F2 + (size_t)NLAT * 512 + ((((size_t)(b * 4 + g) * 4 + k1) * 64 + s2 * 16 + s2l) * 2) * 64 + m0;
        u32x4 o; o.x = pk2(re[0], re[1]); o.y = pk2(re[2], re[3]); o.z = pk2(re[4], re[5]); o.w = pk2(re[6], re[7]); *(u32x4*)dst = o;
        o.x = pk2(im[0], im[1]); o.y = pk2(im[2], im[3]); o.z = pk2(im[4], im[5]); o.w = pk2(im[6], im[7]); *(u32x4*)(dst + 64) = o;
    }
}
template <bool CTXM>
__device__ __forceinline__ void fm3_unit(int unit, const bf16_t* F2, bf16_t* MIX, LAS unsigned char* lds, int tid) {
    const LAS bf16_t* Wc = (const LAS bf16_t*)(lds + FM_WC); const LAS bf16_t* Ws = (const LAS bf16_t*)(lds + FM_WS);
    LAS bf16_t* AT = (LAS bf16_t*)(lds + FM_AT);
    constexpr int N1 = CTXM ? 4 : 64; constexpr float NRM = CTXM ? (1.f / 128.f) : (1.f / 512.f);
    int b, g, kp;
    if (!CTXM) { b = unit >> 7; g = (unit >> 5) & 3; kp = unit & 31; } else { b = unit >> 3; g = (unit >> 1) & 3; kp = unit & 1; }
    const bf16_t* F2b = F2 + (CTXM ? (size_t)NLAT * 512 : 0);
    const size_t tok0 = CTXM ? (size_t)NLAT + b * CTXL : (size_t)b * SEQ;
    const int lane = tid & 63, wave = tid >> 6, r = lane & 31, h = lane >> 5;
    LAS f32x2* tw = (LAS f32x2*)(lds + FM_TW);
    if (tid < 128) { const int ki = tid >> 6, s2 = tid & 63; float sn, cs; sincos_rev((float)(s2 * (kp * 2 + ki)) * (1.f / (64.f * N1)), sn, cs); tw[tid] = (f32x2){cs, sn}; }
    __syncthreads();
#pragma unroll
    for (int ki = 0; ki < 2; ++ki) { const bf16_t* img = F2b + (((size_t)(b * 4 + g) * N1 + kp * 2 + ki) * 64) * 128;
        const int s2 = tid >> 3, mch = tid & 7;
        const u32x4 rv = *(const u32x4*)(img + s2 * 128 + mch * 8), iv = *(const u32x4*)(img + s2 * 128 + 64 + mch * 8);
        const f32x2 t = tw[ki * 64 + s2]; const float cs = t.x, sn = t.y;
        const float re[8] = {bflo(rv.x), bfhi(rv.x), bflo(rv.y), bfhi(rv.y), bflo(rv.z), bfhi(rv.z), bflo(rv.w), bfhi(rv.w)};
        const float im[8] = {bflo(iv.x), bfhi(iv.x), bflo(iv.y), bfhi(iv.y), bflo(iv.z), bfhi(iv.z), bflo(iv.w), bfhi(iv.w)};
        const int col = (((s2 >> 3) ^ mch) << 3) | (s2 & 7);
        LAS bf16_t* are = AT + (ki * 2 + 0) * 64 * FM_LD + (mch * 8) * FM_LD + col; LAS bf16_t* aim = AT + (ki * 2 + 1) * 64 * FM_LD + (mch * 8) * FM_LD + col;
#pragma unroll
        for (int q = 0; q < 8; ++q) { are[q * FM_LD] = (bf16_t)f2bf(re[q] * cs + im[q] * sn); aim[q * FM_LD] = (bf16_t)f2bf(im[q] * cs - re[q] * sn); }
    }
    __syncthreads();
    { const int ki = wave >> 2, tr = (wave >> 1) & 1, tc = wave & 1;
        f32x16 acc = {};
        fm_mm<true>(acc, Wc, tr * 32, AT + (ki * 2 + 0) * 64 * FM_LD, tc * 32, lane);
        fm_mm<true>(acc, Ws, tr * 32, AT + (ki * 2 + 1) * 64 * FM_LD, tc * 32, lane);
        LAS bf16_t* OUT = (LAS bf16_t*)(lds + FM_OUT3) + ki * 64 * FM_LD;
#pragma unroll
        for (int reg = 0; reg < 16; ++reg) OUT[(tr * 32 + fm_crow(reg, h)) * FM_LD + tc * 32 + r] = (bf16_t)f2bf(acc[reg] * NRM);
    }
    __syncthreads();
#pragma unroll
    for (int i = 0; i < 2; ++i) { const int c = tid + NTHR * i, ki = c >> 9, k2 = (c >> 3) & 63, mch = (c & 7) * 8;
        *(u32x4*)(MIX + (tok0 + kp * 2 + ki + N1 * k2) * MIX_W + 768 + g * 64 + mch) = *(const LAS u32x4*)((LAS bf16_t*)(lds + FM_OUT3) + (ki * 64 + k2) * FM_LD + mch); }
    __syncthreads();
}

constexpr int N2_SSQ = 0, N2_PART = 1024, N2_LG = N2_PART + 8 * 32 * 33 * 4, N2_HIST = N2_LG + 32 * 33 * 4, N2_TA = 40960, N2_TB = N2_TA + 9 * DM * 4, N2_END = N2_TB + 9 * DM * 4;
static_assert(N2_HIST + 128 <= N2_TA && N2_END <= LDS_FREE, "norm2 LDS");
__device__ __forceinline__ void hilo8(const float (&v)[8], bf16x8& hi, bf16x8& lo) {
    u32x4 H, L;
#pragma unroll
    for (int j = 0; j < 4; ++j) { const unsigned hw = pk2(v[2 * j], v[2 * j + 1]); H[j] = hw; L[j] = pk2(v[2 * j] - bflo(hw), v[2 * j + 1] - bfhi(hw)); }
    hi = __builtin_bit_cast(bf16x8, H); lo = __builtin_bit_cast(bf16x8, L);
}
__device__ __forceinline__ void n2_tables(int l, const Args& a, LAS unsigned char* lds, int t, int nt) {
    const float* mods_l = (const float*)(a.ws + WS_MODS) + (size_t)l * 9 * NMOD; const float* gain = a.in[I_NFFN] + l * DM;
    LAS float* TA = (LAS float*)(lds + N2_TA); LAS float* TB = (LAS float*)(lds + N2_TB); LAS int* hist = (LAS int*)(lds + N2_HIST);
    if (t < NE) hist[t] = 0;
    for (int i = t; i < 9 * DM; i += nt) { const int rr = i >> 10, k = i & 1023; TA[i] = gain[k] * (1.f + mods_l[(size_t)rr * NMOD + 4 * DM + k]); TB[i] = mods_l[(size_t)rr * NMOD + 3 * DM + k]; }
}
template <bool PRE>
__device__ __forceinline__ void ph_norm2(int l, int ntok, const Args& a, LAS unsigned char* lds, int wg, int tid) {
    const int lane = tid & 63, wave = tid >> 6, r = lane & 31, h = lane >> 5;
    unsigned char* ws = a.ws;
    const bf16_t* XA = (const bf16_t*)(ws + WS_XA); unsigned char* H8 = (unsigned char*)(ws + WS_H8);
    const float* mods_l = (const float*)(ws + WS_MODS) + (size_t)l * 9 * NMOD;
    const float* gain = a.in[I_NFFN] + l * DM; const float* rw = a.in[I_RW] + (size_t)l * DM * NE; const float* rb = a.in[I_RB] + l * NE;
    int* tok_e = (int*)(ws + WS_TOKE); float* tok_p = (float*)(ws + WS_TOKP); int* counts = (int*)(ws + WS_CNT);
    LAS float* ssq = (LAS float*)(lds + N2_SSQ); LAS float* part = (LAS float*)(lds + N2_PART); LAS float* lg = (LAS float*)(lds + N2_LG); LAS int* hist = (LAS int*)(lds + N2_HIST);
    LAS float* TA = (LAS float*)(lds + N2_TA); LAS float* TB = (LAS float*)(lds + N2_TB);
    if (!PRE) n2_tables(l, a, lds, tid, NTHR);
    bf16x8 Bhi[8], Blo[8];
#pragma unroll
    for (int s = 0; s < 8; ++s) { float v[8];
#pragma unroll
        for (int j = 0; j < 8; ++j) v[j] = rw[(size_t)(128 * wave + 16 * s + 8 * h + j) * NE + r];
        hilo8(v, Bhi[s], Blo[s]); }
    __syncthreads();
    const int ntile = ntok / 32;
    u32x4 xraw[8];
    if (wg < ntile) { const bf16_t* xr0 = XA + (size_t)(wg * 32 + r) * DM + 128 * wave + 8 * h;
#pragma unroll
        for (int s = 0; s < 8; ++s) xraw[s] = *(const u32x4*)(xr0 + 16 * s); }
    for (int tile = wg; tile < ntile; tile += NWG) {
        const int t = tile * 32 + r;
        f32x4 xv[8][2]; float ss = 0.f;
#pragma unroll
        for (int s = 0; s < 8; ++s) { xv[s][0] = (f32x4){bflo(xraw[s].x), bfhi(xraw[s].x), bflo(xraw[s].y), bfhi(xraw[s].y)}; xv[s][1] = (f32x4){bflo(xraw[s].z), bfhi(xraw[s].z), bflo(xraw[s].w), bfhi(xraw[s].w)}; }
        if (tile + NWG < ntile) { const bf16_t* xrn = XA + (size_t)((tile + NWG) * 32 + r) * DM + 128 * wave + 8 * h;
#pragma unroll
            for (int s = 0; s < 8; ++s) xraw[s] = *(const u32x4*)(xrn + 16 * s); }
#pragma unroll
        for (int s = 0; s < 8; ++s) ss += (xv[s][0].x * xv[s][0].x + xv[s][0].y * xv[s][0].y + xv[s][0].z * xv[s][0].z + xv[s][0].w * xv[s][0].w) + (xv[s][1].x * xv[s][1].x + xv[s][1].y * xv[s][1].y + xv[s][1].z * xv[s][1].z + xv[s][1].w * xv[s][1].w);
        { auto rr = __builtin_amdgcn_permlane32_swap(__float_as_uint(ss), __float_as_uint(ss), false, false); ss = __uint_as_float(rr[0]) + __uint_as_float(rr[1]); }
        if (h == 0) ssq[wave * 32 + r] = ss;
        __syncthreads();
        float tot = 0.f;
#pragma unroll
        for (int w = 0; w < 8; ++w) tot += ssq[w * 32 + r];
        const float rstd = rsqrtf(tot * (1.f / DM) + EPS);
        f32x16 acc = {};
        const LAS float* ta = TA + tok_bidx(tile * 32) * DM + 128 * wave + 8 * h; const LAS float* tb = TB + tok_bidx(tile * 32) * DM + 128 * wave + 8 * h;
#pragma unroll
        for (int s = 0; s < 8; ++s) {
            const f32x4 y0 = (xv[s][0] * rstd) * *(const LAS f32x4*)(ta + 16 * s) + *(const LAS f32x4*)(tb + 16 * s), y1 = (xv[s][1] * rstd) * *(const LAS f32x4*)(ta + 16 * s + 4) + *(const LAS f32x4*)(tb + 16 * s + 4);
            const float v[8] = {y0.x, y0.y, y0.z, y0.w, y1.x, y1.y, y1.z, y1.w};
            u32x2 o8; o8.x = pg8::cvt4_fp8(v[0], v[1], v[2], v[3]); o8.y = pg8::cvt4_fp8(v[4], v[5], v[6], v[7]);
            *(u32x2*)(H8 + (size_t)t * DM + 128 * wave + 16 * s + 8 * h) = o8;
            bf16x8 ahi, alo; hilo8(v, ahi, alo);
            acc = __builtin_amdgcn_mfma_f32_32x32x16_bf16(ahi, Bhi[s], acc, 0, 0, 0);
            acc = __builtin_amdgcn_mfma_f32_32x32x16_bf16(alo, Bhi[s], acc, 0, 0, 0);
            acc = __builtin_amdgcn_mfma_f32_32x32x16_bf16(ahi, Blo[s], acc, 0, 0, 0); }
#pragma unroll
        for (int reg = 0; reg < 16; ++reg) part[(wave * 32 + fm_crow(reg, h)) * 33 + r] = acc[reg];
        __syncthreads();
#pragma unroll
        for (int q = 0; q < 2; ++q) { const int idx = tid + NTHR * q, tk = idx >> 5, e = idx & 31; float sm = rb[e];
#pragma unroll
            for (int w = 0; w < 8; ++w) sm += part[(w * 32 + tk) * 33 + e];
            lg[tk * 33 + e] = sm; }
        __syncthreads();
#pragma unroll
        for (int q = 0; q < 2; ++q) { const int tk = wave * 4 + q * 2 + h;
            float v = lg[tk * 33 + r]; float bv[4]; int be[4];
#pragma unroll
            for (int j = 0; j < 4; ++j) { float m = v;
                m = fmaxf(m, xor_swz<1>(m)); m = fmaxf(m, xor_swz<2>(m)); m = fmaxf(m, xor_swz<4>(m)); m = fmaxf(m, xor_swz<8>(m)); m = fmaxf(m, xor_swz<16>(m));
                const unsigned long long bal = __ballot(v == m); const unsigned mine = (unsigned)(bal >> (32 * h));
                const int idx = __builtin_ctz(mine);
                bv[j] = m; be[j] = idx; if (r == idx) v = -3.0e38f; }
            if (r == 0) { const float e1 = __expf(bv[1] - bv[0]), e2 = __expf(bv[2] - bv[0]), e3 = __expf(bv[3] - bv[0]); const float inv = __builtin_amdgcn_rcpf(1.f + e1 + e2 + e3);
                const int tt = tile * 32 + tk;
                *(int4*)(tok_e + (size_t)tt * 4) = make_int4(be[0], be[1], be[2], be[3]);
                *(float4*)(tok_p + (size_t)tt * 4) = make_float4(inv, e1 * inv, e2 * inv, e3 * inv);
#pragma unroll
                for (int j = 0; j < 4; ++j) atomicAdd((int*)&hist[be[j]], 1); } }
    }
    __syncthreads();
    if (tid < NE) counts[wg * NE + tid] = hist[tid];
}

constexpr int RT_PSUM = 0, RT_PPRE = 2048, RT_TOT = 4096, RT_BASE = 4224, RT_OFF = 4352, RT_POS = 4608;
__device__ __forceinline__ void ph_route(int ntok, const Args& a, LAS unsigned char* lds, int wg, int tid) {
    const int lane = tid & 63, wave = tid >> 6;
    unsigned char* ws = a.ws;
    const int* counts = (const int*)(ws + WS_CNT); int* eoff = (int*)(ws + WS_EOFF);
    const int* tok_e = (const int*)(ws + WS_TOKE); const float* tok_p = (const float*)(ws + WS_TOKP); int* tokpos = (int*)(ws + WS_TOKPOS); float* roww = (float*)(ws + WS_ROWW);
    int* rowtok = (int*)(ws + WS_ROWTOK);
    LAS int* psum = (LAS int*)(lds + RT_PSUM); LAS int* ppre = (LAS int*)(lds + RT_PPRE); LAS int* tot = (LAS int*)(lds + RT_TOT); LAS int* base = (LAS int*)(lds + RT_BASE); LAS int* off = (LAS int*)(lds + RT_OFF); LAS int* posb = (LAS int*)(lds + RT_POS);
    { const int e = tid & 31, part = tid >> 5; int s = 0, pre = 0;
        for (int w = part * 16; w < part * 16 + 16; ++w) { const int c = counts[w * NE + e]; if (w < wg) pre += c; s += c; }
        psum[part * 32 + e] = s; ppre[part * 32 + e] = pre; }
    __syncthreads();
    if (tid < NE) { int s = 0, pre = 0;
        for (int p = 0; p < 16; ++p) { s += psum[p * 32 + tid]; pre += ppre[p * 32 + tid]; }
        tot[tid] = s; base[tid] = pre; }
    __syncthreads();
    if (tid == 0) { int o = 0; for (int e = 0; e < NE; ++e) { off[e] = o; o += (tot[e] + 255) & ~255; } off[NE] = o; }
    __syncthreads();
    if (wg == 0 && tid <= NE) eoff[tid] = off[tid];
    { LAS int* tab = (LAS int*)(lds + LDS_TAB); const int nMt_ = off[NE] >> 8;
        for (int i = tid; i < nMt_; i += NTHR) { const int row = i << 8; int e = 0;
            for (int q = 1; q < NE; ++q) if (off[q] <= row) e = q;
            tab[i] = e; }
        if (tid == 0) tab[LDS_TAB_NMT] = nMt_; }
    const int ntile = ntok / 32, ntw = (ntile - wg + NWG - 1) / NWG, nas = ntw * 128;
#define RT_TOK(ai) ((wg + NWG * ((ai) >> 7)) * 32 + (((ai) >> 2) & 31))
    if (wave == 0) {
        constexpr int MAXCH = 10; static_assert((NTOK / 32 + NWG - 1) / NWG * 128 <= MAXCH * 64, "route chunks");
        if (lane < NE) posb[lane] = off[lane] + base[lane];
        int ev[MAXCH]; float pw[MAXCH];
#pragma unroll
        for (int k = 0; k < MAXCH; ++k) { const int aidx = 64 * k + lane; const bool valid = aidx < nas; const size_t gi = valid ? (size_t)RT_TOK(aidx) * 4 + (aidx & 3) : 0;
            ev[k] = valid ? tok_e[gi] : -1; pw[k] = valid ? tok_p[gi] : 0.f; }
#pragma unroll
        for (int k = 0; k < MAXCH; ++k) if (64 * k < nas) {
            const int e = ev[k], aidx = 64 * k + lane; const bool valid = e >= 0;
            unsigned long long m = __ballot(valid);
#pragma unroll
            for (int b = 0; b < 5; ++b) { const bool bit = (e >> b) & 1; const unsigned long long bb = __ballot(bit); m &= bit ? bb : ~bb; }
            const int rank = (int)__builtin_amdgcn_mbcnt_hi((unsigned)(m >> 32), __builtin_amdgcn_mbcnt_lo((unsigned)m, 0u));
            const int rs = posb[valid ? e : 0];
            if (valid && rank == 0) posb[e] = rs + __popcll(m);
            if (valid) { const size_t gi = (size_t)RT_TOK(aidx) * 4 + (aidx & 3); const int pos = rs + rank; tokpos[gi] = pos; roww[pos] = pw[k]; rowtok[pos] = RT_TOK(aidx); } }
    }
    if (wg < NE) { const int p0 = off[wg] + tot[wg], p1 = off[wg + 1]; for (int p = p0 + tid; p < p1; p += NTHR) rowtok[p] = 0; }
#undef RT_TOK
}
__device__ __forceinline__ int moe_tiles(const unsigned char* ws, LAS unsigned char* lds, int tid) {
    const int* eoff = (const int*)(ws + WS_EOFF); LAS int* tab = (LAS int*)(lds + LDS_TAB);
    const int total = eoff[NE];
    const int nMt = total >> 8;
    for (int i = tid; i < nMt; i += NTHR) { const int row = i << 8; int e = 0;
        for (int q = 1; q < NE; ++q) if (eoff[q] <= row) e = q;
        tab[i] = e; }
    __syncthreads();
    return __builtin_amdgcn_readfirstlane(nMt);
}

__device__ __forceinline__ f32x4 fp8x4_to_f32(unsigned w) {
    const f32x2 lo = __builtin_amdgcn_cvt_pk_f32_fp8((int)w, false), hi = __builtin_amdgcn_cvt_pk_f32_fp8((int)w, true);
    return (f32x4){lo.x, lo.y, hi.x, hi.y};
}
constexpr int CB_G2 = 0, CB_SH = 9 * DM * 4, CB_SC = 2 * 9 * DM * 4, CB_GN = 3 * 9 * DM * 4, CB_END = CB_GN + DM * 4;
static_assert(CB_END <= LDS_FREE, "combine LDS");
__device__ __forceinline__ void fp8x16_acc(f32x4 (&acc)[4], const u32x4 y) {
    const unsigned w[4] = {y.x, y.y, y.z, y.w};
#pragma unroll
    for (int i = 0; i < 4; ++i) { const f32x2 lo = __builtin_amdgcn_cvt_pk_f32_fp8((int)w[i], false), hi = __builtin_amdgcn_cvt_pk_f32_fp8((int)w[i], true); acc[i] += (f32x4){lo.x, lo.y, hi.x, hi.y}; }
}
__device__ __forceinline__ void cb_tables(int l, const Args& a, LAS unsigned char* lds, int t, int nt) {
    const float* mods_l = (const float*)(a.ws + WS_MODS) + (size_t)l * 9 * NMOD; const bool more = l < DEPTH - 1;
    LAS float* Lg2 = (LAS float*)(lds + CB_G2); LAS float* Lsh = (LAS float*)(lds + CB_SH); LAS float* Lsc = (LAS float*)(lds + CB_SC); LAS float* Lgn = (LAS float*)(lds + CB_GN);
    for (int i = t; i < 9 * DM; i += nt) { const int r = i >> 10, k = i & 1023;
        Lg2[i] = mods_l[(size_t)r * NMOD + 5 * DM + k] * YR_INV;
        if (more) { Lsh[i] = mods_l[(size_t)(9 + r) * NMOD + k]; Lsc[i] = mods_l[(size_t)(9 + r) * NMOD + DM + k] + 1.f; } }
    for (int i = t; i < DM; i += nt) Lgn[i] = more ? a.in[I_NMIX][(l + 1) * DM + i] : a.in[I_FN][i];
}
template <bool PRE>
__device__ __forceinline__ void ph_combine(int l, int ntok, const Args& a, LAS unsigned char* lds, int gw, int NGW, int tid) {
    const int lane = tid & 63;
    unsigned char* ws = a.ws;
    const bf16_t* XA = (const bf16_t*)(ws + WS_XA); bf16_t* XB = (bf16_t*)(ws + WS_XB); const unsigned char* YR = (const unsigned char*)(ws + WS_YR);
    const int* tokpos = (const int*)(ws + WS_TOKPOS);
    const float* mods_l = (const float*)(ws + WS_MODS) + (size_t)l * 9 * NMOD;
    const bool more = l < DEPTH - 1;
    LAS float* Lg2 = (LAS float*)(lds + CB_G2); LAS float* Lsh = (LAS float*)(lds + CB_SH); LAS float* Lsc = (LAS float*)(lds + CB_SC); LAS float* Lgn = (LAS float*)(lds + CB_GN);
    if (!PRE) cb_tables(l, a, lds, tid, NTHR);
    __syncthreads();
    bf16_t* HA = (bf16_t*)(ws + WS_HA); unsigned char* HA8 = ws + WS_HA8;
    const int k0 = 16 * lane;
    for (int t0 = gw * 2; t0 < ntok; t0 += NGW * 2) {
        u32x4 y[2][4], xr[2][2];
#pragma unroll
        for (int r = 0; r < 2; ++r) { const int t = t0 + r; const int4 pp = *(const int4*)(tokpos + (size_t)t * 4);
            y[r][0] = *(const u32x4*)(YR + (size_t)pp.x * DM + k0); y[r][1] = *(const u32x4*)(YR + (size_t)pp.y * DM + k0);
            y[r][2] = *(const u32x4*)(YR + (size_t)pp.z * DM + k0); y[r][3] = *(const u32x4*)(YR + (size_t)pp.w * DM + k0);
            xr[r][0] = *(const u32x4*)(XA + (size_t)t * DM + k0); xr[r][1] = *(const u32x4*)(XA + (size_t)t * DM + k0 + 8); }
#pragma unroll
        for (int r = 0; r < 2; ++r) { const int t = t0 + r, bi = tok_bidx(t);
            int kt = k0; asm volatile("" : "+v"(kt));
            f32x4 ff[4] = {{0.f, 0.f, 0.f, 0.f}, {0.f, 0.f, 0.f, 0.f}, {0.f, 0.f, 0.f, 0.f}, {0.f, 0.f, 0.f, 0.f}};
            fp8x16_acc(ff, y[r][0]); fp8x16_acc(ff, y[r][1]); fp8x16_acc(ff, y[r][2]); fp8x16_acc(ff, y[r][3]);
            const unsigned xw[8] = {xr[r][0].x, xr[r][0].y, xr[r][0].z, xr[r][0].w, xr[r][1].x, xr[r][1].y, xr[r][1].z, xr[r][1].w};
            f32x4 v[4]; float ss = 0.f;
#pragma unroll
            for (int j = 0; j < 4; ++j) { const f32x4 xv = {bflo(xw[2 * j]), bfhi(xw[2 * j]), bflo(xw[2 * j + 1]), bfhi(xw[2 * j + 1])};
                v[j] = xv + *(const LAS f32x4*)(Lg2 + bi * DM + kt + 4 * j) * ff[j];
                ss += v[j].x * v[j].x + v[j].y * v[j].y + v[j].z * v[j].z + v[j].w * v[j].w; }
            const float rstd = rsqrtf(wave_sum(ss) * (1.f / DM) + EPS);
            if (more) {
                u32x4 xo[2], ho[2]; unsigned h8[4];
#pragma unroll
                for (int j = 0; j < 4; ++j) { const f32x4 y2 = (v[j] * rstd * *(const LAS f32x4*)(Lgn + kt + 4 * j)) * *(const LAS f32x4*)(Lsc + bi * DM + kt + 4 * j) + *(const LAS f32x4*)(Lsh + bi * DM + kt + 4 * j);
                    xo[j >> 1][(j & 1) * 2] = pk2(v[j].x, v[j].y); xo[j >> 1][(j & 1) * 2 + 1] = pk2(v[j].z, v[j].w);
                    ho[j >> 1][(j & 1) * 2] = pk2(y2.x, y2.y); ho[j >> 1][(j & 1) * 2 + 1] = pk2(y2.z, y2.w); h8[j] = pg8::cvt4_fp8(y2.x, y2.y, y2.z, y2.w); }
                *(u32x4*)(XB + (size_t)t * DM + k0) = xo[0]; *(u32x4*)(XB + (size_t)t * DM + k0 + 8) = xo[1];
                *(u32x4*)(HA + (size_t)t * DM + k0) = ho[0]; *(u32x4*)(HA + (size_t)t * DM + k0 + 8) = ho[1];
                *(u32x4*)(HA8 + (size_t)t * DM + k0) = (u32x4){h8[0], h8[1], h8[2], h8[3]};
            } else {
#pragma unroll
                for (int j = 0; j < 4; ++j) *(f32x4*)(a.out + (size_t)t * DM + k0 + 4 * j) = v[j] * rstd * *(const LAS f32x4*)(Lgn + kt + 4 * j);
            } }
    }
    __syncthreads();
}

constexpr int PH_PER_LAYER = 10, N_PHASES = 1 + DEPTH * PH_PER_LAYER;
#if MK_ONE_LAUNCH
#define GRID_BAR() do { XcdBarrier b_ = bar; asm volatile("" : "+s"(b_.bar), "+s"(b_.x)); xcd_barrier(b_, [](int, int) {}); } while (0)
#define GRID_BAR_W(...) do { XcdBarrier b_ = bar; asm volatile("" : "+s"(b_.bar), "+s"(b_.x)); xcd_barrier(b_, [&](int t_, int nt_) { __VA_ARGS__; }); } while (0)
#else
#define GRID_BAR() do {} while (0)
#define GRID_BAR_W(...) do {} while (0)
#endif
#define IN(k) (lo <= (k) && (k) < hi)
#define BOTH(k) (IN(k) && IN((k) + 1))
#define REPEAT(R) _Pragma("unroll") for (int rp_ = 0; rp_ < (R); ++rp_)
#define GWAVE() (wg * NWAVES + wv)
#define ptid() ptid_w(wv)
template <int LAYER>
__device__ __forceinline__ void layer_phases(LAS unsigned char* lds, unsigned char* lds_raw, const XcdBarrier& bar, int lo, int hi, int wg, int G, int wv) {
        constexpr int l = LAYER, pb = 1 + PH_PER_LAYER * l;
        constexpr bool last = (l == DEPTH - 1);
        constexpr int ntok_l = last ? NLAT : NTOK;

        if (IN(pb + 0) && l == 0) { REPEAT(REP_NORM1) { const Args a = load_args();
                const float* xlat = (l == 0) ? a.in[I_X] : (const float*)(a.ws + WS_XB);
                const float* xctx = (l == 0) ? a.in[I_CTX] : (const float*)(a.ws + WS_XB) + (size_t)NLAT * DM;
                ph_norm1(xlat, xctx, a.in[I_NMIX] + l * DM, (const float*)(a.ws + WS_MODS) + (size_t)l * 9 * NMOD, (bf16_t*)(a.ws + WS_HA), a.ws + WS_HA8, GWAVE(), G * NWAVES, ptid() & 63); }
            if (BOTH(pb + 0)) GRID_BAR(); }

        if (IN(pb + 1)) {
            const Args a = load_args();
            REPEAT(REP_GEMM) {
            { pg8::Gemm g{a.ws + WS_HA8, a.ws + WS_WIN8 + (size_t)l * IN_W * DM, DM};
                constexpr int G8 = last ? 256 : 208;
                pg8::SchedSub<4> S; S.G = (G == 256) ? G8 : G; S.c = wg; S.first = 0; S.cfirst = last ? 2 : 0; S.nctx = last ? 2 : 4; S.rev = false;
                pg8::EpiStoreBf16 E{(bf16_t*)(a.ws + WS_U), IN_W, W8_INV};
                if (wg < S.G) pg8::gemm_phase<true>(lds, g, S, E, ptid()); }
            { pg8::Gemm g{a.ws + WS_HA, (const bf16_t*)(a.ws + WS_WIN) + (size_t)l * IN_W * DM, DM * 2};
                pg8::SchedSub<6> S; S.G = G; S.c = wg; S.first = 4; S.cfirst = 4; S.nctx = last ? 0 : 6; S.rev = true;
                pg8::EpiStoreBf16 E{(bf16_t*)(a.ws + WS_U), IN_W, 1.f};
                pg8::gemm_phase<false>(lds, g, S, E, ptid()); }
            }
            if (BOTH(pb + 1)) GRID_BAR();
        }

        if (IN(pb + 2)) REPEAT(REP_PREP) {
            const Args a = load_args();
            ph_qkv(l, a, lds, wg, ptid());
            ph_conv_tiles(l, a, lds, wg, ptid());
            const bf16_t* U = (const bf16_t*)(a.ws + WS_U); bf16_t* F2 = (bf16_t*)(a.ws + WS_F2);
            fm_tables(lds, ptid());
            if (!last && wg >= 128) fm12_unit<true>(wg - 128, U, F2, lds, ptid());
            for (int u = wg; u < 2048; u += G) fm12_unit<false>(u, U, F2, lds, ptid());
            __syncthreads();
            if (rp_ + 1 == REP_PREP && BOTH(pb + 2)) GRID_BAR();
        }

        if (IN(pb + 3)) REPEAT(REP_ATTN) {
            const Args a = load_args();
            const unsigned char* QB = a.ws + WS_QB; const unsigned char* KB = a.ws + WS_KB; const unsigned char* VT = a.ws + WS_VB; bf16_t* MIX = (bf16_t*)(a.ws + WS_MIX);
            const int x = wg & 7, rk = wg >> 3;
            const int nun = (!last && wg < 32) ? 3 : 2;
            for (int i = 0; i < nun; ++i) {
                int b, h, kvh, seq; size_t trow;
                if (i < 2) { const int set = i * 8 + x; b = set >> 1; kvh = set & 1; h = kvh * 2 + (rk >> 4); trow = (size_t)b * SEQ + (rk & 15) * 256; seq = SKV; }
                else { b = wg >> 2; h = wg & 3; kvh = h >> 1; trow = (size_t)NLAT + b * CTXL; seq = CTXL; }
                att8::attn_body<512, MIX_W>(QB + trow * 512 + h * 128, KB + (size_t)(b * 2 + kvh) * SKV * 128, VT + (size_t)(b * 2 + kvh) * SKV * 128, MIX + trow * MIX_W + h * 128, seq, (char*)lds_raw, ptid()); }
            const bf16_t* F2 = (const bf16_t*)(a.ws + WS_F2);
            fm_tables(lds, ptid());
            if (!last && wg >= 192) fm3_unit<true>(wg - 192, F2, MIX, lds, ptid());
            for (int u = wg; u < 1024; u += G) fm3_unit<false>(u, F2, MIX, lds, ptid());
            if (rp_ + 1 == REP_ATTN && BOTH(pb + 3)) GRID_BAR();
        }

        if (IN(pb + 4)) {
            const Args a = load_args();
            pg8::Gemm g{a.ws + WS_MIX, (const bf16_t*)(a.ws + WS_WOUT) + (size_t)l * DM * MIX_W, MIX_W * 2};
            pg8::SchedGrid<4> S; S.G = G; S.c = wg; S.nM = ntok_l / 256;
            const float* gate = (const float*)(a.ws + WS_MODS) + (size_t)l * 9 * NMOD + 2 * DM;
            if (l == 0) { pg8::EpiResidual<false> E{a.in[I_X], a.in[I_CTX], (bf16_t*)(a.ws + WS_XA), gate};
                REPEAT(REP_GEMM) pg8::gemm_phase<false>(lds, g, S, E, ptid());
                if (G == NWG && wg >= 32) { const int t_ = ptid(); p0_items(a, lds, (wg - 32) * NWAVES + (t_ >> 6), (NWG - 32) * NWAVES, P0_ITEMS - P0_DEFER, P0_ITEMS, t_); __syncthreads(); }
                else if (G != NWG) { const int t_ = ptid(); p0_items(a, lds, wg * NWAVES + (t_ >> 6), G * NWAVES, P0_ITEMS - P0_DEFER, P0_ITEMS, t_); __syncthreads(); } }
            else { pg8::EpiResidual<true> E{a.ws + WS_XB, a.ws + WS_XB + (size_t)NLAT * DM * 2, (bf16_t*)(a.ws + WS_XA), gate};
                REPEAT(REP_GEMM) pg8::gemm_phase<false>(lds, g, S, E, ptid()); }
            if (BOTH(pb + 4)) GRID_BAR_W(n2_tables(l, load_args(), lds, t_, nt_));
        }

        if (IN(pb + 5)) { REPEAT(REP_N2) { const Args a = load_args(); ph_norm2<MK_ONE_LAUNCH != 0>(l, ntok_l, a, lds, wg, ptid()); __syncthreads(); } if (BOTH(pb + 5)) GRID_BAR(); }
        if (IN(pb + 6)) { REPEAT(REP_ROUTE) { const Args a = load_args(); ph_route(ntok_l, a, lds, wg, ptid()); __syncthreads(); } if (BOTH(pb + 6)) GRID_BAR(); }

        if (IN(pb + 7)) {
            const Args a = load_args();
#if MK_ONE_LAUNCH
            const int nMt = __builtin_amdgcn_readfirstlane(((const LAS int*)(lds + LDS_TAB))[LDS_TAB_NMT]);
#else
            const int nMt = moe_tiles(a.ws, lds, ptid());
#endif
            { const int* rowtok = (const int*)(a.ws + WS_ROWTOK); LAS int* ltok = (LAS int*)(lds + LDS_LTOK); const int t_ = ptid();
                const int nun = (nMt * 8 - wg + G - 1) / G;
                for (int idx = t_; idx < nun * 256; idx += NTHR) { int pm, pn; pg8::tile_order<8>((idx >> 8) * G + wg, nMt, pm, pn); ltok[idx] = rowtok[pm * 256 + (idx & 255)]; }
                __syncthreads(); }
            pg8::Gemm g{a.ws + WS_H8, a.ws + WS_WUP + (size_t)l * NE * 2048 * DM, DM};
            pg8::SchedMoe<8, true> S{G, wg, nMt, (const LAS int*)(lds + LDS_TAB), (const LAS int*)(lds + LDS_LTOK)};
            pg8::EpiSwiGLU E{(unsigned char*)(a.ws + WS_ACT), a.in[I_BUP] + (size_t)l * NE * 2048};
            REPEAT(REP_MOE) pg8::gemm_phase<true>(lds, g, S, E, ptid());
            if (BOTH(pb + 7)) GRID_BAR();
        }
        if (IN(pb + 8)) {
            const Args a = load_args();
#if MK_ONE_LAUNCH
            const int nMt = __builtin_amdgcn_readfirstlane(((const LAS int*)(lds + LDS_TAB))[LDS_TAB_NMT]);
#else
            const int nMt = moe_tiles(a.ws, lds, ptid());
#endif
            pg8::Gemm g{a.ws + WS_ACT, a.ws + WS_WDN + (size_t)l * NE * DM * DFF, DFF};
            pg8::SchedMoe<4, false> S{G, wg, nMt, (const LAS int*)(lds + LDS_TAB), nullptr};
            pg8::EpiDown E{(unsigned char*)(a.ws + WS_YR), a.in[I_BDN] + (size_t)l * NE * DM, (const float*)(a.ws + WS_ROWW)};
            REPEAT(REP_MOE) pg8::gemm_phase<true>(lds, g, S, E, ptid());
            if (BOTH(pb + 8)) GRID_BAR_W(cb_tables(l, load_args(), lds, t_, nt_));
        }
        if (IN(pb + 9)) { REPEAT(REP_COMB) { const Args a = load_args(); ph_combine<MK_ONE_LAUNCH != 0>(l, ntok_l, a, lds, GWAVE(), G * NWAVES, ptid()); } if (BOTH(pb + 9)) GRID_BAR(); }
}

__global__ void __launch_bounds__(NTHR, 2) mk_fwd(Args a_kernarg) {
    extern __shared__ __attribute__((aligned(16))) unsigned char lds_raw[];
    LAS unsigned char* lds = (LAS unsigned char*)lds_raw;
    const int wg = blockIdx.x, G = gridDim.x, wv = __builtin_amdgcn_readfirstlane(threadIdx.x >> 6);
    volatile LAS unsigned* lctl = (volatile LAS unsigned*)(lds + LDS_CTL);
    if (threadIdx.x < 64) lctl[threadIdx.x] = 0u;
    __syncthreads();
#if MK_ONE_LAUNCH
    XcdBarrier bar = xcd_barrier_post((unsigned*)(a_kernarg.ws + WS_CTL) + 4096, lctl);
#else
    XcdBarrier bar; bar.bar = nullptr; bar.x = 0; bar.st = nullptr;
#endif
    const int lo = a_kernarg.ph_lo, hi = a_kernarg.ph_hi;
    if (IN(0)) { REPEAT(REP_P0) { const Args a = load_args(); p0_prologue(a, lds, wg, ptid()); __syncthreads(); } if (BOTH(0)) GRID_BAR(); }

    layer_phases<0>(lds, lds_raw, bar, lo, hi, wg, G, wv);
    layer_phases<1>(lds, lds_raw, bar, lo, hi, wg, G, wv);
}

extern "C" void kernel_launch(void* const* d_in, const int* in_sizes, int n_in, void* d_out, int out_size, void* d_ws, size_t ws_size, hipStream_t stream) {
    static int ok = 0;
    if (ok == 0) {
        if (n_in != 24 || in_sizes[0] != NLAT * DM || out_size != NLAT * DM || ws_size < WS_END) {
            fprintf(stderr, "kernel_launch: shape mismatch (n_in %d, in0 %d, out %d, ws %zu; need ws >= %zu)\n", n_in, n_in > 0 ? in_sizes[0] : -1, out_size, ws_size, (size_t)WS_END); ok = -1; return; }
        if (hipFuncSetAttribute((const void*)mk_fwd, hipFuncAttributeMaxDynamicSharedMemorySize, LDS_BYTES) != hipSuccess) { fprintf(stderr, "kernel_launch: hipFuncSetAttribute failed\n"); ok = -1; return; }
        int per_cu = 0;
        if (hipOccupancyMaxActiveBlocksPerMultiprocessor(&per_cu, (const void*)mk_fwd, NTHR, LDS_BYTES) != hipSuccess || per_cu < 1)
            fprintf(stderr, "kernel_launch: note: occupancy query reports %d workgroups per CU\n", per_cu);
        (void)hipGetLastError();
        ok = 1;
    }
    if (ok < 0) return;
    if (hipMemsetAsync((char*)d_ws + WS_CTL, 0, CTL_ZERO_BYTES, stream) != hipSuccess) { fprintf(stderr, "kernel_launch: memset failed\n"); return; }
    Args a{};
    for (int i = 0; i < 24; ++i) a.in[i] = (const float*)d_in[i];
    a.out = (float*)d_out; a.ws = (unsigned char*)d_ws;
#if MK_ONE_LAUNCH
    a.ph_lo = 0; a.ph_hi = N_PHASES;
    hipLaunchKernelGGL(mk_fwd, dim3(NWG), dim3(NTHR), LDS_BYTES, stream, a);
#else
    for (int p = 0; p < N_PHASES; ++p) { a.ph_lo = p; a.ph_hi = p + 1; hipLaunchKernelGGL(mk_fwd, dim3(NWG), dim3(NTHR), LDS_BYTES, stream, a); }
#endif
    const hipError_t le = hipPeekAtLastError();
    if (le != hipSuccess) fprintf(stderr, "kernel_launch: launch failed: %s\n", hipGetErrorName(le));
}
```

```cpp
#include <hip/hip_runtime.h>
#include <cstdio>
#include <cstdint>

#ifndef MK_ONE_LAUNCH
#define MK_ONE_LAUNCH 1
#endif

#ifndef REP_P0
#define REP_P0 1
#endif
#ifndef REP_NORM1
#define REP_NORM1 1
#endif
#ifndef REP_PREP
#define REP_PREP 1
#endif
#ifndef REP_N2
#define REP_N2 1
#endif
#ifndef REP_ROUTE
#define REP_ROUTE 1
#endif
#ifndef REP_COMB
#define REP_COMB 1
#endif
#ifndef REP_GEMM
#define REP_GEMM 1
#endif
#ifndef REP_ATTN
#define REP_ATTN 1
#endif
#ifndef REP_MOE
#define REP_MOE 1
#endif
#define LAS __attribute__((address_space(3)))
#define GAS __attribute__((address_space(1)))
typedef unsigned short bf16_t;
typedef short bf16x8 __attribute__((ext_vector_type(8)));
typedef short s16x4 __attribute__((ext_vector_type(4)));
typedef float f32x2 __attribute__((ext_vector_type(2)));
typedef float f32x4 __attribute__((ext_vector_type(4)));
typedef float f32x8 __attribute__((ext_vector_type(8)));
typedef float f32x16 __attribute__((ext_vector_type(16)));
typedef unsigned u32x2 __attribute__((ext_vector_type(2)));
typedef unsigned u32x4 __attribute__((ext_vector_type(4)));

constexpr int DM = 1024, BATCH = 8, SEQ = 4096, CTXL = 256, DEPTH = 2;
constexpr int NLAT = BATCH * SEQ, NCTX = BATCH * CTXL, NTOK = NLAT + NCTX;
constexpr int IN_W = 2560, MIX_W = 1280, NE = 32, TOPK = 4, DFF = 1024;
constexpr int SKV = CTXL + SEQ;
constexpr int NMOD = 6 * DM;
constexpr int MPAD = (NTOK * TOPK / 256 + NE) * 256;
constexpr float EPS = 1e-6f;
constexpr int NWG = 256, NTHR = 512, NWAVES = 8;

constexpr size_t MiB = 1u << 20;
constexpr size_t WS_CTL = 0, CTL_ZERO_BYTES = 1 * MiB;
constexpr size_t WS_MODS = 1 * MiB;
constexpr size_t WS_CNT = 2 * MiB;
constexpr size_t WS_EOFF = WS_CNT + 64 * 1024;
constexpr size_t WS_TOKE = 3 * MiB;
constexpr size_t WS_TOKP = 4 * MiB;
constexpr size_t WS_TOKPOS = 5 * MiB;
constexpr size_t WS_ROWW = 6 * MiB;
constexpr size_t WS_ROWTOK = 7 * MiB;
constexpr size_t WS_WIN = 8 * MiB;
constexpr size_t WS_WOUT = 18 * MiB;
constexpr size_t WS_WUP = 24 * MiB;
constexpr size_t WS_WDN = 152 * MiB;
constexpr size_t WS_H8 = 216 * MiB;
constexpr size_t WS_HA8 = 252 * MiB;
constexpr size_t WS_WIN8 = 288 * MiB;
constexpr size_t WS_HA = 408 * MiB;
constexpr size_t WS_XA = 476 * MiB;
constexpr size_t WS_XB = 612 * MiB;
constexpr size_t WS_S = 748 * MiB;
constexpr size_t WS_U = WS_S;
constexpr size_t WS_QB = WS_S + 170 * MiB;
constexpr size_t WS_KB = WS_S + 204 * MiB;
constexpr size_t WS_VB = WS_S + 221 * MiB;
constexpr size_t WS_MIX = WS_S + 238 * MiB;
constexpr size_t WS_F2 = WS_S + 323 * MiB;
constexpr size_t WS_ACT = WS_S + 360 * MiB;
constexpr size_t WS_YR = WS_S;
constexpr size_t WS_END = WS_S + 648 * MiB;
static_assert(WS_F2 + (size_t)NTOK * 512 * 2 <= WS_ACT && WS_YR + (size_t)MPAD * 1024 * 2 <= WS_ACT && WS_H8 + (size_t)NTOK * 1024 <= WS_HA && WS_WDN + 2ull * 32 * 1024 * 1024 <= WS_H8, "ws map");
constexpr float YR_SCALE = 16.f, YR_INV = 1.f / 16.f;
constexpr float W8_SCALE = 64.f, W8_INV = 1.f / 64.f;

constexpr int LDS_BYTES = 163840;
constexpr int LDS_LTOK = 131072;
constexpr int LDS_TAB = 159744;
constexpr int LDS_TAB_NMT = 700;
constexpr int LDS_CTL = 163584;
constexpr int LDS_FREE = 159744;

typedef float f32x2_t_ __attribute__((ext_vector_type(2)));
typedef __bf16 bf16x2_t_ __attribute__((ext_vector_type(2)));
__device__ __forceinline__ unsigned f2bf(float f) { const __bf16 b = (__bf16)f; return (unsigned)__builtin_bit_cast(unsigned short, b); }
__device__ __forceinline__ unsigned pk2(float lo, float hi) { const f32x2_t_ v = {lo, hi}; const bf16x2_t_ b = __builtin_convertvector(v, bf16x2_t_); return __builtin_bit_cast(unsigned, b); }
__device__ __forceinline__ float bf2f(unsigned h) { return __builtin_bit_cast(float, h << 16); }
__device__ __forceinline__ float bflo(unsigned w) { return __builtin_bit_cast(float, w << 16); }
__device__ __forceinline__ float bfhi(unsigned w) { return __builtin_bit_cast(float, w & 0xffff0000u); }
template <int M> __device__ __forceinline__ float xor_swz(float v) { return __builtin_bit_cast(float, __builtin_amdgcn_ds_swizzle(__builtin_bit_cast(int, v), (M << 10) | 0x1f)); }
__device__ __forceinline__ float xor32(float v, bool upper) { auto r = __builtin_amdgcn_permlane32_swap(__float_as_uint(v), __float_as_uint(v), false, false); return __uint_as_float(upper ? r[0] : r[1]); }
__device__ __forceinline__ float wave_sum(float v) {
    v += xor_swz<1>(v); v += xor_swz<2>(v); v += xor_swz<4>(v); v += xor_swz<8>(v); v += xor_swz<16>(v);
    auto r = __builtin_amdgcn_permlane32_swap(__float_as_uint(v), __float_as_uint(v), false, false);
    return __uint_as_float(r[0]) + __uint_as_float(r[1]);
}
__device__ __forceinline__ float sigmoidf_(float x) { return __builtin_amdgcn_rcpf(1.f + __builtin_amdgcn_exp2f(x * -1.4426950408889634f)); }
__device__ __forceinline__ void sincos_rev(float rev, float& sn, float& cs) { const float fr = __builtin_amdgcn_fractf(rev); sn = __builtin_amdgcn_sinf(fr); cs = __builtin_amdgcn_cosf(fr); }
__device__ __forceinline__ int tok_bidx(int t) { return t < NLAT ? (t >> 12) : 8; }
#define LDS_WAIT() asm volatile("s_waitcnt lgkmcnt(0)" ::: "memory")

__device__ __forceinline__ int ptid_w(int wv) { unsigned m = ~0u; asm volatile("" : "+s"(m)); int l = (int)__builtin_amdgcn_mbcnt_hi(m, __builtin_amdgcn_mbcnt_lo(m, 0u)); asm volatile("" : "+v"(l)); return (wv << 6) | l; }

namespace pg8 {
#define PG8_LAS __attribute__((address_space(3)))
constexpr int BM = 256, BK = 64, HALF = 128, HTB = HALF * BK * 2, STAGE_BYTES = 8 * HTB;
__host__ __device__ __forceinline__ int lds_byte(int r, int c) { const int st = (r >> 4) * 2 + (c >> 5), rr = r & 15, cc = c & 31, ob = rr * 64 + cc * 2; return st * 1024 + (ob ^ (((ob >> 9) & 1) << 5)); }
__host__ __device__ __forceinline__ void stage_rc(int b, int& R, int& C) { const int st = b / 1024, sb = b % 1024, swz = sb ^ (((sb >> 9) & 1) << 5); R = (st >> 1) * 16 + swz / 64; C = (st & 1) * 32 + (swz % 64) / 2; }
__host__ __device__ __forceinline__ int perm32(int rho) { const int n = rho >> 4, i = rho & 15; return 8 * (i >> 2) + 4 * n + (i & 3); }
__host__ __device__ __forceinline__ int perm64(int R) { return (R >> 5) * 64 + ((R >> 2) & 3) * 16 + ((R >> 4) & 1) * 4 + (R & 3); }
struct Unit { int pm, pn; };
struct Gemm { const void* A; const void* Bt; int Kb; };
__device__ __forceinline__ unsigned cvt_pk_bf16(float lo, float hi) { unsigned r; asm volatile("v_cvt_pk_bf16_f32 %0, %1, %2" : "=v"(r) : "v"(lo), "v"(hi)); return r; }
typedef int v8i __attribute__((ext_vector_type(8)));
typedef int v4i __attribute__((ext_vector_type(4)));
__device__ __forceinline__ v8i cat8(bf16x8 a, bf16x8 b) { const v4i x = __builtin_bit_cast(v4i, a), y = __builtin_bit_cast(v4i, b); return (v8i){x[0], x[1], x[2], x[3], y[0], y[1], y[2], y[3]}; }
__device__ __forceinline__ unsigned cvt4_fp8(float a, float b, float c, float d) { int r = 0; r = __builtin_amdgcn_cvt_pk_fp8_f32(a, b, r, false); r = __builtin_amdgcn_cvt_pk_fp8_f32(c, d, r, true); return (unsigned)r; }

template <int nN>
__device__ __forceinline__ void tile_order(int L, int nM, int& pm, int& pn) {
    const int nwg = nM * nN; int wgid = L;
    { const int q = nwg >> 3, r = nwg & 7, xcd = wgid & 7, off = wgid >> 3; wgid = (xcd < r ? xcd * (q + 1) : r * (q + 1) + (xcd - r) * q) + off; }
    constexpr int nig = 8 * nN; const int gid = wgid / nig, fm = gid * 8, gsz = (nM - fm) < 8 ? (nM - fm) : 8, rem = wgid - gid * nig;
    if (gsz == 8) { pm = fm + (rem & 7); pn = rem >> 3; } else { pn = rem / gsz; pm = fm + (rem - pn * gsz); }
}

template <bool FP8, class Epi, class Sched>
__device__ __forceinline__ void gemm_phase(PG8_LAS unsigned char* lds, const Gemm g, const Sched& S, const Epi& E, const int tid) {
    const int wid = __builtin_amdgcn_readfirstlane(tid >> 6), lane = tid & 63, wr = wid >> 2, wc = wid & 3, fr = lane & 15, fq = lane >> 4;
    const int Kb = g.Kb, nt = Kb / (BK * 2);
    constexpr bool GATHER = Sched::GATHER;
    unsigned voffA[2], voffB[2]; int rcA[2];
#pragma unroll
    for (int i = 0; i < 2; ++i) { int R, C; stage_rc(tid * 16 + i * 8192, R, C); const int Rb = Epi::PERM == 2 ? perm64(R) : Epi::PERM ? ((R & ~31) + perm32(R & 31)) : R;
        voffA[i] = (unsigned)(R * Kb + C * 2); voffB[i] = (unsigned)(Rb * Kb + C * 2); rcA[i] = (R << 8) | (C * 2); }
    unsigned gc[2][2];
#define PG8_GOFF(uidx) do { if constexpr (GATHER) { _Pragma("unroll") for (int h_ = 0; h_ < 2; ++h_) _Pragma("unroll") for (int i_ = 0; i_ < 2; ++i_) \
        gc[h_][i_] = (unsigned)S.ltok[(uidx) * 256 + h_ * 128 + (rcA[i_] >> 8)] * (unsigned)Kb + (unsigned)(rcA[i_] & 255); } } while (0)
#define PG8_STAGE_A(bufoff, kptr, half) do { if constexpr (GATHER) PG8_STAGE(bufoff, kptr, gc[half]); else PG8_STAGE(bufoff, (kptr) + (half) * hstep, voffA); } while (0)
    const size_t kstep = (size_t)(BK * 2);
    const size_t hstep = (size_t)HALF * Kb;
    const size_t tstep = 2 * hstep;
    const size_t hstepB = Epi::PERM == 2 ? (size_t)8 * Kb : hstep;
    const unsigned ldsw = (unsigned)wid * 1024u;
    const int aoff = lds_byte(wr * 64 + fr, fq * 8), boff = lds_byte(wc * 32 + fr, fq * 8);
#define PG8_SA(b, h) (((b) * 2 + (h)) * HTB)
#define PG8_SB(b, h) ((4 + (b) * 2 + (h)) * HTB)
#define PG8_STAGE(bufoff, gbase, voff) do { _Pragma("unroll") for (int _i = 0; _i < 2; ++_i) { unsigned _vo = (voff)[_i]; asm volatile("" : "+v"(_vo));   \
        __builtin_amdgcn_global_load_lds((const unsigned*)((const char*)(gbase) + _vo), (PG8_LAS unsigned*)(lds + (bufoff) + ldsw + _i * 8192), 16, 0, 0); } } while (0)
#define PG8_LDA(dst, b, h) do { _Pragma("unroll") for (int m = 0; m < 4; ++m) _Pragma("unroll") for (int k = 0; k < 2; ++k) dst[m][k] = *(const PG8_LAS bf16x8*)(lds + PG8_SA(b, h) + aoff + m * 2048 + k * 1024); } while (0)
#define PG8_LDB(dst, b, h) do { _Pragma("unroll") for (int n = 0; n < 2; ++n) _Pragma("unroll") for (int k = 0; k < 2; ++k) dst[n][k] = *(const PG8_LAS bf16x8*)(lds + PG8_SB(b, h) + boff + n * 2048 + k * 1024); } while (0)
#define PG8_MMA(ai, bj, At, Bt) do { __builtin_amdgcn_s_setprio(1); _Pragma("unroll") for (int m = 0; m < 4; ++m) _Pragma("unroll") for (int n = 0; n < 2; ++n) { \
        if constexpr (FP8) acc[ai][bj][m][n] = __builtin_amdgcn_mfma_scale_f32_16x16x128_f8f6f4(cat8(Bt[n][0], Bt[n][1]), cat8(At[m][0], At[m][1]), acc[ai][bj][m][n], 0, 0, 0, 0, 0, 0); \
        else { _Pragma("unroll") for (int k = 0; k < 2; ++k) acc[ai][bj][m][n] = __builtin_amdgcn_mfma_f32_16x16x32_bf16(Bt[n][k], At[m][k], acc[ai][bj][m][n], 0, 0, 0); } } \
        __builtin_amdgcn_s_setprio(0); } while (0)
#define PG8_WAIT_V(n) asm volatile("s_waitcnt vmcnt(" #n ")" ::: "memory")
#define PG8_WAIT_L(n) asm volatile("s_waitcnt lgkmcnt(" #n ")" ::: "memory")
#define PG8_BAR __builtin_amdgcn_s_barrier()
#define PG8_SCHED __builtin_amdgcn_sched_barrier(0)
    Unit cur, nxt; int ui = 0;
    if (!S.next(0, cur)) return;
    f32x4 acc[2][2][4][2];
#pragma unroll
    for (int a = 0; a < 2; ++a)
#pragma unroll
        for (int b = 0; b < 2; ++b)
#pragma unroll
            for (int m = 0; m < 4; ++m)
#pragma unroll
                for (int n = 0; n < 2; ++n) acc[a][b][m][n] = (f32x4){0.f, 0.f, 0.f, 0.f};
    bf16x8 At[4][2], B0[2][2], B1[2][2];
    const char* cA = (const char*)g.A + (GATHER ? (size_t)0 : (size_t)cur.pm * tstep); const char* cB = (const char*)g.Bt + (size_t)cur.pn * tstep;
    PG8_GOFF(0);
    PG8_STAGE(PG8_SB(0, 0), cB, voffB); PG8_STAGE(PG8_SB(0, 1), cB + hstepB, voffB); PG8_STAGE_A(PG8_SA(0, 0), cA, 0); PG8_STAGE_A(PG8_SA(0, 1), cA, 1);
    if (wr == 1) PG8_BAR;
    PG8_WAIT_V(2); PG8_BAR;
    PG8_STAGE(PG8_SB(1, 0), cB + kstep, voffB); PG8_STAGE_A(PG8_SA(1, 0), cA + kstep, 0); PG8_STAGE(PG8_SB(1, 1), cB + hstepB + kstep, voffB);
    PG8_WAIT_V(6); PG8_BAR;
    for (;;) {
        const bool has_next = S.next(ui + 1, nxt);
        const char* nA = (has_next && !GATHER) ? (const char*)g.A + (size_t)nxt.pm * tstep : cA; const char* nB = has_next ? (const char*)g.Bt + (size_t)nxt.pn * tstep : cB;
        for (int t = 0; t < nt; t += 2) {
            const bool last = (t == nt - 2);
            const char* a1 = cA + (size_t)(t + 1) * kstep;
            const char* a2 = last ? nA : cA + (size_t)(t + 2) * kstep; const char* b2 = last ? nB : cB + (size_t)(t + 2) * kstep;
            const char* a3 = a2 + kstep; const char* b3 = b2 + kstep;
            PG8_LDB(B0, 0, 0); PG8_LDB(B1, 0, 1); PG8_SCHED; PG8_LDA(At, 0, 0); PG8_STAGE_A(PG8_SA(1, 1), a1, 1); if (last && has_next) PG8_GOFF(ui + 1);
            PG8_WAIT_V(8); PG8_WAIT_L(0); PG8_BAR; PG8_MMA(0, 0, At, B0); PG8_MMA(0, 1, At, B1); PG8_BAR; PG8_SCHED;
            PG8_LDA(At, 0, 1); PG8_STAGE(PG8_SB(0, 0), b2, voffB); PG8_STAGE(PG8_SB(0, 1), b2 + hstepB, voffB); PG8_STAGE_A(PG8_SA(0, 0), a2, 0);
            PG8_WAIT_V(8); PG8_WAIT_L(0); PG8_BAR; PG8_MMA(1, 0, At, B0); PG8_MMA(1, 1, At, B1); PG8_BAR; PG8_SCHED;
            PG8_LDB(B0, 1, 0); PG8_LDB(B1, 1, 1); PG8_SCHED; PG8_LDA(At, 1, 0); PG8_STAGE_A(PG8_SA(0, 1), a2, 1);
            PG8_WAIT_V(8); PG8_WAIT_L(0); PG8_BAR; PG8_MMA(0, 0, At, B0); PG8_MMA(0, 1, At, B1); PG8_BAR; PG8_SCHED;
            PG8_LDA(At, 1, 1); PG8_STAGE(PG8_SB(1, 0), b3, voffB); PG8_STAGE(PG8_SB(1, 1), b3 + hstepB, voffB); PG8_STAGE_A(PG8_SA(1, 0), a3, 0);
            PG8_WAIT_V(8); PG8_WAIT_L(0); PG8_BAR; PG8_MMA(1, 0, At, B0); PG8_MMA(1, 1, At, B1); PG8_BAR; PG8_SCHED;
        }
        if (wr == 0) PG8_BAR;
        { const int l2 = ptid_w(wid) & 63; E(acc, cur, wr, wc, l2 & 15, l2 >> 4); }
        if (!has_next) break;
#pragma unroll
        for (int a = 0; a < 2; ++a)
#pragma unroll
            for (int b = 0; b < 2; ++b)
#pragma unroll
                for (int m = 0; m < 4; ++m)
#pragma unroll
                    for (int n = 0; n < 2; ++n) acc[a][b][m][n] = (f32x4){0.f, 0.f, 0.f, 0.f};
        cur = nxt; cA = nA; cB = nB; ++ui;
        if (wr == 1) PG8_BAR;
    }
    PG8_WAIT_V(0);
    PG8_BAR;
#undef PG8_SA
#undef PG8_SB
#undef PG8_STAGE
#undef PG8_STAGE_A
#undef PG8_GOFF
#undef PG8_LDA
#undef PG8_LDB
#undef PG8_MMA
#undef PG8_WAIT_V
#undef PG8_WAIT_L
#undef PG8_BAR
#undef PG8_SCHED
}

struct EpiStoreBf16 {
    static constexpr int PERM = 2;
    bf16_t* O; int ldc; float sc;
    __device__ __forceinline__ void operator()(const f32x4 (&acc)[2][2][4][2], const Unit& u, int wr, int wc, int fr, int fq) const {
        const int row0 = u.pm * BM + wr * 64 + fr, col0 = u.pn * BM + wc * 64 + 16 * fq;
#pragma unroll
        for (int ai = 0; ai < 2; ++ai)
#pragma unroll
            for (int m = 0; m < 4; ++m) { bf16_t* rowp = O + (size_t)(row0 + ai * HALF + m * 16) * ldc + col0;
#pragma unroll
                for (int bj = 0; bj < 2; ++bj) { const f32x4 v0 = acc[ai][bj][m][0] * sc, v1 = acc[ai][bj][m][1] * sc;
                    u32x4 w; w.x = cvt_pk_bf16(v0[0], v0[1]); w.y = cvt_pk_bf16(v0[2], v0[3]); w.z = cvt_pk_bf16(v1[0], v1[1]); w.w = cvt_pk_bf16(v1[2], v1[3]);
                    *(u32x4*)(rowp + bj * 8) = w; } }
    }
};
template <bool XBF16>
struct EpiResidual {
    static constexpr int PERM = 2;
    const void* xlat; const void* xctx; bf16_t* out; const float* gate;
    __device__ __forceinline__ void operator()(const f32x4 (&acc)[2][2][4][2], const Unit& u, int wr, int wc, int fr, int fq) const {
        const int row0 = u.pm * BM + wr * 64 + fr, col0 = u.pn * BM + wc * 64 + 16 * fq;
        const int bidx = (u.pm < NLAT / 256) ? (u.pm >> 4) : 8;
        const float* gp = gate + (size_t)bidx * NMOD + col0;
        f32x4 gv[2][2];
#pragma unroll
        for (int bj = 0; bj < 2; ++bj)
#pragma unroll
            for (int n = 0; n < 2; ++n) gv[bj][n] = *(const f32x4*)(gp + bj * 8 + 4 * n);
#pragma unroll
        for (int ai = 0; ai < 2; ++ai)
#pragma unroll
            for (int m = 0; m < 4; ++m) { const int row = row0 + ai * HALF + m * 16;
                bf16_t* orow = out + (size_t)row * DM + col0;
#pragma unroll
                for (int bj = 0; bj < 2; ++bj) { f32x4 x0, x1;
                    if constexpr (XBF16) { const bf16_t* xr = (row < NLAT ? (const bf16_t*)xlat + (size_t)row * DM : (const bf16_t*)xctx + (size_t)(row - NLAT) * DM) + col0 + bj * 8;
                        const u32x4 xb = *(const u32x4*)xr; x0 = (f32x4){bflo(xb.x), bfhi(xb.x), bflo(xb.y), bfhi(xb.y)}; x1 = (f32x4){bflo(xb.z), bfhi(xb.z), bflo(xb.w), bfhi(xb.w)}; }
                    else { const float* xr = (row < NLAT ? (const float*)xlat + (size_t)row * DM : (const float*)xctx + (size_t)(row - NLAT) * DM) + col0 + bj * 8;
                        x0 = *(const f32x4*)xr; x1 = *(const f32x4*)(xr + 4); }
                    const f32x4 v0 = x0 + gv[bj][0] * acc[ai][bj][m][0], v1 = x1 + gv[bj][1] * acc[ai][bj][m][1];
                    u32x4 w; w.x = cvt_pk_bf16(v0[0], v0[1]); w.y = cvt_pk_bf16(v0[2], v0[3]); w.z = cvt_pk_bf16(v1[0], v1[1]); w.w = cvt_pk_bf16(v1[2], v1[3]);
                    *(u32x4*)(orow + bj * 8) = w; } }
    }
};
struct EpiSwiGLU {
    static constexpr int PERM = 1;
    unsigned char* O; const float* bup;
    __device__ __forceinline__ void operator()(const f32x4 (&acc)[2][2][4][2], const Unit& u, int wr, int wc, int fr, int fq) const {
        const int e = u.pn >> 3, pnl = u.pn & 7;
        const int row0 = u.pm * BM + wr * 64 + fr, ac0 = pnl * 128 + wc * 32 + 8 * fq;
        const float* bp = bup + (size_t)e * 2048 + 2 * ac0;
        f32x4 bb[4];
#pragma unroll
        for (int q = 0; q < 4; ++q) bb[q] = *(const f32x4*)(bp + 4 * q);
        f32x2 bg[4], bl[4];
#pragma unroll
        for (int p = 0; p < 4; ++p) { bg[p] = (f32x2){bb[p][0], bb[p][2]}; bl[p] = (f32x2){bb[p][1] + 1.f, bb[p][3] + 1.f}; }
        unsigned char* cbase = O + (size_t)(row0 + (fq & 1) * 16) * DFF + (ac0 - 8 * (fq & 1));
#pragma unroll
        for (int ai = 0; ai < 2; ++ai)
#pragma unroll
            for (int mp = 0; mp < 2; ++mp) { u32x2 wq[2];
#pragma unroll
                for (int mi = 0; mi < 2; ++mi) { const int m = 2 * mp + mi;
                    float r[8];
#pragma unroll
                    for (int p = 0; p < 4; ++p) { const int n = p >> 1, i0 = (p & 1) * 2;
                        f32x2 gt = (f32x2){acc[ai][0][m][n][i0], acc[ai][0][m][n][i0 + 1]} * W8_INV + bg[p];
                        f32x2 ln = (f32x2){acc[ai][1][m][n][i0], acc[ai][1][m][n][i0 + 1]} * W8_INV + bl[p];
                        gt.x = fminf(gt.x, 7.f); gt.y = fminf(gt.y, 7.f);
                        ln.x = __builtin_amdgcn_fmed3f(ln.x, -6.f, 8.f); ln.y = __builtin_amdgcn_fmed3f(ln.y, -6.f, 8.f);
                        const f32x2 ex = gt * (-1.702f * 1.4426950408889634f);
                        f32x2 dn = (f32x2){__builtin_amdgcn_exp2f(ex.x), __builtin_amdgcn_exp2f(ex.y)} + 1.f;
                        dn.x = __builtin_amdgcn_rcpf(dn.x); dn.y = __builtin_amdgcn_rcpf(dn.y);
                        const f32x2 rr = (gt * dn) * ln;
                        r[2 * p] = rr.x; r[2 * p + 1] = rr.y; }
                    wq[mi].x = cvt4_fp8(r[0], r[1], r[2], r[3]); wq[mi].y = cvt4_fp8(r[4], r[5], r[6], r[7]); }
                const auto s0 = __builtin_amdgcn_permlane16_swap(wq[0].x, wq[1].x, false, false), s1 = __builtin_amdgcn_permlane16_swap(wq[0].y, wq[1].y, false, false);
                u32x4 w; w.x = s0[0]; w.y = s1[0]; w.z = s0[1]; w.w = s1[1];
                *(u32x4*)(cbase + (size_t)(ai * HALF + mp * 32) * DFF) = w; }
    }
};
struct EpiDown {
    static constexpr int PERM = 2;
    unsigned char* O; const float* bdn; const float* roww;
    __device__ __forceinline__ void operator()(const f32x4 (&acc)[2][2][4][2], const Unit& u, int wr, int wc, int fr, int fq) const {
        const int e = u.pn >> 2, pnl = u.pn & 3;
        const int row0 = u.pm * BM + wr * 64 + fr, col0 = pnl * BM + wc * 64 + 16 * fq;
        const float* bp = bdn + (size_t)e * DM + col0;
        f32x4 bv[2][2];
#pragma unroll
        for (int bj = 0; bj < 2; ++bj)
#pragma unroll
            for (int n = 0; n < 2; ++n) bv[bj][n] = *(const f32x4*)(bp + 8 * bj + 4 * n);
        float rwv[2][4];
#pragma unroll
        for (int ai = 0; ai < 2; ++ai)
#pragma unroll
            for (int m = 0; m < 4; ++m) rwv[ai][m] = roww[row0 + ai * HALF + m * 16] * YR_SCALE;
#pragma unroll
        for (int ai = 0; ai < 2; ++ai)
#pragma unroll
            for (int m = 0; m < 4; ++m) { const int row = row0 + ai * HALF + m * 16; const float w_ = rwv[ai][m];
                const f32x4 v0 = (acc[ai][0][m][0] * W8_INV + bv[0][0]) * w_, v1 = (acc[ai][0][m][1] * W8_INV + bv[0][1]) * w_;
                const f32x4 v2 = (acc[ai][1][m][0] * W8_INV + bv[1][0]) * w_, v3 = (acc[ai][1][m][1] * W8_INV + bv[1][1]) * w_;
                u32x4 w; w.x = cvt4_fp8(v0[0], v0[1], v0[2], v0[3]); w.y = cvt4_fp8(v1[0], v1[1], v1[2], v1[3]); w.z = cvt4_fp8(v2[0], v2[1], v2[2], v2[3]); w.w = cvt4_fp8(v3[0], v3[1], v3[2], v3[3]);
                *(u32x4*)(O + (size_t)row * DM + col0) = w; }
    }
};

template <int NS>
struct SchedSub {
    static constexpr bool GATHER = false; const LAS int* ltok = nullptr;
    int G, c, first, cfirst, nctx; bool rev;
    __device__ __forceinline__ bool next(int i, Unit& u) const {
        const int L = i * G + (rev ? G - 1 - c : c);
        if (L < 128 * NS) { int j; tile_order<NS>(L, 128, u.pm, j); u.pn = first + j; return true; }
        const int r = L - 128 * NS; if (r >= 8 * nctx) return false;
        const int q = (nctx == 2) ? (r >> 1) : (nctx == 4) ? (r >> 2) : (r / 6);
        u.pm = 128 + q; u.pn = cfirst + (r - q * nctx); return true;
    }
};
template <int nN>
struct SchedGrid {
    static constexpr bool GATHER = false; const LAS int* ltok = nullptr;
    int G, c, nM;
    __device__ __forceinline__ bool next(int i, Unit& u) const {
        const int L = i * G + c; if (L >= nM * nN) return false;
        tile_order<nN>(L, nM, u.pm, u.pn); return true;
    }
};
template <int nN, bool GATHER_>
struct SchedMoe {
    static constexpr bool GATHER = GATHER_;
    int G, c, nMt; const LAS int* tile_e; const LAS int* ltok;
    __device__ __forceinline__ bool next(int i, Unit& u) const {
        const int L = i * G + c; if (L >= nMt * nN) return false;
        int pm, pn; tile_order<nN>(L, nMt, pm, pn);
        const int e = __builtin_amdgcn_readfirstlane(tile_e[pm]);
        u.pm = pm; u.pn = e * nN + pn; return true;
    }
};
}

namespace att { __device__ __forceinline__ unsigned cvtpk(float lo, float hi) { unsigned r; asm volatile("v_cvt_pk_bf16_f32 %0, %1, %2" : "=v"(r) : "v"(lo), "v"(hi)); return r; } }
namespace att8 {
typedef int v8i __attribute__((ext_vector_type(8)));
typedef int v4i __attribute__((ext_vector_type(4)));
constexpr int NW = 8, QBLK = 32, KVBLK = 64;
constexpr float SCALE = 0.088388347648318440f;
constexpr float QSC = SCALE * 1.4426950408889634f;
constexpr float THR = 3.f;
constexpr float THR2 = THR * 1.4426950408889634f;
constexpr int NSLOT = 4, SLOT = 8192;
constexpr int OFF_K = 0, OFF_V = NSLOT * SLOT, OFF_WS = 2 * NSLOT * SLOT, OFF_OST = OFF_WS + 2048;
static_assert(OFF_OST + 8 * 8704 <= 163840 - 256, "att8 LDS");
__device__ __forceinline__ int crow(int r, int hi) { return (r & 3) + 8 * (r >> 2) + 4 * hi; }
__host__ __device__ __forceinline__ int kpos(int k) { const int kk = k & 31, up = k >> 5, hi = (kk >> 2) & 1, r = (kk & 3) + 4 * (kk >> 3); return 32 * hi + 16 * up + r; }
__device__ __forceinline__ v8i ld32(const char* p) { const v4i a = *(const v4i*)p, b = *(const v4i*)(p + 16); return (v8i){a[0], a[1], a[2], a[3], b[0], b[1], b[2], b[3]}; }
__device__ __forceinline__ f32x16 mma8(v8i a, v8i b, f32x16 c) { return __builtin_amdgcn_mfma_scale_f32_32x32x64_f8f6f4(a, b, c, 0, 0, 0, 0, 0, 0); }

template <bool FIRST>
__device__ __forceinline__ void partialSM(f32x16& p0, f32x16& p1, f32x16& negm, float& alpha) {
  float pmax = p0[0]; for (int r = 1; r < 16; ++r) pmax = fmaxf(pmax, p0[r]); for (int r = 0; r < 16; ++r) pmax = fmaxf(pmax, p1[r]);
  { auto rr = __builtin_amdgcn_permlane32_swap(__float_as_uint(pmax), __float_as_uint(pmax), false, false);
    pmax = fmaxf(__uint_as_float(rr[0]), __uint_as_float(rr[1])); }
  const float d = pmax - 4.f;
  if (!FIRST && __builtin_expect(__all(d <= THR2), 1)) alpha = 1.f;
  else { const float dl = FIRST ? d : fmaxf(d, 0.f); alpha = __builtin_amdgcn_exp2f(-dl);
    for (int r = 0; r < 16; ++r) { p0[r] -= dl; p1[r] -= dl; negm[r] -= dl; } }
  for (int r = 0; r < 16; ++r) p0[r] = __builtin_amdgcn_exp2f(p0[r]);
}
__device__ __forceinline__ void finishA(f32x16& p1) { for (int r = 0; r < 16; ++r) p1[r] = __builtin_amdgcn_exp2f(p1[r]); }
__device__ __forceinline__ void finishB(f32x16& p0, f32x16& p1, v8i& pa, float& lsum) {
  { float t0 = p0[0] + p1[0], t1 = p0[1] + p1[1], t2 = p0[2] + p1[2], t3 = p0[3] + p1[3];
#pragma unroll
    for (int r = 4; r < 16; r += 4) { t0 += p0[r] + p1[r]; t1 += p0[r + 1] + p1[r + 1]; t2 += p0[r + 2] + p1[r + 2]; t3 += p0[r + 3] + p1[r + 3]; }
    lsum += (t0 + t1) + (t2 + t3); }
#pragma unroll
  for (int w = 0; w < 4; ++w) { int a = pa[w], b = pa[4 + w];
    a = __builtin_amdgcn_cvt_pk_fp8_f32(p0[4 * w], p0[4 * w + 1], a, false); a = __builtin_amdgcn_cvt_pk_fp8_f32(p0[4 * w + 2], p0[4 * w + 3], a, true);
    b = __builtin_amdgcn_cvt_pk_fp8_f32(p1[4 * w], p1[4 * w + 1], b, false); b = __builtin_amdgcn_cvt_pk_fp8_f32(p1[4 * w + 2], p1[4 * w + 3], b, true);
    pa[w] = a; pa[4 + w] = b; }
}
struct KFrag { v8i a0, a1, a2, a3; };
__device__ __forceinline__ v8i ld2(const char* p, int o0, int o1) { const v4i a = *(const v4i*)(p + o0), b = *(const v4i*)(p + o1); return (v8i){a[0], a[1], a[2], a[3], b[0], b[1], b[2], b[3]}; }
__device__ __forceinline__ void kf_load(KFrag& f, const char* Ks, const int (&ka)[4]) {
  f.a0 = ld2(Ks, ka[0], ka[1]); f.a1 = ld2(Ks + 4096, ka[0], ka[1]); f.a2 = ld2(Ks, ka[2], ka[3]); f.a3 = ld2(Ks + 4096, ka[2], ka[3]);
}
__device__ __forceinline__ void qkt(f32x16& p0, f32x16& p1, const f32x16& negm, const KFrag& f, const v8i* qr) {
  p0 = mma8(f.a0, qr[0], negm); p1 = mma8(f.a1, qr[0], negm); p0 = mma8(f.a2, qr[1], p0); p1 = mma8(f.a3, qr[1], p1);
}
struct VFrag { v8i b0, b1, b2, b3; };
__device__ __forceinline__ void pv_load(VFrag& f, const char* Vs, const int (&va)[2]) {
  f.b0 = ld2(Vs, va[0], va[1]); f.b1 = ld2(Vs + 2048, va[0], va[1]); f.b2 = ld2(Vs + 4096, va[0], va[1]); f.b3 = ld2(Vs + 6144, va[0], va[1]);
}
__device__ __forceinline__ void pv(f32x16* o, const VFrag& f, v8i pa) {
  o[0] = mma8(pa, f.b0, o[0]); o[1] = mma8(pa, f.b1, o[1]); o[2] = mma8(pa, f.b2, o[2]); o[3] = mma8(pa, f.b3, o[3]);
}
template <int LDQ, int LDO>
__device__ __forceinline__ void attn_body(const unsigned char* __restrict__ Qb, const unsigned char* __restrict__ Kh, const unsigned char* __restrict__ VTh, bf16_t* __restrict__ Ob, int seq, char* lds, const int tid) {
  const int wid = tid >> 6, lane = tid & 63, r32 = lane & 31, hi = lane >> 5;
  char* V_lds = lds + OFF_V; char* K_lds = lds + OFF_K;
  float* ws = (float*)(lds + OFF_WS) + wid * 64; float* al_l = ws + 32;
  f32x16 o[4] = {}; float lsum = 0.f; v8i qr[2]; f32x16 negm;
#pragma unroll
  for (int r = 0; r < 16; ++r) negm[r] = 0.f;
  { const char* Qw = (const char*)Qb + (long)(wid * QBLK + r32) * LDQ + 32 * hi;
#pragma unroll
    for (int st = 0; st < 2; ++st) qr[st] = ld32(Qw + 64 * st); }
  unsigned kgoff, vgoff;
  { const int kr = wid * 8 + (lane >> 3), vr = wid * 16 + (lane >> 2);
    kgoff = (unsigned)(kr * 128 + (((lane & 7) ^ ((kr >> 1) & 7)) << 4)); vgoff = (unsigned)(vr * 64 + (((lane & 3) ^ ((vr >> 2) & 3)) << 4)); }
  int ka[4], va[2];
  { const int xk = (r32 >> 1) & 7, xv = (r32 >> 2) & 3;
#pragma unroll
    for (int c = 0; c < 4; ++c) ka[c] = r32 * 128 + (((4 * (c >> 1) + 2 * hi + (c & 1)) ^ xk) << 4);
#pragma unroll
    for (int c = 0; c < 2; ++c) va[c] = r32 * 64 + (((2 * hi + c) ^ xv) << 4); }
  const unsigned ldsw = (unsigned)__builtin_amdgcn_readfirstlane(wid) * 1024u;
#define DMA(t) do { const int t_ = (t); const unsigned so_ = (unsigned)(t_ & (NSLOT - 1)) * SLOT + ldsw; unsigned ko_ = kgoff, vo_ = vgoff; asm volatile("" : "+v"(ko_), "+v"(vo_)); \
    __builtin_amdgcn_global_load_lds((const unsigned*)(Kh + (size_t)t_ * SLOT + ko_), (LAS unsigned*)(lds + OFF_K + so_), 16, 0, 0); \
    __builtin_amdgcn_global_load_lds((const unsigned*)(VTh + (size_t)t_ * SLOT + vo_), (LAS unsigned*)(lds + OFF_V + so_), 16, 0, 0); } while (0)
#define WAITV2() asm volatile("s_waitcnt vmcnt(2)" ::: "memory")
#define BARX() __builtin_amdgcn_s_barrier()
#define RESC(a) do { if (__any((a) < 1.f)) { if (hi == 0) al_l[r32] = (a); asm volatile("s_waitcnt lgkmcnt(0)" ::: "memory"); \
    lsum *= (a); for (int r = 0; r < 16; ++r) { const float f_ = al_l[crow(r, hi)]; for (int d = 0; d < 4; ++d) o[d][r] *= f_; } } } while (0)
#define SBAR8() __builtin_amdgcn_sched_barrier(0)
  f32x16 pA0, pA1, pB0, pB1; float alA, alB; v8i pa = {}; const int NT = seq / KVBLK;
  DMA(0); DMA(1); WAITV2(); BARX();
  KFrag kf; kf_load(kf, K_lds, ka); qkt(pA0, pA1, negm, kf, qr); partialSM<true>(pA0, pA1, negm, alA);
  DMA(2 < NT ? 2 : NT - 1); WAITV2(); BARX();
  VFrag vf;
#define STEP(pN0, pN1, pO0, pO1, jj, alN) do { const int j_ = (jj); \
    SBAR8(); kf_load(kf, K_lds + (j_ & (NSLOT - 1)) * SLOT, ka); SBAR8(); \
    finishA(pO1); SBAR8(); \
    qkt(pN0, pN1, negm, kf, qr); SBAR8(); \
    pv_load(vf, V_lds + ((j_ - 1) & (NSLOT - 1)) * SLOT, va); SBAR8(); \
    finishB(pO0, pO1, pa, lsum); SBAR8(); \
    DMA(j_ + 2 < NT ? j_ + 2 : NT - 1); SBAR8();     \
    pv(o, vf, pa); partialSM<false>(pN0, pN1, negm, alN); \
    RESC(alN); WAITV2(); BARX(); } while (0)
  for (int j = 1; j + 1 < NT; j += 2) {
    STEP(pB0, pB1, pA0, pA1, j, alB);
    STEP(pA0, pA1, pB0, pB1, j + 1, alA);
  }
  STEP(pB0, pB1, pA0, pA1, NT - 1, alB);
  pv_load(vf, V_lds + ((NT - 1) & (NSLOT - 1)) * SLOT, va);
  finishA(pB1); finishB(pB0, pB1, pa, lsum); SBAR8();
  pv(o, vf, pa);
#undef STEP
  float rli[16];
  { auto rr = __builtin_amdgcn_permlane32_swap(__float_as_uint(lsum), __float_as_uint(lsum), false, false);
    const float rl = __builtin_amdgcn_rcpf(__uint_as_float(rr[0]) + __uint_as_float(rr[1]));
    if (hi == 0) al_l[r32] = rl; asm volatile("s_waitcnt lgkmcnt(0)" ::: "memory");
#pragma unroll
    for (int r = 0; r < 16; ++r) rli[r] = al_l[crow(r, hi)]; }
  { char* ost = lds + OFF_OST + wid * (32 * 272);
#pragma unroll
    for (int r = 0; r < 16; ++r) { const int orow = crow(r, hi);
#pragma unroll
      for (int d0 = 0; d0 < 4; ++d0) *(bf16_t*)(ost + orow * 272 + (d0 * 32 + r32) * 2) = (bf16_t)att::cvtpk(o[d0][r] * rli[r], 0.f); }
    asm volatile("s_waitcnt lgkmcnt(0)" ::: "memory");
    bf16_t* Ow = Ob + (long)(wid * QBLK) * LDO;
#pragma unroll
    for (int i = 0; i < 8; ++i) { const int idx = lane + 64 * i, row = idx >> 4, ch = idx & 15;
      *(u32x4*)(Ow + (long)row * LDO + ch * 8) = *(const u32x4*)(ost + row * 272 + ch * 16); } }
  asm volatile("s_waitcnt vmcnt(0)" ::: "memory");
  __syncthreads();
#undef DMA
#undef WAITV2
#undef BARX
#undef RESC
#undef SBAR8
}
}

#define XB_TMO      128
#define XB_XCNT(j)  (256  + 64 * (j))
#define XB_XSUB(j)  (1280 + 64 * (j))
#define XB_XGEN(j)  (2304 + 64 * (j))
#define XB_TOP      3328
#define XB_TOPGEN   3392
#define XCD_BAR_WORDS 3456
#define XB_SPIN_CAP (1u << 18)
__device__ __forceinline__ unsigned xb_ld(unsigned* p)              { return __hip_atomic_load(p, __ATOMIC_RELAXED, __HIP_MEMORY_SCOPE_AGENT); }
__device__ __forceinline__ unsigned xb_add(unsigned* p, unsigned v) { return __hip_atomic_fetch_add(p, v, __ATOMIC_RELAXED, __HIP_MEMORY_SCOPE_AGENT); }
__device__ __forceinline__ unsigned xb_xcc_id() { return (unsigned)__builtin_amdgcn_s_getreg((3 << 11) | 20) & 0xFu; }
#define XB_SPIN(cond, bar) do { unsigned _sp = 0; while (cond) { __builtin_amdgcn_s_sleep(1); \
    if ((++_sp & 255u) == 0u) { if (xb_ld(&(bar)[XB_TMO])) break; if (_sp > XB_SPIN_CAP) { atomicAdd(&(bar)[XB_TMO], 1u); break; } } } } while (0)
struct XcdBarrier { unsigned* bar; unsigned x; volatile LAS unsigned* st; };
__device__ __forceinline__ XcdBarrier xcd_barrier_post(unsigned* bar, volatile LAS unsigned* st) {
    XcdBarrier b; b.bar = bar; b.x = xb_xcc_id(); b.st = st;
    if (threadIdx.x == 0) (void)xb_add(&bar[XB_XCNT(b.x)], 1u);
    return b;
}
__device__ __forceinline__ void xcd_barrier_complete(unsigned* bar, unsigned x, unsigned& nloc, unsigned& nx) {
    const unsigned G = gridDim.x * gridDim.y * gridDim.z;
    unsigned sum, cnt, mine, sp = 0u;
    for (;;) {
        sum = 0u; cnt = 0u; mine = 0u;
#pragma unroll
        for (unsigned j = 0; j < 16; ++j) { const unsigned c = xb_ld(&bar[XB_XCNT(j)]); sum += c; cnt += (c > 0u) ? 1u : 0u; mine = (j == x) ? c : mine; }
        if (sum == G) break;
        __builtin_amdgcn_s_sleep(1);
        if ((++sp & 255u) == 0u) { if (xb_ld(&bar[XB_TMO])) break; if (sp > XB_SPIN_CAP) { atomicAdd(&bar[XB_TMO], 1u); break; } }
    }
    nloc = mine > 0u ? mine : 1u; nx = cnt > 0u ? cnt : 1u;
}
template <class Work>
__device__ __forceinline__ void xcd_barrier(const XcdBarrier& b, Work work) {
    asm volatile("s_waitcnt vmcnt(0)" ::: "memory");
    __syncthreads();
    if (threadIdx.x >= 64) work((int)threadIdx.x - 64, (int)blockDim.x - 64);
    if (threadIdx.x == 0) {
        unsigned* bar = b.bar;
        __builtin_amdgcn_s_waitcnt(0);
        unsigned nloc = b.st[0], nx = b.st[1];
        if (nloc == 0u) { xcd_barrier_complete(bar, b.x, nloc, nx); b.st[0] = nloc; b.st[1] = nx; }
        const unsigned old = xb_add(&bar[XB_XSUB(b.x)], 1u);
        const unsigned gen = old / nloc;
        if (old + 1u == (gen + 1u) * nloc) {
            __builtin_amdgcn_fence(__ATOMIC_RELEASE, "agent");
            asm volatile("s_waitcnt vmcnt(0)" ::: "memory");
            const unsigned og = xb_add(&bar[XB_TOP], 1u);
            const unsigned tg = og / nx;
            if (og + 1u == (tg + 1u) * nx) xb_add(&bar[XB_TOPGEN], 1u);
            else XB_SPIN(xb_ld(&bar[XB_TOPGEN]) == tg, bar);
            __builtin_amdgcn_fence(__ATOMIC_ACQUIRE, "agent");
            xb_add(&bar[XB_XGEN(b.x)], 1u);
            asm volatile("s_waitcnt vmcnt(0)" ::: "memory");
        } else {
            XB_SPIN(xb_ld(&bar[XB_XGEN(b.x)]) == gen, bar);
            __builtin_amdgcn_fence(__ATOMIC_ACQUIRE, "agent");
            asm volatile("s_waitcnt vmcnt(0)" ::: "memory");
        }
    }
    __syncthreads();
}

__device__ __forceinline__ unsigned char* opq(unsigned char* p) { asm volatile("" : "+s"(p)); return p; }
struct Args { const float* in[24]; float* out; unsigned char* ws; int ph_lo, ph_hi; };
__device__ __forceinline__ Args load_args() {
#if defined(__HIP_DEVICE_COMPILE__)
    auto kp = __builtin_amdgcn_kernarg_segment_ptr();
    asm volatile("" : "+s"(kp));
    return *(const __attribute__((address_space(4))) Args*)kp;
#else
    return Args{};
#endif
}
enum { I_X = 0, I_C, I_CTX, I_CCTX, I_WMOD, I_BMOD, I_NMIX, I_NFFN, I_WIN, I_QN, I_KN, I_SCW, I_CDW, I_CDB, I_CLG, I_CLB, I_WOUT, I_RW, I_RB, I_WUP, I_BUP, I_WDN, I_BDN, I_FN };

__device__ __forceinline__ void p0_mods_unit(int unit, const float* w_mod, const float* b_mod, float* mods, const LAS float* act, LAS float* red, int tid) {
    const int l = unit / 384, col0 = (unit % 384) * 16, col = tid & 15, kg = tid >> 4;
    float acc[9];
#pragma unroll
    for (int r = 0; r < 9; ++r) acc[r] = 0.f;
    const float* wp = w_mod + ((size_t)l * DM + kg * 32) * NMOD + col0 + col;
#pragma unroll 16
    for (int k = 0; k < 32; ++k) { const float w = wp[(size_t)k * NMOD];
#pragma unroll
        for (int r = 0; r < 9; ++r) acc[r] += act[r * DM + kg * 32 + k] * w; }
#pragma unroll
    for (int r = 0; r < 9; ++r) red[(kg * 9 + r) * 16 + col] = acc[r];
    __syncthreads();
    if (tid < 9 * 16) { const int r = tid >> 4, cc = tid & 15; float sm = 0.f;
#pragma unroll
        for (int g = 0; g < 32; ++g) sm += red[(g * 9 + r) * 16 + cc];
        mods[((size_t)l * 9 + r) * NMOD + col0 + cc] = sm + b_mod[(size_t)l * NMOD + col0 + cc]; }
    __syncthreads();
}
struct MapId { __device__ __forceinline__ int operator()(int n) const { return n; } };
struct MapUp { __device__ __forceinline__ int operator()(int n) const { const int a = n >> 1, j = n & 1; return ((a >> 7) << 8) + (j << 7) + (a & 127); } };
template <class NMap>
__device__ __forceinline__ void p0_transpose_item8(const float* W, int K, int N, unsigned char* WT, LAS float* scr, int kb, int nb, int lane, NMap nmap) {
    const int k0 = 64 * kb, n0 = 64 * nb;
    { const int kq = lane >> 4, n4 = (lane & 15) * 4;
#pragma unroll
        for (int i = 0; i < 16; ++i) { const f32x4 v = __builtin_nontemporal_load((const f32x4*)(W + (size_t)(k0 + 4 * i + kq) * N + n0 + n4));
            LAS float* d = scr + (4 * i + kq) * 65 + n4; d[0] = v.x; d[1] = v.y; d[2] = v.z; d[3] = v.w; } }
    LDS_WAIT(); asm volatile("" ::: "memory");
    const int c = lane & 3, rs = lane >> 2;
#pragma unroll
    for (int j = 0; j < 4; ++j) { const int nl = rs + 16 * j; const LAS float* s = scr + (16 * c) * 65 + nl;
        u32x4 o;
        o.x = pg8::cvt4_fp8(s[0 * 65] * W8_SCALE, s[1 * 65] * W8_SCALE, s[2 * 65] * W8_SCALE, s[3 * 65] * W8_SCALE); o.y = pg8::cvt4_fp8(s[4 * 65] * W8_SCALE, s[5 * 65] * W8_SCALE, s[6 * 65] * W8_SCALE, s[7 * 65] * W8_SCALE);
        o.z = pg8::cvt4_fp8(s[8 * 65] * W8_SCALE, s[9 * 65] * W8_SCALE, s[10 * 65] * W8_SCALE, s[11 * 65] * W8_SCALE); o.w = pg8::cvt4_fp8(s[12 * 65] * W8_SCALE, s[13 * 65] * W8_SCALE, s[14 * 65] * W8_SCALE, s[15 * 65] * W8_SCALE);
        *(u32x4*)(WT + (size_t)nmap(n0 + nl) * K + k0 + 16 * c) = o; }
    LDS_WAIT(); asm volatile("" ::: "memory");
}
template <class NMap>
__device__ __forceinline__ void p0_transpose_item(const float* W, int K, int N, bf16_t* WT, LAS float* scr, int kb, int nb, int lane, NMap nmap) {
    const int k0 = 64 * kb, n0 = 64 * nb;
    { const int kq = lane >> 4, n4 = (lane & 15) * 4;
#pragma unroll
        for (int i = 0; i < 16; ++i) { const f32x4 v = __builtin_nontemporal_load((const f32x4*)(W + (size_t)(k0 + 4 * i + kq) * N + n0 + n4));
            LAS float* d = scr + (4 * i + kq) * 65 + n4; d[0] = v.x; d[1] = v.y; d[2] = v.z; d[3] = v.w; } }
    LDS_WAIT(); asm volatile("" ::: "memory");
    const int c = lane & 7, rs = lane >> 3;
#pragma unroll
    for (int j = 0; j < 8; ++j) { const int nl = rs + 8 * j; const LAS float* s = scr + (8 * c) * 65 + nl;
        u32x4 o; o.x = pk2(s[0 * 65], s[1 * 65]); o.y = pk2(s[2 * 65], s[3 * 65]); o.z = pk2(s[4 * 65], s[5 * 65]); o.w = pk2(s[6 * 65], s[7 * 65]);
        *(u32x4*)(WT + (size_t)nmap(n0 + nl) * K + k0 + 8 * c) = o; }
    LDS_WAIT(); asm volatile("" ::: "memory");
}
constexpr int P0_IT_IN = 16 * 40, P0_IT_IN8 = 16 * 16, P0_IT_OUT = 20 * 16, P0_IT_UP = 16 * 32, P0_IT_DN = 16 * 16, P0_IT_LAYER = P0_IT_IN + P0_IT_IN8 + P0_IT_OUT + NE * P0_IT_UP + NE * P0_IT_DN;
constexpr int P0_ITEMS = DEPTH * P0_IT_LAYER, P0_DEFER = NE * P0_IT_DN;
constexpr int P0_WPB = 7, P0_SLOTN = NWG * P0_WPB, P0_NSLOT = MK_ONE_LAUNCH ? 13 : 0, P0_CNT = P0_ITEMS - P0_DEFER - P0_NSLOT * P0_SLOTN;
__host__ __device__ constexpr int p0_slot(int k) { return k <= 4 ? k : k == 6 ? 5 : k == 7 ? 6 : k == 8 ? 7 : k == 10 ? 8 : k == 12 ? 9 : k == 13 ? 10 : k == 14 ? 11 : k == 16 ? 12 : -1; }
static_assert(P0_CNT > 0, "p0 slots");
__device__ __forceinline__ void p0_items(const Args& a, LAS unsigned char* lds, int gw, int NGW, int it_lo, int it_hi, int tid);
__device__ __forceinline__ void p0_prologue(const Args& a, LAS unsigned char* lds, int wg, int tid) {
    const int lane = tid & 63, wave = tid >> 6;
    unsigned char* ws = a.ws;
    {
        LAS float* act = (LAS float*)lds; LAS float* red = (LAS float*)(lds + 9 * DM * 4);
        for (int i = tid; i < 9 * DM; i += NTHR) { const int r = i >> 10, k = i & 1023; const float v = (r < 8) ? a.in[I_C][r * DM + k] : a.in[I_CCTX][k]; act[i] = v * sigmoidf_(v); }
        __syncthreads();
        for (int u = wg; u < 768; u += NWG) p0_mods_unit(u, a.in[I_WMOD], a.in[I_BMOD], (float*)(ws + WS_MODS), act, red, tid);
    }
    p0_items(a, lds, wg * NWAVES + wave, NWG * NWAVES, 0, P0_CNT, tid);
}
__device__ __forceinline__ void p0_items(const Args& a, LAS unsigned char* lds, int gw, int NGW, int it_lo, int it_hi, int tid) {
    const int lane = tid & 63, wave = tid >> 6;
    unsigned char* ws = a.ws;
    LAS float* scr = (LAS float*)(lds + wave * 16640);
    constexpr int IT_IN = P0_IT_IN, IT_IN8 = P0_IT_IN8, IT_OUT = P0_IT_OUT, IT_UP = P0_IT_UP, IT_DN = P0_IT_DN, IT_LAYER = P0_IT_LAYER;
    for (int it = it_lo + gw; it < it_hi; it += NGW) {
        const int l = it / IT_LAYER; int r = it % IT_LAYER;
        if (r < IT_IN) { p0_transpose_item(a.in[I_WIN] + (size_t)l * DM * IN_W, DM, IN_W, (bf16_t*)(ws + WS_WIN) + (size_t)l * IN_W * DM, scr, r / 40, r % 40, lane, MapId()); continue; } r -= IT_IN;
        if (r < IT_IN8) { p0_transpose_item8(a.in[I_WIN] + (size_t)l * DM * IN_W, DM, IN_W, (unsigned char*)(ws + WS_WIN8) + (size_t)l * IN_W * DM, scr, r / 16, r % 16, lane, MapId()); continue; } r -= IT_IN8;
        if (r < IT_OUT) { p0_transpose_item(a.in[I_WOUT] + (size_t)l * MIX_W * DM, MIX_W, DM, (bf16_t*)(ws + WS_WOUT) + (size_t)l * DM * MIX_W, scr, r / 16, r % 16, lane, MapId()); continue; } r -= IT_OUT;
        if (r < NE * IT_UP) { const int e = r / IT_UP, q = r % IT_UP;
            p0_transpose_item8(a.in[I_WUP] + ((size_t)l * NE + e) * DM * 2048, DM, 2048, (unsigned char*)(ws + WS_WUP) + ((size_t)l * NE + e) * 2048 * DM, scr, q / 32, q % 32, lane, MapUp()); continue; } r -= NE * IT_UP;
        { const int e = r / IT_DN, q = r % IT_DN;
            p0_transpose_item8(a.in[I_WDN] + ((size_t)l * NE + e) * DFF * DM, DFF, DM, (unsigned char*)(ws + WS_WDN) + ((size_t)l * NE + e) * DM * DFF, scr, q / 16, q % 16, lane, MapId()); }
    }
}

__device__ __forceinline__ void p0_slot_items(const Args& a, LAS unsigned char* lds, int wg, int slot, int t) {
    const int w = t >> 6;
    if (w < P0_WPB) p0_items(a, lds, wg * P0_WPB + w, NWG * P0_WPB, P0_CNT + slot * P0_SLOTN, P0_CNT + (slot + 1) * P0_SLOTN, t);
}

__device__ __forceinline__ void ph_norm1(const float* xlat, const float* xctx, const float* gain, const float* mods_l, bf16_t* HA, unsigned char* HA8, int gw, int NGW, int lane) {
    const int k0 = 16 * lane;
    for (int t0 = gw * 2; t0 < NTOK; t0 += NGW * 2) {
        f32x4 v[2][4]; float ss[2];
#pragma unroll
        for (int r = 0; r < 2; ++r) { const int t = t0 + r; const float* xr = (t < NLAT) ? xlat + (size_t)t * DM : xctx + (size_t)(t - NLAT) * DM;
#pragma unroll
            for (int j = 0; j < 4; ++j) v[r][j] = *(const f32x4*)(xr + k0 + 4 * j); }
#pragma unroll
        for (int r = 0; r < 2; ++r) { float q = 0.f;
#pragma unroll
            for (int j = 0; j < 4; ++j) q += v[r][j].x * v[r][j].x + v[r][j].y * v[r][j].y + v[r][j].z * v[r][j].z + v[r][j].w * v[r][j].w;
            ss[r] = q; }
#pragma unroll
        for (int r = 0; r < 2; ++r) { const int t = t0 + r; const float* mp = mods_l + (size_t)tok_bidx(t) * NMOD;
            const float rstd = rsqrtf(wave_sum(ss[r]) * (1.f / DM) + EPS);
            u32x4 ho[2]; unsigned h8[4];
#pragma unroll
            for (int j = 0; j < 4; ++j) { const int k = k0 + 4 * j;
                const f32x4 g = *(const f32x4*)(gain + k), sh = *(const f32x4*)(mp + k), sc = *(const f32x4*)(mp + DM + k);
                const f32x4 y = (v[r][j] * rstd * g) * (sc + 1.f) + sh;
                ho[j >> 1][(j & 1) * 2] = pk2(y.x, y.y); ho[j >> 1][(j & 1) * 2 + 1] = pk2(y.z, y.w); h8[j] = pg8::cvt4_fp8(y.x, y.y, y.z, y.w); }
            *(u32x4*)(HA + (size_t)t * DM + k0) = ho[0]; *(u32x4*)(HA + (size_t)t * DM + k0 + 8) = ho[1];
            *(u32x4*)(HA8 + (size_t)t * DM + k0) = (u32x4){h8[0], h8[1], h8[2], h8[3]}; }
    }
}

__device__ __forceinline__ u32x2 qk_row(u32x4 X, const float (&g)[8], const float (&gp)[8], bool rot, float sgn, const LAS f32x2* rp) {
    float x[8] = {bflo(X.x), bfhi(X.x), bflo(X.y), bfhi(X.y), bflo(X.z), bfhi(X.z), bflo(X.w), bfhi(X.w)};
    float ss = 0.f;
#pragma unroll
    for (int i = 0; i < 8; ++i) ss += x[i] * x[i];
    ss += xor_swz<1>(ss); ss += xor_swz<2>(ss); ss += xor_swz<4>(ss); ss += xor_swz<8>(ss);
    const float rstd = rsqrtf(ss * (1.f / 128.f) + EPS);
    u32x4 P;
    P.x = (unsigned)__builtin_amdgcn_ds_swizzle((int)X.x, (4 << 10) | 0x1f); P.y = (unsigned)__builtin_amdgcn_ds_swizzle((int)X.y, (4 << 10) | 0x1f);
    P.z = (unsigned)__builtin_amdgcn_ds_swizzle((int)X.z, (4 << 10) | 0x1f); P.w = (unsigned)__builtin_amdgcn_ds_swizzle((int)X.w, (4 << 10) | 0x1f);
    const float px[8] = {bflo(P.x), bfhi(P.x), bflo(P.y), bfhi(P.y), bflo(P.z), bfhi(P.z), bflo(P.w), bfhi(P.w)};
    float o[8];
    if (rot) {
#pragma unroll
        for (int i = 0; i < 8; ++i) { const f32x2 cssn = rp[i]; o[i] = (x[i] * rstd * g[i]) * cssn.x + sgn * (px[i] * rstd * gp[i]) * cssn.y; }
    } else {
#pragma unroll
        for (int i = 0; i < 8; ++i) o[i] = x[i] * rstd * g[i];
    }
    u32x2 r; r.x = pg8::cvt4_fp8(o[0], o[1], o[2], o[3]); r.y = pg8::cvt4_fp8(o[4], o[5], o[6], o[7]); return r;
}
__device__ __forceinline__ void ph_qkv(int l, const Args& a, LAS unsigned char* lds, int wg, int tid) {
    const int lane = tid & 63, wave = tid >> 6;
    unsigned char* ws = a.ws;
    const bf16_t* U = (const bf16_t*)(ws + WS_U);
    unsigned char* QB = ws + WS_QB; unsigned char* KB = ws + WS_KB; unsigned char* VT = ws + WS_VB;
    LAS f32x2* rope = (LAS f32x2*)lds;
    for (int i = tid; i < 64 * 32; i += NTHR) { const int p = i >> 5, f = i & 31;
        const float inv = __builtin_amdgcn_exp2f(-(float)f * (2.0f / 64.0f) * 13.287712379549449f);
        float sn, cs; sincos_rev((float)p * inv * 0.15915494309189535f, sn, cs); rope[i] = (f32x2){cs, sn}; }
    __syncthreads();
    const bool last = (l == DEPTH - 1);
    const int j16 = lane & 15, d0 = j16 * 8, axis = j16 >> 3, fi0 = (j16 & 3) * 8;
    const float sgn = ((j16 >> 2) & 1) ? 1.f : -1.f;
    const float* qn = a.in[I_QN] + l * 128; const float* kn = a.in[I_KN] + l * 128;
    float qg[8], qgp[8], kg[8], kgp[8];
#pragma unroll
    for (int i = 0; i < 8; ++i) { qg[i] = qn[d0 + i] * att8::QSC; qgp[i] = qn[(d0 ^ 32) + i] * att8::QSC; kg[i] = kn[d0 + i]; kgp[i] = kn[(d0 ^ 32) + i]; }
#pragma unroll 2
    for (int t = wg * NWAVES + wave; t < NTOK; t += NWG * NWAVES) {
        const bool isctx = t >= NLAT;
        const int b = isctx ? (t - NLAT) >> 8 : t >> 12, sp = isctx ? (t - NLAT) & 255 : t & 4095, krow = isctx ? sp : CTXL + sp;
        const bool doq = !(last && isctx);
        const bf16_t* up = U + (size_t)t * IN_W;
        u32x4 A = {0u, 0u, 0u, 0u}; if (doq) A = *(const u32x4*)(up + 8 * lane);
        u32x4 B = {0u, 0u, 0u, 0u}; if (lane < 32) B = *(const u32x4*)(up + 512 + 8 * lane);
        const LAS f32x2* rp = rope + (axis ? (sp & 63) : (sp >> 6)) * 32 + fi0;
        const u32x2 qo = qk_row(A, qg, qgp, !isctx, sgn, rp);
        if (doq) *(u32x2*)(QB + (size_t)t * 512 + 8 * lane) = qo;
        const u32x2 ko = qk_row(B, kg, kgp, !isctx, sgn, rp);
        if (lane < 32) *(u32x2*)(KB + ((size_t)(b * 2 + (lane >> 4)) * SKV + krow) * 128 + d0) = ko;
    }
    __syncthreads();
    LAS unsigned char* T = (LAS unsigned char*)lds;
    for (int u = wg; u < BATCH * 2 * (SKV / 64); u += NWG) {
        const int b = u / (2 * (SKV / 64)), rem = u % (2 * (SKV / 64)), kvh = rem / (SKV / 64), tile = rem % (SKV / 64);
        { const int key = tid & 63, dch = (tid >> 6) * 16, kr = tile * 64 + key;
            const size_t tok = (kr < CTXL) ? (size_t)NLAT + b * CTXL + kr : (size_t)b * SEQ + (kr - CTXL);
            const bf16_t* src = U + tok * IN_W + 768 + kvh * 128 + dch;
            const u32x4 v0 = *(const u32x4*)src, v1 = *(const u32x4*)(src + 8);
            const unsigned w0 = pg8::cvt4_fp8(bflo(v0.x), bfhi(v0.x), bflo(v0.y), bfhi(v0.y)), w1 = pg8::cvt4_fp8(bflo(v0.z), bfhi(v0.z), bflo(v0.w), bfhi(v0.w));
            const unsigned w2 = pg8::cvt4_fp8(bflo(v1.x), bfhi(v1.x), bflo(v1.y), bfhi(v1.y)), w3 = pg8::cvt4_fp8(bflo(v1.z), bfhi(v1.z), bflo(v1.w), bfhi(v1.w));
            LAS unsigned char* dst = T + dch * 64 + att8::kpos(key);
#pragma unroll
            for (int i = 0; i < 4; ++i) { dst[(i) * 64] = (unsigned char)(w0 >> (8 * i)); dst[(4 + i) * 64] = (unsigned char)(w1 >> (8 * i)); dst[(8 + i) * 64] = (unsigned char)(w2 >> (8 * i)); dst[(12 + i) * 64] = (unsigned char)(w3 >> (8 * i)); } }
        __syncthreads();
        *(u32x4*)(VT + ((size_t)(b * 2 + kvh) * (SKV / 64) + tile) * 8192 + tid * 16) = *(const LAS u32x4*)(T + tid * 16);
        __syncthreads();
    }
}

constexpr int CV_GLU = 0, CV_D = 32768, CV_END = CV_D + 32 * 256 * 4;
__device__ __forceinline__ void ph_conv_tiles(int l, const Args& a, LAS unsigned char* lds, int wg, int tid) {
    unsigned char* ws = a.ws;
    const bf16_t* U = (const bf16_t*)(ws + WS_U); bf16_t* MIX = (bf16_t*)(ws + WS_MIX);
    const float* cdw = a.in[I_CDW] + (size_t)l * 31 * 256; const float* cdb = a.in[I_CDB] + l * 256;
    const float* clg = a.in[I_CLG] + l * 256; const float* clb = a.in[I_CLB] + l * 256; const float* scw = a.in[I_SCW] + (size_t)l * 3 * 256;
    LAS unsigned* glu = (LAS unsigned*)(lds + CV_GLU);
    LAS float* dbuf = (LAS float*)(lds + CV_D);
    const int cp = tid & 127, tg = tid >> 7;
    const int hw = tid >> 5, l32 = tid & 31;
    f32x2 w[31];
#pragma unroll
    for (int j = 0; j < 31; ++j) w[j] = *(const f32x2*)(cdw + j * 256 + 2 * cp);
    const f32x2 cbias = *(const f32x2*)(cdb + 2 * cp);
    const int ntiles = (l == DEPTH - 1) ? NLAT / 32 : NTOK / 32;
    u32x4 ra[4], rg[4];
#define CV_LOAD(TT) do { const int t0_ = (TT) * 32; const bool ic_ = t0_ >= NLAT; const int sq_ = ic_ ? (t0_ - NLAT) & 255 : t0_ & 4095, sl_ = ic_ ? CTXL : SEQ; \
        _Pragma("unroll") for (int i = 0; i < 4; ++i) { const int id = tid + NTHR * i, j = id >> 5, c8 = (id & 31) * 8, sj = sq_ - 15 + j; \
            ra[i] = (u32x4){0u, 0u, 0u, 0u}; rg[i] = ra[i]; \
            if (id < 62 * 32 && sj >= 0 && sj < sl_) { const bf16_t* up = U + (size_t)(t0_ - 15 + j) * IN_W + 2048 + c8; ra[i] = *(const u32x4*)up; rg[i] = *(const u32x4*)(up + 256); } } } while (0)
    if (wg < ntiles) CV_LOAD(wg);
    for (int tt = wg; tt < ntiles; tt += NWG) {
        const int t0 = tt * 32; const bool isctx = t0 >= NLAT;
        const int s0p = isctx ? (t0 - NLAT) & 255 : t0 & 4095, slen = isctx ? CTXL : SEQ;
#pragma unroll
        for (int i = 0; i < 4; ++i) { const int id = tid + NTHR * i;
            if (id < 62 * 32) { u32x4 o;
                o.x = pk2(bflo(ra[i].x) * sigmoidf_(bflo(rg[i].x)), bfhi(ra[i].x) * sigmoidf_(bfhi(rg[i].x))); o.y = pk2(bflo(ra[i].y) * sigmoidf_(bflo(rg[i].y)), bfhi(ra[i].y) * sigmoidf_(bfhi(rg[i].y)));
                o.z = pk2(bflo(ra[i].z) * sigmoidf_(bflo(rg[i].z)), bfhi(ra[i].z) * sigmoidf_(bfhi(rg[i].z))); o.w = pk2(bflo(ra[i].w) * sigmoidf_(bflo(rg[i].w)), bfhi(ra[i].w) * sigmoidf_(bfhi(rg[i].w)));
                *(LAS u32x4*)(glu + id * 4) = o; } }
        __syncthreads();
        if (tt + NWG < ntiles) CV_LOAD(tt + NWG);
        {
            f32x2 acc[8];
#pragma unroll
            for (int o = 0; o < 8; ++o) acc[o] = cbias;
#pragma unroll
            for (int jj = 0; jj < 38; ++jj) { const unsigned gv = glu[(tg * 8 + jj) * 128 + cp]; const f32x2 v = {bflo(gv), bfhi(gv)};
#pragma unroll
                for (int o = 0; o < 8; ++o) { const int k = jj - o; if (k >= 0 && k < 31) acc[o] += w[k] * v; } }
#pragma unroll
            for (int o = 0; o < 8; ++o) *(LAS f32x2*)(dbuf + (tg * 8 + o) * 256 + 2 * cp) = acc[o];
        }
        {
            const int c8 = (tid & 31) * 8;
#pragma unroll
            for (int q = 0; q < 2; ++q) { const int tl = (tid >> 5) + 16 * q, sj = s0p + tl; const bf16_t* up = U + (size_t)(t0 + tl) * IN_W + c8;
                u32x4 cv[3], xv[3];
#pragma unroll
                for (int d = 0; d < 3; ++d) { cv[d] = (u32x4){0u, 0u, 0u, 0u}; xv[d] = cv[d];
                    if (sj + d - 1 >= 0 && sj + d - 1 < slen) { cv[d] = *(const u32x4*)(up + (d - 1) * IN_W + 1280); xv[d] = *(const u32x4*)(up + (d - 1) * IN_W + 1536); } }
                const u32x4 bv = *(const u32x4*)(up + 1024);
                const f32x4 w0a = *(const f32x4*)(scw + c8), w0b = *(const f32x4*)(scw + c8 + 4), w1a = *(const f32x4*)(scw + 256 + c8), w1b = *(const f32x4*)(scw + 256 + c8 + 4), w2a = *(const f32x4*)(scw + 512 + c8), w2b = *(const f32x4*)(scw + 512 + c8 + 4);
                const float wt[3][8] = {{w0a.x, w0a.y, w0a.z, w0a.w, w0b.x, w0b.y, w0b.z, w0b.w}, {w1a.x, w1a.y, w1a.z, w1a.w, w1b.x, w1b.y, w1b.z, w1b.w}, {w2a.x, w2a.y, w2a.z, w2a.w, w2b.x, w2b.y, w2b.z, w2b.w}};
                float acc[8];
#pragma unroll
                for (int i = 0; i < 8; ++i) acc[i] = 0.f;
#pragma unroll
                for (int d = 0; d < 3; ++d) { const unsigned cw[4] = {cv[d].x, cv[d].y, cv[d].z, cv[d].w}, xw[4] = {xv[d].x, xv[d].y, xv[d].z, xv[d].w};
#pragma unroll
                    for (int i = 0; i < 4; ++i) { acc[2 * i] += wt[d][2 * i] * (bflo(cw[i]) * bflo(xw[i])); acc[2 * i + 1] += wt[d][2 * i + 1] * (bfhi(cw[i]) * bfhi(xw[i])); } }
                const unsigned bw[4] = {bv.x, bv.y, bv.z, bv.w}; u32x4 o;
                o.x = pk2(bflo(bw[0]) * acc[0], bfhi(bw[0]) * acc[1]); o.y = pk2(bflo(bw[1]) * acc[2], bfhi(bw[1]) * acc[3]); o.z = pk2(bflo(bw[2]) * acc[4], bfhi(bw[2]) * acc[5]); o.w = pk2(bflo(bw[3]) * acc[6], bfhi(bw[3]) * acc[7]);
                *(u32x4*)(MIX + (size_t)(t0 + tl) * MIX_W + 512 + c8) = o; }
        }
        __syncthreads();
#pragma unroll
        for (int q = 0; q < 2; ++q) { const int tok = hw * 2 + q;
            const f32x4 v0 = *(const LAS f32x4*)(dbuf + tok * 256 + l32 * 8), v1 = *(const LAS f32x4*)(dbuf + tok * 256 + l32 * 8 + 4);
            float sm = (v0.x + v0.y + v0.z + v0.w) + (v1.x + v1.y + v1.z + v1.w);
            sm += xor_swz<1>(sm); sm += xor_swz<2>(sm); sm += xor_swz<4>(sm); sm += xor_swz<8>(sm); sm += xor_swz<16>(sm);
            const float mean = sm * (1.f / 256.f);
            const f32x4 d0 = v0 - mean, d1 = v1 - mean;
            float vs = (d0.x * d0.x + d0.y * d0.y + d0.z * d0.z + d0.w * d0.w) + (d1.x * d1.x + d1.y * d1.y + d1.z * d1.z + d1.w * d1.w);
            vs += xor_swz<1>(vs); vs += xor_swz<2>(vs); vs += xor_swz<4>(vs); vs += xor_swz<8>(vs); vs += xor_swz<16>(vs);
            const float rstd = rsqrtf(vs * (1.f / 256.f) + EPS);
            const f32x4 g0 = *(const f32x4*)(clg + l32 * 8), g1 = *(const f32x4*)(clg + l32 * 8 + 4), b0 = *(const f32x4*)(clb + l32 * 8), b1 = *(const f32x4*)(clb + l32 * 8 + 4);
            f32x4 y0 = d0 * rstd * g0 + b0, y1 = d1 * rstd * g1 + b1;
            y0.x *= sigmoidf_(y0.x); y0.y *= sigmoidf_(y0.y); y0.z *= sigmoidf_(y0.z); y0.w *= sigmoidf_(y0.w);
            y1.x *= sigmoidf_(y1.x); y1.y *= sigmoidf_(y1.y); y1.z *= sigmoidf_(y1.z); y1.w *= sigmoidf_(y1.w);
            u32x4 o; o.x = pk2(y0.x, y0.y); o.y = pk2(y0.z, y0.w); o.z = pk2(y1.x, y1.y); o.w = pk2(y1.z, y1.w);
            *(u32x4*)(MIX + (size_t)(t0 + tok) * MIX_W + 1024 + l32 * 8) = o; }
    }
#undef CV_LOAD
    __syncthreads();
}

constexpr int FM_LD = 72;
constexpr int FM_WC = 0, FM_WS = 9216, FM_WSN = 18432, FM_X = 27648, FM_GRE = 36864, FM_GIM = 46080, FM_AT = 27648  , FM_OUT = 55296  , FM_OUT3 = 64512  , FM_TW = FM_OUT3 + 2 * 9216  , FM_END = FM_TW + 1024;
__device__ __forceinline__ void fm_tables(LAS unsigned char* lds, int tid) {
    LAS bf16_t* Wc = (LAS bf16_t*)(lds + FM_WC); LAS bf16_t* Ws = (LAS bf16_t*)(lds + FM_WS); LAS bf16_t* Wsn = (LAS bf16_t*)(lds + FM_WSN);
    for (int i = tid; i < 4096; i += NTHR) { const int r = i >> 6, c = i & 63; float sn, cs; sincos_rev((float)((r * c) & 63) * (1.f / 64.f), sn, cs);
        Wc[r * FM_LD + c] = (bf16_t)f2bf(cs); Ws[r * FM_LD + c] = (bf16_t)f2bf(sn); Wsn[r * FM_LD + c] = (bf16_t)f2bf(-sn); }
    __syncthreads();
}
template <bool BSWZ = false>
__device__ __forceinline__ void fm_mm(f32x16& acc, const LAS bf16_t* A, int ar0, const LAS bf16_t* Bt, int br0, int lane) {
    const int r = lane & 31, h = lane >> 5;
#pragma unroll
    for (int k0 = 0; k0 < 64; k0 += 16) {
        const int kg = (k0 >> 3) + h, kb = BSWZ ? ((kg ^ (((br0 + r) >> 3) & 7)) << 3) : (kg << 3);
        const bf16x8 av = *(const LAS bf16x8*)(A + (ar0 + r) * FM_LD + k0 + 8 * h), bv = *(const LAS bf16x8*)(Bt + (br0 + r) * FM_LD + kb);
        acc = __builtin_amdgcn_mfma_f32_32x32x16_bf16(av, bv, acc, 0, 0, 0); }
}
__device__ __forceinline__ int fm_crow(int reg, int h) { return (reg & 3) + 8 * (reg >> 2) + 4 * h; }
template <bool CTXM>
__device__ __forceinline__ void fm12_unit(int unit, const bf16_t* U, bf16_t* F2, LAS unsigned char* lds, int tid) {
    const LAS bf16_t* Wc = (const LAS bf16_t*)(lds + FM_WC); const LAS bf16_t* Ws = (const LAS bf16_t*)(lds + FM_WS); const LAS bf16_t* Wsn = (const LAS bf16_t*)(lds + FM_WSN);
    LAS bf16_t* X = (LAS bf16_t*)(lds + FM_X); LAS bf16_t* Gre = (LAS bf16_t*)(lds + FM_GRE); LAS bf16_t* Gim = (LAS bf16_t*)(lds + FM_GIM);
    int b, g, s2;
    if (!CTXM) { b = unit >> 8; g = (unit >> 6) & 3; s2 = unit & 63; } else { b = unit >> 4; g = (unit >> 2) & 3; s2 = unit & 3; }
    const int lane = tid & 63, wave = tid >> 6, r = lane & 31, h = lane >> 5, part = wave >> 2, tr = (wave >> 1) & 1, tc = wave & 1;
    { const int s1 = tid >> 3, c8 = (tid & 7) * 8;
        const size_t tok = CTXM ? (size_t)NLAT + b * CTXL + (s1 >> 4) * 64 + s2 * 16 + (s1 & 15) : (size_t)b * SEQ + s1 * 64 + s2;
        *(LAS u32x4*)(X + s1 * FM_LD + c8) = *(const u32x4*)(U + tok * IN_W + 1792 + g * 64 + c8); }
    __syncthreads();
    {
        f32x16 acc = {};
        fm_mm(acc, X, tr * 32, part ? Wsn : Wc, tc * 32, lane);
        LAS bf16_t* GT = part ? Gim : Gre;
#pragma unroll
        for (int q = 0; q < 4; ++q) { u32x2 o; o.x = pk2(acc[4 * q], acc[4 * q + 1]); o.y = pk2(acc[4 * q + 2], acc[4 * q + 3]);
            *(LAS u32x2*)(GT + (tc * 32 + r) * FM_LD + tr * 32 + 8 * q + 4 * h) = o; }
    }
    __syncthreads();
    if constexpr (!CTXM) {
    {
        f32x16 acc = {};
        fm_mm(acc, Wc, tr * 32, part ? Gim : Gre, tc * 32, lane);
        fm_mm(acc, part ? Wsn : Ws, tr * 32, part ? Gre : Gim, tc * 32, lane);
        LAS bf16_t* OUT = (LAS bf16_t*)(lds + FM_OUT) + part * 64 * FM_LD;
#pragma unroll
        for (int reg = 0; reg < 16; ++reg) OUT[(tr * 32 + fm_crow(reg, h)) * FM_LD + tc * 32 + r] = (bf16_t)f2bf(acc[reg]);
    }
    __syncthreads();
#pragma unroll
    for (int i = 0; i < 2; ++i) { const int c = tid + NTHR * i, k1 = c >> 4, pt = (c >> 3) & 1, mch = (c & 7) * 8;
        *(u32x4*)(F2 + ((((size_t)(b * 4 + g) * 64 + k1) * 64 + s2) * 2 + pt) * 64 + mch) = *(const LAS u32x4*)((LAS bf16_t*)(lds + FM_OUT) + (pt * 64 + k1) * FM_LD + mch); }
    } else {
        const int k1 = tid >> 7, s2l = (tid >> 3) & 15, m0 = (tid & 7) * 8;
        float re[8], im[8];
#pragma unroll
        for (int q = 0; q < 8; ++q) { re[q] = 0.f; im[q] = 0.f; }
#pragma unroll
        for (int s1 = 0; s1 < 4; ++s1) { const int idx = (16 * s1 * k1) & 63; const float wr = bf2f(Wc[FM_LD + idx]), wi = bf2f(Ws[FM_LD + idx]);
#pragma unroll
            for (int q = 0; q < 8; ++q) { const float gr = bf2f(Gre[(m0 + q) * FM_LD + s1 * 16 + s2l]), gi = bf2f(Gim[(m0 + q) * FM_LD + s1 * 16 + s2l]); re[q] += wr * gr + wi * gi; im[q] += wr * gi - wi * gr; } }
        bf16_t* dst = F2 + (size_t)NLAT * 512 + ((((size_t)(b * 4 + g) * 4 + k1) * 64 + s2 * 16 + s2l) * 2) * 64 + m0;
        u32x4 o; o.x = pk2(re[0], re[1]); o.y = pk2(re[2], re[3]); o.z = pk2(re[4], re[5]); o.w = pk2(re[6], re[7]); *(u32x4*)dst = o;
        o.x = pk2(im[0], im[1]); o.y = pk2(im[2], im[3]); o.z = pk2(im[4], im[5]); o.w = pk2(im[6], im[7]); *(u32x4*)(dst + 64) = o;
    }
}
template <bool CTXM>
__device__ __forceinline__ void fm3_unit(int unit, const bf16_t* F2, bf16_t* MIX, LAS unsigned char* lds, int tid) {
    const LAS bf16_t* Wc = (const LAS bf16_t*)(lds + FM_WC); const LAS bf16_t* Ws = (const LAS bf16_t*)(lds + FM_WS);
    LAS bf16_t* AT = (LAS bf16_t*)(lds + FM_AT);
    constexpr int N1 = CTXM ? 4 : 64; constexpr float NRM = CTXM ? (1.f / 128.f) : (1.f / 512.f);
    int b, g, kp;
    if (!CTXM) { b = unit >> 7; g = (unit >> 5) & 3; kp = unit & 31; } else { b = unit >> 3; g = (unit >> 1) & 3; kp = unit & 1; }
    const bf16_t* F2b = F2 + (CTXM ? (size_t)NLAT * 512 : 0);
    const size_t tok0 = CTXM ? (size_t)NLAT + b * CTXL : (size_t)b * SEQ;
    const int lane = tid & 63, wave = tid >> 6, r = lane & 31, h = lane >> 5;
    LAS f32x2* tw = (LAS f32x2*)(lds + FM_TW);
    if (tid < 128) { const int ki = tid >> 6, s2 = tid & 63; float sn, cs; sincos_rev((float)(s2 * (kp * 2 + ki)) * (1.f / (64.f * N1)), sn, cs); tw[tid] = (f32x2){cs, sn}; }
    __syncthreads();
#pragma unroll
    for (int ki = 0; ki < 2; ++ki) { const bf16_t* img = F2b + (((size_t)(b * 4 + g) * N1 + kp * 2 + ki) * 64) * 128;
        const int s2 = tid >> 3, mch = tid & 7;
        const u32x4 rv = *(const u32x4*)(img + s2 * 128 + mch * 8), iv = *(const u32x4*)(img + s2 * 128 + 64 + mch * 8);
        const f32x2 t = tw[ki * 64 + s2]; const float cs = t.x, sn = t.y;
        const float re[8] = {bflo(rv.x), bfhi(rv.x), bflo(rv.y), bfhi(rv.y), bflo(rv.z), bfhi(rv.z), bflo(rv.w), bfhi(rv.w)};
        const float im[8] = {bflo(iv.x), bfhi(iv.x), bflo(iv.y), bfhi(iv.y), bflo(iv.z), bfhi(iv.z), bflo(iv.w), bfhi(iv.w)};
        const int col = (((s2 >> 3) ^ mch) << 3) | (s2 & 7);
        LAS bf16_t* are = AT + (ki * 2 + 0) * 64 * FM_LD + (mch * 8) * FM_LD + col; LAS bf16_t* aim = AT + (ki * 2 + 1) * 64 * FM_LD + (mch * 8) * FM_LD + col;
#pragma unroll
        for (int q = 0; q < 8; ++q) { are[q * FM_LD] = (bf16_t)f2bf(re[q] * cs + im[q] * sn); aim[q * FM_LD] = (bf16_t)f2bf(im[q] * cs - re[q] * sn); }
    }
    __syncthreads();
    { const int ki = wave >> 2, tr = (wave >> 1) & 1, tc = wave & 1;
        f32x16 acc = {};
        fm_mm<true>(acc, Wc, tr * 32, AT + (ki * 2 + 0) * 64 * FM_LD, tc * 32, lane);
        fm_mm<true>(acc, Ws, tr * 32, AT + (ki * 2 + 1) * 64 * FM_LD, tc * 32, lane);
        LAS bf16_t* OUT = (LAS bf16_t*)(lds + FM_OUT3) + ki * 64 * FM_LD;
#pragma unroll
        for (int reg = 0; reg < 16; ++reg) OUT[(tr * 32 + fm_crow(reg, h)) * FM_LD + tc * 32 + r] = (bf16_t)f2bf(acc[reg] * NRM);
    }
    __syncthreads();
#pragma unroll
    for (int i = 0; i < 2; ++i) { const int c = tid + NTHR * i, ki = c >> 9, k2 = (c >> 3) & 63, mch = (c & 7) * 8;
        *(u32x4*)(MIX + (tok0 + kp * 2 + ki + N1 * k2) * MIX_W + 768 + g * 64 + mch) = *(const LAS u32x4*)((LAS bf16_t*)(lds + FM_OUT3) + (ki * 64 + k2) * FM_LD + mch); }
    __syncthreads();
}

constexpr int N2_SSQ = 0, N2_PART = 1024, N2_LG = N2_PART + 8 * 32 * 33 * 4, N2_HIST = N2_LG + 32 * 33 * 4, N2_TA = 40960, N2_TB = N2_TA + 9 * DM * 4, N2_END = N2_TB + 9 * DM * 4;
static_assert(N2_HIST + 128 <= N2_TA && N2_END <= LDS_FREE, "norm2 LDS");
__device__ __forceinline__ void hilo8(const float (&v)[8], bf16x8& hi, bf16x8& lo) {
    u32x4 H, L;
#pragma unroll
    for (int j = 0; j < 4; ++j) { const unsigned hw = pk2(v[2 * j], v[2 * j + 1]); H[j] = hw; L[j] = pk2(v[2 * j] - bflo(hw), v[2 * j + 1] - bfhi(hw)); }
    hi = __builtin_bit_cast(bf16x8, H); lo = __builtin_bit_cast(bf16x8, L);
}
__device__ __forceinline__ void n2_tables(int l, const Args& a, LAS unsigned char* lds, int t, int nt) {
    const float* mods_l = (const float*)(a.ws + WS_MODS) + (size_t)l * 9 * NMOD; const float* gain = a.in[I_NFFN] + l * DM;
    LAS float* TA = (LAS float*)(lds + N2_TA); LAS float* TB = (LAS float*)(lds + N2_TB); LAS int* hist = (LAS int*)(lds + N2_HIST);
    if (t < NE) hist[t] = 0;
    for (int i = t; i < 9 * DM; i += nt) { const int rr = i >> 10, k = i & 1023; TA[i] = gain[k] * (1.f + mods_l[(size_t)rr * NMOD + 4 * DM + k]); TB[i] = mods_l[(size_t)rr * NMOD + 3 * DM + k]; }
}
template <bool PRE>
__device__ __forceinline__ void ph_norm2(int l, int ntok, const Args& a, LAS unsigned char* lds, int wg, int tid) {
    const int lane = tid & 63, wave = tid >> 6, r = lane & 31, h = lane >> 5;
    unsigned char* ws = a.ws;
    const bf16_t* XA = (const bf16_t*)(ws + WS_XA); unsigned char* H8 = (unsigned char*)(ws + WS_H8);
    const float* mods_l = (const float*)(ws + WS_MODS) + (size_t)l * 9 * NMOD;
    const float* gain = a.in[I_NFFN] + l * DM; const float* rw = a.in[I_RW] + (size_t)l * DM * NE; const float* rb = a.in[I_RB] + l * NE;
    int* tok_e = (int*)(ws + WS_TOKE); float* tok_p = (float*)(ws + WS_TOKP); int* counts = (int*)(ws + WS_CNT);
    LAS float* ssq = (LAS float*)(lds + N2_SSQ); LAS float* part = (LAS float*)(lds + N2_PART); LAS float* lg = (LAS float*)(lds + N2_LG); LAS int* hist = (LAS int*)(lds + N2_HIST);
    LAS float* TA = (LAS float*)(lds + N2_TA); LAS float* TB = (LAS float*)(lds + N2_TB);
    if (!PRE) n2_tables(l, a, lds, tid, NTHR);
    bf16x8 Bhi[8], Blo[8];
#pragma unroll
    for (int s = 0; s < 8; ++s) { float v[8];
#pragma unroll
        for (int j = 0; j < 8; ++j) v[j] = rw[(size_t)(128 * wave + 16 * s + 8 * h + j) * NE + r];
        hilo8(v, Bhi[s], Blo[s]); }
    __syncthreads();
    const int ntile = ntok / 32;
    u32x4 xraw[8];
    if (wg < ntile) { const bf16_t* xr0 = XA + (size_t)(wg * 32 + r) * DM + 128 * wave + 8 * h;
#pragma unroll
        for (int s = 0; s < 8; ++s) xraw[s] = *(const u32x4*)(xr0 + 16 * s); }
    for (int tile = wg; tile < ntile; tile += NWG) {
        const int t = tile * 32 + r;
        f32x4 xv[8][2]; float ss = 0.f;
#pragma unroll
        for (int s = 0; s < 8; ++s) { xv[s][0] = (f32x4){bflo(xraw[s].x), bfhi(xraw[s].x), bflo(xraw[s].y), bfhi(xraw[s].y)}; xv[s][1] = (f32x4){bflo(xraw[s].z), bfhi(xraw[s].z), bflo(xraw[s].w), bfhi(xraw[s].w)}; }
        if (tile + NWG < ntile) { const bf16_t* xrn = XA + (size_t)((tile + NWG) * 32 + r) * DM + 128 * wave + 8 * h;
#pragma unroll
            for (int s = 0; s < 8; ++s) xraw[s] = *(const u32x4*)(xrn + 16 * s); }
#pragma unroll
        for (int s = 0; s < 8; ++s) ss += (xv[s][0].x * xv[s][0].x + xv[s][0].y * xv[s][0].y + xv[s][0].z * xv[s][0].z + xv[s][0].w * xv[s][0].w) + (xv[s][1].x * xv[s][1].x + xv[s][1].y * xv[s][1].y + xv[s][1].z * xv[s][1].z + xv[s][1].w * xv[s][1].w);
        { auto rr = __builtin_amdgcn_permlane32_swap(__float_as_uint(ss), __float_as_uint(ss), false, false); ss = __uint_as_float(rr[0]) + __uint_as_float(rr[1]); }
        if (h == 0) ssq[wave * 32 + r] = ss;
        __syncthreads();
        float tot = 0.f;
#pragma unroll
        for (int w = 0; w < 8; ++w) tot += ssq[w * 32 + r];
        const float rstd = rsqrtf(tot * (1.f / DM) + EPS);
        f32x16 acc = {};
        const LAS float* ta = TA + tok_bidx(tile * 32) * DM + 128 * wave + 8 * h; const LAS float* tb = TB + tok_bidx(tile * 32) * DM + 128 * wave + 8 * h;
#pragma unroll
        for (int s = 0; s < 8; ++s) {
            const f32x4 y0 = (xv[s][0] * rstd) * *(const LAS f32x4*)(ta + 16 * s) + *(const LAS f32x4*)(tb + 16 * s), y1 = (xv[s][1] * rstd) * *(const LAS f32x4*)(ta + 16 * s + 4) + *(const LAS f32x4*)(tb + 16 * s + 4);
            const float v[8] = {y0.x, y0.y, y0.z, y0.w, y1.x, y1.y, y1.z, y1.w};
            u32x2 o8; o8.x = pg8::cvt4_fp8(v[0], v[1], v[2], v[3]); o8.y = pg8::cvt4_fp8(v[4], v[5], v[6], v[7]);
            *(u32x2*)(H8 + (size_t)t * DM + 128 * wave + 16 * s + 8 * h) = o8;
            bf16x8 ahi, alo; hilo8(v, ahi, alo);
            acc = __builtin_amdgcn_mfma_f32_32x32x16_bf16(ahi, Bhi[s], acc, 0, 0, 0);
            acc = __builtin_amdgcn_mfma_f32_32x32x16_bf16(alo, Bhi[s], acc, 0, 0, 0);
            acc = __builtin_amdgcn_mfma_f32_32x32x16_bf16(ahi, Blo[s], acc, 0, 0, 0); }
#pragma unroll
        for (int reg = 0; reg < 16; ++reg) part[(wave * 32 + fm_crow(reg, h)) * 33 + r] = acc[reg];
        __syncthreads();
#pragma unroll
        for (int q = 0; q < 2; ++q) { const int idx = tid + NTHR * q, tk = idx >> 5, e = idx & 31; float sm = rb[e];
#pragma unroll
            for (int w = 0; w < 8; ++w) sm += part[(w * 32 + tk) * 33 + e];
            lg[tk * 33 + e] = sm; }
        __syncthreads();
#pragma unroll
        for (int q = 0; q < 2; ++q) { const int tk = wave * 4 + q * 2 + h;
            float v = lg[tk * 33 + r]; float bv[4]; int be[4];
#pragma unroll
            for (int j = 0; j < 4; ++j) { float m = v;
                m = fmaxf(m, xor_swz<1>(m)); m = fmaxf(m, xor_swz<2>(m)); m = fmaxf(m, xor_swz<4>(m)); m = fmaxf(m, xor_swz<8>(m)); m = fmaxf(m, xor_swz<16>(m));
                const unsigned long long bal = __ballot(v == m); const unsigned mine = (unsigned)(bal >> (32 * h));
                const int idx = __builtin_ctz(mine);
                bv[j] = m; be[j] = idx; if (r == idx) v = -3.0e38f; }
            if (r == 0) { const float e1 = __expf(bv[1] - bv[0]), e2 = __expf(bv[2] - bv[0]), e3 = __expf(bv[3] - bv[0]); const float inv = __builtin_amdgcn_rcpf(1.f + e1 + e2 + e3);
                const int tt = tile * 32 + tk;
                *(int4*)(tok_e + (size_t)tt * 4) = make_int4(be[0], be[1], be[2], be[3]);
                *(float4*)(tok_p + (size_t)tt * 4) = make_float4(inv, e1 * inv, e2 * inv, e3 * inv);
#pragma unroll
                for (int j = 0; j < 4; ++j) atomicAdd((int*)&hist[be[j]], 1); } }
    }
    __syncthreads();
    if (tid < NE) counts[wg * NE + tid] = hist[tid];
}

constexpr int RT_PSUM = 0, RT_PPRE = 2048, RT_TOT = 4096, RT_BASE = 4224, RT_OFF = 4352, RT_POS = 4608;
__device__ __forceinline__ void ph_route(int ntok, const Args& a, LAS unsigned char* lds, int wg, int tid) {
    const int lane = tid & 63, wave = tid >> 6;
    unsigned char* ws = a.ws;
    const int* counts = (const int*)(ws + WS_CNT); int* eoff = (int*)(ws + WS_EOFF);
    const int* tok_e = (const int*)(ws + WS_TOKE); const float* tok_p = (const float*)(ws + WS_TOKP); int* tokpos = (int*)(ws + WS_TOKPOS); float* roww = (float*)(ws + WS_ROWW);
    int* rowtok = (int*)(ws + WS_ROWTOK);
    LAS int* psum = (LAS int*)(lds + RT_PSUM); LAS int* ppre = (LAS int*)(lds + RT_PPRE); LAS int* tot = (LAS int*)(lds + RT_TOT); LAS int* base = (LAS int*)(lds + RT_BASE); LAS int* off = (LAS int*)(lds + RT_OFF); LAS int* posb = (LAS int*)(lds + RT_POS);
    { const int e = tid & 31, part = tid >> 5; int s = 0, pre = 0;
        for (int w = part * 16; w < part * 16 + 16; ++w) { const int c = counts[w * NE + e]; if (w < wg) pre += c; s += c; }
        psum[part * 32 + e] = s; ppre[part * 32 + e] = pre; }
    __syncthreads();
    if (tid < NE) { int s = 0, pre = 0;
        for (int p = 0; p < 16; ++p) { s += psum[p * 32 + tid]; pre += ppre[p * 32 + tid]; }
        tot[tid] = s; base[tid] = pre; }
    __syncthreads();
    if (tid == 0) { int o = 0; for (int e = 0; e < NE; ++e) { off[e] = o; o += (tot[e] + 255) & ~255; } off[NE] = o; }
    __syncthreads();
    if (wg == 0 && tid <= NE) eoff[tid] = off[tid];
    { LAS int* tab = (LAS int*)(lds + LDS_TAB); const int nMt_ = off[NE] >> 8;
        for (int i = tid; i < nMt_; i += NTHR) { const int row = i << 8; int e = 0;
            for (int q = 1; q < NE; ++q) if (off[q] <= row) e = q;
            tab[i] = e; }
        if (tid == 0) tab[LDS_TAB_NMT] = nMt_; }
    const int ntile = ntok / 32, ntw = (ntile - wg + NWG - 1) / NWG, nas = ntw * 128;
#define RT_TOK(ai) ((wg + NWG * ((ai) >> 7)) * 32 + (((ai) >> 2) & 31))
    if (wave == 0) {
        constexpr int MAXCH = 10; static_assert((NTOK / 32 + NWG - 1) / NWG * 128 <= MAXCH * 64, "route chunks");
        if (lane < NE) posb[lane] = off[lane] + base[lane];
        int ev[MAXCH]; float pw[MAXCH];
#pragma unroll
        for (int k = 0; k < MAXCH; ++k) { const int aidx = 64 * k + lane; const bool valid = aidx < nas; const size_t gi = valid ? (size_t)RT_TOK(aidx) * 4 + (aidx & 3) : 0;
            ev[k] = valid ? tok_e[gi] : -1; pw[k] = valid ? tok_p[gi] : 0.f; }
#pragma unroll
        for (int k = 0; k < MAXCH; ++k) if (64 * k < nas) {
            const int e = ev[k], aidx = 64 * k + lane; const bool valid = e >= 0;
            unsigned long long m = __ballot(valid);
#pragma unroll
            for (int b = 0; b < 5; ++b) { const bool bit = (e >> b) & 1; const unsigned long long bb = __ballot(bit); m &= bit ? bb : ~bb; }
            const int rank = (int)__builtin_amdgcn_mbcnt_hi((unsigned)(m >> 32), __builtin_amdgcn_mbcnt_lo((unsigned)m, 0u));
            const int rs = posb[valid ? e : 0];
            if (valid && rank == 0) posb[e] = rs + __popcll(m);
            if (valid) { const size_t gi = (size_t)RT_TOK(aidx) * 4 + (aidx & 3); const int pos = rs + rank; tokpos[gi] = pos; roww[pos] = pw[k]; rowtok[pos] = RT_TOK(aidx); } }
    }
    if (wg < NE) { const int p0 = off[wg] + tot[wg], p1 = off[wg + 1]; for (int p = p0 + tid; p < p1; p += NTHR) rowtok[p] = 0; }
#undef RT_TOK
}
__device__ __forceinline__ int moe_tiles(const unsigned char* ws, LAS unsigned char* lds, int tid) {
    const int* eoff = (const int*)(ws + WS_EOFF); LAS int* tab = (LAS int*)(lds + LDS_TAB);
    const int total = eoff[NE];
    const int nMt = total >> 8;
    for (int i = tid; i < nMt; i += NTHR) { const int row = i << 8; int e = 0;
        for (int q = 1; q < NE; ++q) if (eoff[q] <= row) e = q;
        tab[i] = e; }
    __syncthreads();
    return __builtin_amdgcn_readfirstlane(nMt);
}

__device__ __forceinline__ f32x4 fp8x4_to_f32(unsigned w) {
    const f32x2 lo = __builtin_amdgcn_cvt_pk_f32_fp8((int)w, false), hi = __builtin_amdgcn_cvt_pk_f32_fp8((int)w, true);
    return (f32x4){lo.x, lo.y, hi.x, hi.y};
}
constexpr int CB_G2 = 0, CB_SH = 9 * DM * 4, CB_SC = 2 * 9 * DM * 4, CB_GN = 3 * 9 * DM * 4, CB_END = CB_GN + DM * 4;
static_assert(CB_END <= LDS_FREE, "combine LDS");
__device__ __forceinline__ void fp8x16_acc(f32x4 (&acc)[4], const u32x4 y) {
    const unsigned w[4] = {y.x, y.y, y.z, y.w};
#pragma unroll
    for (int i = 0; i < 4; ++i) { const f32x2 lo = __builtin_amdgcn_cvt_pk_f32_fp8((int)w[i], false), hi = __builtin_amdgcn_cvt_pk_f32_fp8((int)w[i], true); acc[i] += (f32x4){lo.x, lo.y, hi.x, hi.y}; }
}
__device__ __forceinline__ void cb_tables(int l, const Args& a, LAS unsigned char* lds, int t, int nt) {
    const float* mods_l = (const float*)(a.ws + WS_MODS) + (size_t)l * 9 * NMOD; const bool more = l < DEPTH - 1;
    LAS float* Lg2 = (LAS float*)(lds + CB_G2); LAS float* Lsh = (LAS float*)(lds + CB_SH); LAS float* Lsc = (LAS float*)(lds + CB_SC); LAS float* Lgn = (LAS float*)(lds + CB_GN);
    for (int i = t; i < 9 * DM; i += nt) { const int r = i >> 10, k = i & 1023;
        Lg2[i] = mods_l[(size_t)r * NMOD + 5 * DM + k] * YR_INV;
        if (more) { Lsh[i] = mods_l[(size_t)(9 + r) * NMOD + k]; Lsc[i] = mods_l[(size_t)(9 + r) * NMOD + DM + k] + 1.f; } }
    for (int i = t; i < DM; i += nt) Lgn[i] = more ? a.in[I_NMIX][(l + 1) * DM + i] : a.in[I_FN][i];
}
template <bool PRE>
__device__ __forceinline__ void ph_combine(int l, int ntok, const Args& a, LAS unsigned char* lds, int gw, int NGW, int tid) {
    const int lane = tid & 63;
    unsigned char* ws = a.ws;
    const bf16_t* XA = (const bf16_t*)(ws + WS_XA); bf16_t* XB = (bf16_t*)(ws + WS_XB); const unsigned char* YR = (const unsigned char*)(ws + WS_YR);
    const int* tokpos = (const int*)(ws + WS_TOKPOS);
    const float* mods_l = (const float*)(ws + WS_MODS) + (size_t)l * 9 * NMOD;
    const bool more = l < DEPTH - 1;
    LAS float* Lg2 = (LAS float*)(lds + CB_G2); LAS float* Lsh = (LAS float*)(lds + CB_SH); LAS float* Lsc = (LAS float*)(lds + CB_SC); LAS float* Lgn = (LAS float*)(lds + CB_GN);
    if (!PRE) cb_tables(l, a, lds, tid, NTHR);
    __syncthreads();
    bf16_t* HA = (bf16_t*)(ws + WS_HA); unsigned char* HA8 = ws + WS_HA8;
    const int k0 = 16 * lane;
    for (int t0 = gw * 2; t0 < ntok; t0 += NGW * 2) {
        u32x4 y[2][4], xr[2][2];
#pragma unroll
        for (int r = 0; r < 2; ++r) { const int t = t0 + r; const int4 pp = *(const int4*)(tokpos + (size_t)t * 4);
            y[r][0] = *(const u32x4*)(YR + (size_t)pp.x * DM + k0); y[r][1] = *(const u32x4*)(YR + (size_t)pp.y * DM + k0);
            y[r][2] = *(const u32x4*)(YR + (size_t)pp.z * DM + k0); y[r][3] = *(const u32x4*)(YR + (size_t)pp.w * DM + k0);
            xr[r][0] = *(const u32x4*)(XA + (size_t)t * DM + k0); xr[r][1] = *(const u32x4*)(XA + (size_t)t * DM + k0 + 8); }
#pragma unroll
        for (int r = 0; r < 2; ++r) { const int t = t0 + r, bi = tok_bidx(t);
            int kt = k0; asm volatile("" : "+v"(kt));
            f32x4 ff[4] = {{0.f, 0.f, 0.f, 0.f}, {0.f, 0.f, 0.f, 0.f}, {0.f, 0.f, 0.f, 0.f}, {0.f, 0.f, 0.f, 0.f}};
            fp8x16_acc(ff, y[r][0]); fp8x16_acc(ff, y[r][1]); fp8x16_acc(ff, y[r][2]); fp8x16_acc(ff, y[r][3]);
            const unsigned xw[8] = {xr[r][0].x, xr[r][0].y, xr[r][0].z, xr[r][0].w, xr[r][1].x, xr[r][1].y, xr[r][1].z, xr[r][1].w};
            f32x4 v[4]; float ss = 0.f;
#pragma unroll
            for (int j = 0; j < 4; ++j) { const f32x4 xv = {bflo(xw[2 * j]), bfhi(xw[2 * j]), bflo(xw[2 * j + 1]), bfhi(xw[2 * j + 1])};
                v[j] = xv + *(const LAS f32x4*)(Lg2 + bi * DM + kt + 4 * j) * ff[j];
                ss += v[j].x * v[j].x + v[j].y * v[j].y + v[j].z * v[j].z + v[j].w * v[j].w; }
            const float rstd = rsqrtf(wave_sum(ss) * (1.f / DM) + EPS);
            if (more) {
                u32x4 xo[2], ho[2]; unsigned h8[4];
#pragma unroll
                for (int j = 0; j < 4; ++j) { const f32x4 y2 = (v[j] * rstd * *(const LAS f32x4*)(Lgn + kt + 4 * j)) * *(const LAS f32x4*)(Lsc + bi * DM + kt + 4 * j) + *(const LAS f32x4*)(Lsh + bi * DM + kt + 4 * j);
                    xo[j >> 1][(j & 1) * 2] = pk2(v[j].x, v[j].y); xo[j >> 1][(j & 1) * 2 + 1] = pk2(v[j].z, v[j].w);
                    ho[j >> 1][(j & 1) * 2] = pk2(y2.x, y2.y); ho[j >> 1][(j & 1) * 2 + 1] = pk2(y2.z, y2.w); h8[j] = pg8::cvt4_fp8(y2.x, y2.y, y2.z, y2.w); }
                *(u32x4*)(XB + (size_t)t * DM + k0) = xo[0]; *(u32x4*)(XB + (size_t)t * DM + k0 + 8) = xo[1];
                *(u32x4*)(HA + (size_t)t * DM + k0) = ho[0]; *(u32x4*)(HA + (size_t)t * DM + k0 + 8) = ho[1];
                *(u32x4*)(HA8 + (size_t)t * DM + k0) = (u32x4){h8[0], h8[1], h8[2], h8[3]};
            } else {
#pragma unroll
                for (int j = 0; j < 4; ++j) *(f32x4*)(a.out + (size_t)t * DM + k0 + 4 * j) = v[j] * rstd * *(const LAS f32x4*)(Lgn + kt + 4 * j);
            } }
    }
    __syncthreads();
}

constexpr int PH_PER_LAYER = 10, N_PHASES = 1 + DEPTH * PH_PER_LAYER;
#if MK_ONE_LAUNCH
#define GRID_BAR() do { XcdBarrier b_ = bar; asm volatile("" : "+s"(b_.bar), "+s"(b_.x)); xcd_barrier(b_, [](int, int) {}); } while (0)
#define GRID_BAR_W(...) do { XcdBarrier b_ = bar; asm volatile("" : "+s"(b_.bar), "+s"(b_.x)); xcd_barrier(b_, [&](int t_, int nt_) { __VA_ARGS__; }); } while (0)
#define GRID_BAR_P(k) do { if constexpr (p0_slot(k) >= 0) GRID_BAR_W((void)nt_; p0_slot_items(load_args(), lds, wg, p0_slot(k), t_)); else GRID_BAR(); } while (0)
#else
#define GRID_BAR() do {} while (0)
#define GRID_BAR_W(...) do {} while (0)
#define GRID_BAR_P(k) do {} while (0)
#endif
#define IN(k) (lo <= (k) && (k) < hi)
#define BOTH(k) (IN(k) && IN((k) + 1))
#define REPEAT(R) _Pragma("unroll") for (int rp_ = 0; rp_ < (R); ++rp_)
#define GWAVE() (wg * NWAVES + wv)
#define ptid() ptid_w(wv)
template <int LAYER>
__device__ __forceinline__ void layer_phases(LAS unsigned char* lds, unsigned char* lds_raw, const XcdBarrier& bar, int lo, int hi, int wg, int G, int wv) {
        constexpr int l = LAYER, pb = 1 + PH_PER_LAYER * l;
        constexpr bool last = (l == DEPTH - 1);
        constexpr int ntok_l = last ? NLAT : NTOK;

        if (IN(pb + 0) && l == 0) { REPEAT(REP_NORM1) { const Args a = load_args();
                const float* xlat = (l == 0) ? a.in[I_X] : (const float*)(a.ws + WS_XB);
                const float* xctx = (l == 0) ? a.in[I_CTX] : (const float*)(a.ws + WS_XB) + (size_t)NLAT * DM;
                ph_norm1(xlat, xctx, a.in[I_NMIX] + l * DM, (const float*)(a.ws + WS_MODS) + (size_t)l * 9 * NMOD, (bf16_t*)(a.ws + WS_HA), a.ws + WS_HA8, GWAVE(), G * NWAVES, ptid() & 63); }
            if (BOTH(pb + 0)) GRID_BAR_P(pb + 0); }

        if (IN(pb + 1)) {
            const Args a = load_args();
            REPEAT(REP_GEMM) {
            { pg8::Gemm g{a.ws + WS_HA8, a.ws + WS_WIN8 + (size_t)l * IN_W * DM, DM};
                constexpr int G8 = last ? 256 : 208;
                pg8::SchedSub<4> S; S.G = (G == 256) ? G8 : G; S.c = wg; S.first = 0; S.cfirst = last ? 2 : 0; S.nctx = last ? 2 : 4; S.rev = false;
                pg8::EpiStoreBf16 E{(bf16_t*)(a.ws + WS_U), IN_W, W8_INV};
                if (wg < S.G) pg8::gemm_phase<true>(lds, g, S, E, ptid()); }
            { pg8::Gemm g{a.ws + WS_HA, (const bf16_t*)(a.ws + WS_WIN) + (size_t)l * IN_W * DM, DM * 2};
                pg8::SchedSub<6> S; S.G = G; S.c = wg; S.first = 4; S.cfirst = 4; S.nctx = last ? 0 : 6; S.rev = true;
                pg8::EpiStoreBf16 E{(bf16_t*)(a.ws + WS_U), IN_W, 1.f};
                pg8::gemm_phase<false>(lds, g, S, E, ptid()); }
            }
            if (BOTH(pb + 1)) GRID_BAR_P(pb + 1);
        }

        if (IN(pb + 2)) REPEAT(REP_PREP) {
            const Args a = load_args();
            ph_qkv(l, a, lds, wg, ptid());
            ph_conv_tiles(l, a, lds, wg, ptid());
            const bf16_t* U = (const bf16_t*)(a.ws + WS_U); bf16_t* F2 = (bf16_t*)(a.ws + WS_F2);
            fm_tables(lds, ptid());
            if (!last && wg >= 128) fm12_unit<true>(wg - 128, U, F2, lds, ptid());
            for (int u = wg; u < 2048; u += G) fm12_unit<false>(u, U, F2, lds, ptid());
            __syncthreads();
            if (rp_ + 1 == REP_PREP && BOTH(pb + 2)) GRID_BAR_P(pb + 2);
        }

        if (IN(pb + 3)) REPEAT(REP_ATTN) {
            const Args a = load_args();
            const unsigned char* QB = a.ws + WS_QB; const unsigned char* KB = a.ws + WS_KB; const unsigned char* VT = a.ws + WS_VB; bf16_t* MIX = (bf16_t*)(a.ws + WS_MIX);
            const int x = wg & 7, rk = wg >> 3;
            const int nun = (!last && wg < 32) ? 3 : 2;
            for (int i = 0; i < nun; ++i) {
                int b, h, kvh, seq; size_t trow;
                if (i < 2) { const int set = i * 8 + x; b = set >> 1; kvh = set & 1; h = kvh * 2 + (rk >> 4); trow = (size_t)b * SEQ + (rk & 15) * 256; seq = SKV; }
                else { b = wg >> 2; h = wg & 3; kvh = h >> 1; trow = (size_t)NLAT + b * CTXL; seq = CTXL; }
                att8::attn_body<512, MIX_W>(QB + trow * 512 + h * 128, KB + (size_t)(b * 2 + kvh) * SKV * 128, VT + (size_t)(b * 2 + kvh) * SKV * 128, MIX + trow * MIX_W + h * 128, seq, (char*)lds_raw, ptid()); }
            const bf16_t* F2 = (const bf16_t*)(a.ws + WS_F2);
            fm_tables(lds, ptid());
            if (!last && wg >= 192) fm3_unit<true>(wg - 192, F2, MIX, lds, ptid());
            for (int u = wg; u < 1024; u += G) fm3_unit<false>(u, F2, MIX, lds, ptid());
            if (rp_ + 1 == REP_ATTN && BOTH(pb + 3)) GRID_BAR_P(pb + 3);
        }

        if (IN(pb + 4)) {
            const Args a = load_args();
            pg8::Gemm g{a.ws + WS_MIX, (const bf16_t*)(a.ws + WS_WOUT) + (size_t)l * DM * MIX_W, MIX_W * 2};
            pg8::SchedGrid<4> S; S.G = G; S.c = wg; S.nM = ntok_l / 256;
            const float* gate = (const float*)(a.ws + WS_MODS) + (size_t)l * 9 * NMOD + 2 * DM;
            if (l == 0) { pg8::EpiResidual<false> E{a.in[I_X], a.in[I_CTX], (bf16_t*)(a.ws + WS_XA), gate};
                REPEAT(REP_GEMM) pg8::gemm_phase<false>(lds, g, S, E, ptid());
                if (G == NWG && wg >= 32) { const int t_ = ptid(); p0_items(a, lds, (wg - 32) * NWAVES + (t_ >> 6), (NWG - 32) * NWAVES, P0_ITEMS - P0_DEFER, P0_ITEMS, t_); __syncthreads(); }
                else if (G != NWG) { const int t_ = ptid(); p0_items(a, lds, wg * NWAVES + (t_ >> 6), G * NWAVES, P0_ITEMS - P0_DEFER, P0_ITEMS, t_); __syncthreads(); } }
            else { pg8::EpiResidual<true> E{a.ws + WS_XB, a.ws + WS_XB + (size_t)NLAT * DM * 2, (bf16_t*)(a.ws + WS_XA), gate};
                REPEAT(REP_GEMM) pg8::gemm_phase<false>(lds, g, S, E, ptid()); }
            if (BOTH(pb + 4)) GRID_BAR_W(n2_tables(l, load_args(), lds, t_, nt_));
        }

        if (IN(pb + 5)) { REPEAT(REP_N2) { const Args a = load_args(); ph_norm2<MK_ONE_LAUNCH != 0>(l, ntok_l, a, lds, wg, ptid()); __syncthreads(); } if (BOTH(pb + 5)) GRID_BAR_P(pb + 5); }
        if (IN(pb + 6)) { REPEAT(REP_ROUTE) { const Args a = load_args(); ph_route(ntok_l, a, lds, wg, ptid()); __syncthreads(); } if (BOTH(pb + 6)) GRID_BAR_P(pb + 6); }

        if (IN(pb + 7)) {
            const Args a = load_args();
#if MK_ONE_LAUNCH
            const int nMt = __builtin_amdgcn_readfirstlane(((const LAS int*)(lds + LDS_TAB))[LDS_TAB_NMT]);
#else
            const int nMt = moe_tiles(a.ws, lds, ptid());
#endif
            { const int* rowtok = (const int*)(a.ws + WS_ROWTOK); LAS int* ltok = (LAS int*)(lds + LDS_LTOK); const int t_ = ptid();
                const int nun = (nMt * 8 - wg + G - 1) / G;
                for (int idx = t_; idx < nun * 256; idx += NTHR) { int pm, pn; pg8::tile_order<8>((idx >> 8) * G + wg, nMt, pm, pn); ltok[idx] = rowtok[pm * 256 + (idx & 255)]; }
                __syncthreads(); }
            pg8::Gemm g{a.ws + WS_H8, a.ws + WS_WUP + (size_t)l * NE * 2048 * DM, DM};
            pg8::SchedMoe<8, true> S{G, wg, nMt, (const LAS int*)(lds + LDS_TAB), (const LAS int*)(lds + LDS_LTOK)};
            pg8::EpiSwiGLU E{(unsigned char*)(a.ws + WS_ACT), a.in[I_BUP] + (size_t)l * NE * 2048};
            REPEAT(REP_MOE) pg8::gemm_phase<true>(lds, g, S, E, ptid());
            if (BOTH(pb + 7)) GRID_BAR_P(pb + 7);
        }
        if (IN(pb + 8)) {
            const Args a = load_args();
#if MK_ONE_LAUNCH
            const int nMt = __builtin_amdgcn_readfirstlane(((const LAS int*)(lds + LDS_TAB))[LDS_TAB_NMT]);
#else
            const int nMt = moe_tiles(a.ws, lds, ptid());
#endif
            pg8::Gemm g{a.ws + WS_ACT, a.ws + WS_WDN + (size_t)l * NE * DM * DFF, DFF};
            pg8::SchedMoe<4, false> S{G, wg, nMt, (const LAS int*)(lds + LDS_TAB), nullptr};
            pg8::EpiDown E{(unsigned char*)(a.ws + WS_YR), a.in[I_BDN] + (size_t)l * NE * DM, (const float*)(a.ws + WS_ROWW)};
            REPEAT(REP_MOE) pg8::gemm_phase<true>(lds, g, S, E, ptid());
            if (BOTH(pb + 8)) GRID_BAR_W(cb_tables(l, load_args(), lds, t_, nt_));
        }
        if (IN(pb + 9)) { REPEAT(REP_COMB) { const Args a = load_args(); ph_combine<MK_ONE_LAUNCH != 0>(l, ntok_l, a, lds, GWAVE(), G * NWAVES, ptid()); } if (BOTH(pb + 9)) GRID_BAR_P(pb + 9); }
}

__global__ void __launch_bounds__(NTHR, 2) mk_fwd(Args a_kernarg) {
    extern __shared__ __attribute__((aligned(16))) unsigned char lds_raw[];
    LAS unsigned char* lds = (LAS unsigned char*)lds_raw;
    const int wg = blockIdx.x, G = gridDim.x, wv = __builtin_amdgcn_readfirstlane(threadIdx.x >> 6);
    volatile LAS unsigned* lctl = (volatile LAS unsigned*)(lds + LDS_CTL);
    if (threadIdx.x < 64) lctl[threadIdx.x] = 0u;
    __syncthreads();
#if MK_ONE_LAUNCH
    XcdBarrier bar = xcd_barrier_post((unsigned*)(a_kernarg.ws + WS_CTL) + 4096, lctl);
#else
    XcdBarrier bar; bar.bar = nullptr; bar.x = 0; bar.st = nullptr;
#endif
    const int lo = a_kernarg.ph_lo, hi = a_kernarg.ph_hi;
    if (IN(0)) { REPEAT(REP_P0) { const Args a = load_args(); p0_prologue(a, lds, wg, ptid()); __syncthreads(); } if (BOTH(0)) GRID_BAR_P(0); }

    layer_phases<0>(lds, lds_raw, bar, lo, hi, wg, G, wv);
    layer_phases<1>(lds, lds_raw, bar, lo, hi, wg, G, wv);
}

extern "C" void kernel_launch(void* const* d_in, const int* in_sizes, int n_in, void* d_out, int out_size, void* d_ws, size_t ws_size, hipStream_t stream) {
    static int ok = 0;
    if (ok == 0) {
        if (n_in != 24 || in_sizes[0] != NLAT * DM || out_size != NLAT * DM || ws_size < WS_END) {
            fprintf(stderr, "kernel_launch: shape mismatch (n_in %d, in0 %d, out %d, ws %zu; need ws >= %zu)\n", n_in, n_in > 0 ? in_sizes[0] : -1, out_size, ws_size, (size_t)WS_END); ok = -1; return; }
        if (hipFuncSetAttribute((const void*)mk_fwd, hipFuncAttributeMaxDynamicSharedMemorySize, LDS_BYTES) != hipSuccess) { fprintf(stderr, "kernel_launch: hipFuncSetAttribute failed\n"); ok = -1; return; }
        int per_cu = 0;
        if (hipOccupancyMaxActiveBlocksPerMultiprocessor(&per_cu, (const void*)mk_fwd, NTHR, LDS_BYTES) != hipSuccess || per_cu < 1)
            fprintf(stderr, "kernel_launch: note: occupancy query reports %d workgroups per CU\n", per_cu);
        (void)hipGetLastError();
        ok = 1;
    }
    if (ok < 0) return;
    if (hipMemsetAsync((char*)d_ws + WS_CTL, 0, CTL_ZERO_BYTES, stream) != hipSuccess) { fprintf(stderr, "kernel_launch: memset failed\n"); return; }
    Args a{};
    for (int i = 0; i < 24; ++i) a.in[i] = (const float*)d_in[i];
    a.out = (float*)d_out; a.ws = (unsigned char*)d_ws;
#if MK_ONE_LAUNCH
    a.ph_lo = 0; a.ph_hi = N_PHASES;
    hipLaunchKernelGGL(mk_fwd, dim3(NWG), dim3(NTHR), LDS_BYTES, stream, a);
#else
    for (int p = 0; p < N_PHASES; ++p) { a.ph_lo = p; a.ph_hi = p + 1; hipLaunchKernelGGL(mk_fwd, dim3(NWG), dim3(NTHR), LDS_BYTES, stream, a); }
#endif
    const hipError_t le = hipPeekAtLastError();
    if (le != hipSuccess) fprintf(stderr, "kernel_launch: launch failed: %s\n", hipGetErrorName(le));
}
```

```cpp
#include <hip/hip_runtime.h>
#include <cstdio>
#include <cstdint>

#ifndef MK_ONE_LAUNCH
#define MK_ONE_LAUNCH 1
#endif

#ifndef REP_P0
#define REP_P0 1
#endif
#ifndef REP_NORM1
#define REP_NORM1 1
#endif
#ifndef REP_PREP
#define REP_PREP 1
#endif
#ifndef REP_N2
#define REP_N2 1
#endif
#ifndef REP_ROUTE
#define REP_ROUTE 1
#endif
#ifndef REP_COMB
#define REP_COMB 1
#endif
#ifndef REP_GEMM
#define REP_GEMM 1
#endif
#ifndef REP_ATTN
#define REP_ATTN 1
#endif
#ifndef REP_MOE
#define REP_MOE 1
#endif
#define LAS __attribute__((address_space(3)))
#define GAS __attribute__((address_space(1)))
typedef unsigned short bf16_t;
typedef short bf16x8 __attribute__((ext_vector_type(8)));
typedef short s16x4 __attribute__((ext_vector_type(4)));
typedef float f32x2 __attribute__((ext_vector_type(2)));
typedef float f32x4 __attribute__((ext_vector_type(4)));
typedef float f32x8 __attribute__((ext_vector_type(8)));
typedef float f32x16 __attribute__((ext_vector_type(16)));
typedef unsigned u32x2 __attribute__((ext_vector_type(2)));
typedef unsigned u32x4 __attribute__((ext_vector_type(4)));

constexpr int DM = 1024, BATCH = 8, SEQ = 4096, CTXL = 256, DEPTH = 2;
constexpr int NLAT = BATCH * SEQ, NCTX = BATCH * CTXL, NTOK = NLAT + NCTX;
constexpr int IN_W = 2560, MIX_W = 1280, NE = 32, TOPK = 4, DFF = 1024;
constexpr int SKV = CTXL + SEQ;
constexpr int NMOD = 6 * DM;
constexpr int MPAD = (NTOK * TOPK / 256 + NE) * 256;
constexpr float EPS = 1e-6f;
constexpr int NWG = 256, NTHR = 512, NWAVES = 8;

constexpr size_t MiB = 1u << 20;
constexpr size_t WS_CTL = 0, CTL_ZERO_BYTES = 1 * MiB;
constexpr size_t WS_MODS = 1 * MiB;
constexpr size_t WS_CNT = 2 * MiB;
constexpr size_t WS_EOFF = WS_CNT + 64 * 1024;
constexpr size_t WS_TOKE = 3 * MiB;
constexpr size_t WS_TOKP = 4 * MiB;
constexpr size_t WS_TOKPOS = 5 * MiB;
constexpr size_t WS_ROWW = 6 * MiB;
constexpr size_t WS_ROWTOK = 7 * MiB;
constexpr size_t WS_WIN = 8 * MiB;
constexpr size_t WS_WOUT = 18 * MiB;
constexpr size_t WS_WUP = 24 * MiB;
constexpr size_t WS_WDN = 152 * MiB;
constexpr size_t WS_H8 = 216 * MiB;
constexpr size_t WS_HA8 = 252 * MiB;
constexpr size_t WS_WIN8 = 288 * MiB;
constexpr size_t WS_HA = 408 * MiB;
constexpr size_t WS_XA = 476 * MiB;
constexpr size_t WS_XB = 612 * MiB;
constexpr size_t WS_S = 748 * MiB;
constexpr size_t WS_U = WS_S;
constexpr size_t WS_QB = WS_S + 170 * MiB;
constexpr size_t WS_KB = WS_S + 204 * MiB;
constexpr size_t WS_VB = WS_S + 221 * MiB;
constexpr size_t WS_MIX = WS_S + 238 * MiB;
constexpr size_t WS_F2 = WS_S + 323 * MiB;
constexpr size_t WS_ACT = WS_S + 360 * MiB;
constexpr size_t WS_YR = WS_S;
constexpr size_t WS_END = WS_S + 648 * MiB;
static_assert(WS_F2 + (size_t)NTOK * 512 * 2 <= WS_ACT && WS_YR + (size_t)MPAD * 1024 * 2 <= WS_ACT && WS_H8 + (size_t)NTOK * 1024 <= WS_HA && WS_WDN + 2ull * 32 * 1024 * 1024 <= WS_H8, "ws map");
constexpr float YR_SCALE = 16.f, YR_INV = 1.f / 16.f;
constexpr float W8_SCALE = 64.f, W8_INV = 1.f / 64.f;

constexpr int LDS_BYTES = 163840;
constexpr int LDS_LTOK = 131072;
constexpr int LDS_TAB = 159744;
constexpr int LDS_TAB_NMT = 700;
constexpr int LDS_CTL = 163584;
constexpr int LDS_FREE = 159744;

typedef float f32x2_t_ __attribute__((ext_vector_type(2)));
typedef __bf16 bf16x2_t_ __attribute__((ext_vector_type(2)));
__device__ __forceinline__ unsigned f2bf(float f) { const __bf16 b = (__bf16)f; return (unsigned)__builtin_bit_cast(unsigned short, b); }
__device__ __forceinline__ unsigned pk2(float lo, float hi) { const f32x2_t_ v = {lo, hi}; const bf16x2_t_ b = __builtin_convertvector(v, bf16x2_t_); return __builtin_bit_cast(unsigned, b); }
__device__ __forceinline__ float bf2f(unsigned h) { return __builtin_bit_cast(float, h << 16); }
__device__ __forceinline__ float bflo(unsigned w) { return __builtin_bit_cast(float, w << 16); }
__device__ __forceinline__ float bfhi(unsigned w) { return __builtin_bit_cast(float, w & 0xffff0000u); }
template <int M> __device__ __forceinline__ float xor_swz(float v) { return __builtin_bit_cast(float, __builtin_amdgcn_ds_swizzle(__builtin_bit_cast(int, v), (M << 10) | 0x1f)); }
__device__ __forceinline__ float xor32(float v, bool upper) { auto r = __builtin_amdgcn_permlane32_swap(__float_as_uint(v), __float_as_uint(v), false, false); return __uint_as_float(upper ? r[0] : r[1]); }
__device__ __forceinline__ float wave_sum(float v) {
    v += xor_swz<1>(v); v += xor_swz<2>(v); v += xor_swz<4>(v); v += xor_swz<8>(v); v += xor_swz<16>(v);
    auto r = __builtin_amdgcn_permlane32_swap(__float_as_uint(v), __float_as_uint(v), false, false);
    return __uint_as_float(r[0]) + __uint_as_float(r[1]);
}
__device__ __forceinline__ float sigmoidf_(float x) { return __builtin_amdgcn_rcpf(1.f + __builtin_amdgcn_exp2f(x * -1.4426950408889634f)); }
__device__ __forceinline__ void sincos_rev(float rev, float& sn, float& cs) { const float fr = __builtin_amdgcn_fractf(rev); sn = __builtin_amdgcn_sinf(fr); cs = __builtin_amdgcn_cosf(fr); }
__device__ __forceinline__ int tok_bidx(int t) { return t < NLAT ? (t >> 12) : 8; }
#define LDS_WAIT() asm volatile("s_waitcnt lgkmcnt(0)" ::: "memory")

__device__ __forceinline__ int ptid_w(int wv) { unsigned m = ~0u; asm volatile("" : "+s"(m)); int l = (int)__builtin_amdgcn_mbcnt_hi(m, __builtin_amdgcn_mbcnt_lo(m, 0u)); asm volatile("" : "+v"(l)); return (wv << 6) | l; }

namespace pg8 {
#define PG8_LAS __attribute__((address_space(3)))
constexpr int BM = 256, BK = 64, HALF = 128, HTB = HALF * BK * 2, STAGE_BYTES = 8 * HTB;
__host__ __device__ __forceinline__ int lds_byte(int r, int c) { const int st = (r >> 4) * 2 + (c >> 5), rr = r & 15, cc = c & 31, ob = rr * 64 + cc * 2; return st * 1024 + (ob ^ (((ob >> 9) & 1) << 5)); }
__host__ __device__ __forceinline__ void stage_rc(int b, int& R, int& C) { const int st = b / 1024, sb = b % 1024, swz = sb ^ (((sb >> 9) & 1) << 5); R = (st >> 1) * 16 + swz / 64; C = (st & 1) * 32 + (swz % 64) / 2; }
__host__ __device__ __forceinline__ int perm32(int rho) { const int n = rho >> 4, i = rho & 15; return 8 * (i >> 2) + 4 * n + (i & 3); }
__host__ __device__ __forceinline__ int perm64(int R) { return (R >> 5) * 64 + ((R >> 2) & 3) * 16 + ((R >> 4) & 1) * 4 + (R & 3); }
struct Unit { int pm, pn; };
struct Gemm { const void* A; const void* Bt; int Kb; };
__device__ __forceinline__ unsigned cvt_pk_bf16(float lo, float hi) { unsigned r; asm volatile("v_cvt_pk_bf16_f32 %0, %1, %2" : "=v"(r) : "v"(lo), "v"(hi)); return r; }
typedef int v8i __attribute__((ext_vector_type(8)));
typedef int v4i __attribute__((ext_vector_type(4)));
__device__ __forceinline__ v8i cat8(bf16x8 a, bf16x8 b) { const v4i x = __builtin_bit_cast(v4i, a), y = __builtin_bit_cast(v4i, b); return (v8i){x[0], x[1], x[2], x[3], y[0], y[1], y[2], y[3]}; }
__device__ __forceinline__ unsigned cvt4_fp8(float a, float b, float c, float d) { int r = 0; r = __builtin_amdgcn_cvt_pk_fp8_f32(a, b, r, false); r = __builtin_amdgcn_cvt_pk_fp8_f32(c, d, r, true); return (unsigned)r; }

template <int nN>
__device__ __forceinline__ void tile_order(int L, int nM, int& pm, int& pn) {
    const int nwg = nM * nN; int wgid = L;
    { const int q = nwg >> 3, r = nwg & 7, xcd = wgid & 7, off = wgid >> 3; wgid = (xcd < r ? xcd * (q + 1) : r * (q + 1) + (xcd - r) * q) + off; }
    constexpr int nig = 8 * nN; const int gid = wgid / nig, fm = gid * 8, gsz = (nM - fm) < 8 ? (nM - fm) : 8, rem = wgid - gid * nig;
    if (gsz == 8) { pm = fm + (rem & 7); pn = rem >> 3; } else { pn = rem / gsz; pm = fm + (rem - pn * gsz); }
}

template <bool FP8, class Epi, class Sched>
__device__ __forceinline__ void gemm_phase(PG8_LAS unsigned char* lds, const Gemm g, const Sched& S, const Epi& E, const int tid) {
    const int wid = __builtin_amdgcn_readfirstlane(tid >> 6), lane = tid & 63, wr = wid >> 2, wc = wid & 3, fr = lane & 15, fq = lane >> 4;
    const int Kb = g.Kb, nt = Kb / (BK * 2);
    constexpr bool GATHER = Sched::GATHER;
    unsigned voffA[2], voffB[2]; int rcA[2];
#pragma unroll
    for (int i = 0; i < 2; ++i) { int R, C; stage_rc(tid * 16 + i * 8192, R, C); const int Rb = Epi::PERM == 2 ? perm64(R) : Epi::PERM ? ((R & ~31) + perm32(R & 31)) : R;
        voffA[i] = (unsigned)(R * Kb + C * 2); voffB[i] = (unsigned)(Rb * Kb + C * 2); rcA[i] = (R << 8) | (C * 2); }
    unsigned gc[2][2];
#define PG8_GOFF(uidx) do { if constexpr (GATHER) { _Pragma("unroll") for (int h_ = 0; h_ < 2; ++h_) _Pragma("unroll") for (int i_ = 0; i_ < 2; ++i_) \
        gc[h_][i_] = (unsigned)S.ltok[(uidx) * 256 + h_ * 128 + (rcA[i_] >> 8)] * (unsigned)Kb + (unsigned)(rcA[i_] & 255); } } while (0)
#define PG8_STAGE_A(bufoff, kptr, half) do { if constexpr (GATHER) PG8_STAGE(bufoff, kptr, gc[half]); else PG8_STAGE(bufoff, (kptr) + (half) * hstep, voffA); } while (0)
    const size_t kstep = (size_t)(BK * 2);
    const size_t hstep = (size_t)HALF * Kb;
    const size_t tstep = 2 * hstep;
    const size_t hstepB = Epi::PERM == 2 ? (size_t)8 * Kb : hstep;
    const unsigned ldsw = (unsigned)wid * 1024u;
    const int aoff = lds_byte(wr * 64 + fr, fq * 8), boff = lds_byte(wc * 32 + fr, fq * 8);
#define PG8_SA(b, h) (((b) * 2 + (h)) * HTB)
#define PG8_SB(b, h) ((4 + (b) * 2 + (h)) * HTB)
#define PG8_STAGE(bufoff, gbase, voff) do { _Pragma("unroll") for (int _i = 0; _i < 2; ++_i) { unsigned _vo = (voff)[_i]; asm volatile("" : "+v"(_vo));   \
        __builtin_amdgcn_global_load_lds((const unsigned*)((const char*)(gbase) + _vo), (PG8_LAS unsigned*)(lds + (bufoff) + ldsw + _i * 8192), 16, 0, 0); } } while (0)
#define PG8_LDA(dst, b, h) do { _Pragma("unroll") for (int m = 0; m < 4; ++m) _Pragma("unroll") for (int k = 0; k < 2; ++k) dst[m][k] = *(const PG8_LAS bf16x8*)(lds + PG8_SA(b, h) + aoff + m * 2048 + k * 1024); } while (0)
#define PG8_LDB(dst, b, h) do { _Pragma("unroll") for (int n = 0; n < 2; ++n) _Pragma("unroll") for (int k = 0; k < 2; ++k) dst[n][k] = *(const PG8_LAS bf16x8*)(lds + PG8_SB(b, h) + boff + n * 2048 + k * 1024); } while (0)
#define PG8_MMA(ai, bj, At, Bt) do { __builtin_amdgcn_s_setprio(1); _Pragma("unroll") for (int m = 0; m < 4; ++m) _Pragma("unroll") for (int n = 0; n < 2; ++n) { \
        if constexpr (FP8) acc[ai][bj][m][n] = __builtin_amdgcn_mfma_scale_f32_16x16x128_f8f6f4(cat8(Bt[n][0], Bt[n][1]), cat8(At[m][0], At[m][1]), acc[ai][bj][m][n], 0, 0, 0, 0, 0, 0); \
        else { _Pragma("unroll") for (int k = 0; k < 2; ++k) acc[ai][bj][m][n] = __builtin_amdgcn_mfma_f32_16x16x32_bf16(Bt[n][k], At[m][k], acc[ai][bj][m][n], 0, 0, 0); } } \
        __builtin_amdgcn_s_setprio(0); } while (0)
#define PG8_WAIT_V(n) asm volatile("s_waitcnt vmcnt(" #n ")" ::: "memory")
#define PG8_WAIT_L(n) asm volatile("s_waitcnt lgkmcnt(" #n ")" ::: "memory")
#define PG8_BAR __builtin_amdgcn_s_barrier()
#define PG8_SCHED __builtin_amdgcn_sched_barrier(0)
    Unit cur, nxt; int ui = 0;
    if (!S.next(0, cur)) return;
    f32x4 acc[2][2][4][2];
#pragma unroll
    for (int a = 0; a < 2; ++a)
#pragma unroll
        for (int b = 0; b < 2; ++b)
#pragma unroll
            for (int m = 0; m < 4; ++m)
#pragma unroll
                for (int n = 0; n < 2; ++n) acc[a][b][m][n] = (f32x4){0.f, 0.f, 0.f, 0.f};
    bf16x8 At[4][2], B0[2][2], B1[2][2];
    const char* cA = (const char*)g.A + (GATHER ? (size_t)0 : (size_t)cur.pm * tstep); const char* cB = (const char*)g.Bt + (size_t)cur.pn * tstep;
    PG8_GOFF(0);
    PG8_STAGE(PG8_SB(0, 0), cB, voffB); PG8_STAGE(PG8_SB(0, 1), cB + hstepB, voffB); PG8_STAGE_A(PG8_SA(0, 0), cA, 0); PG8_STAGE_A(PG8_SA(0, 1), cA, 1);
    if (wr == 1) PG8_BAR;
    PG8_WAIT_V(2); PG8_BAR;
    PG8_STAGE(PG8_SB(1, 0), cB + kstep, voffB); PG8_STAGE_A(PG8_SA(1, 0), cA + kstep, 0); PG8_STAGE(PG8_SB(1, 1), cB + hstepB + kstep, voffB);
    PG8_WAIT_V(6); PG8_BAR;
    for (;;) {
        const bool has_next = S.next(ui + 1, nxt);
        const char* nA = (has_next && !GATHER) ? (const char*)g.A + (size_t)nxt.pm * tstep : cA; const char* nB = has_next ? (const char*)g.Bt + (size_t)nxt.pn * tstep : cB;
        for (int t = 0; t < nt; t += 2) {
            const bool last = (t == nt - 2);
            const char* a1 = cA + (size_t)(t + 1) * kstep;
            const char* a2 = last ? nA : cA + (size_t)(t + 2) * kstep; const char* b2 = last ? nB : cB + (size_t)(t + 2) * kstep;
            const char* a3 = a2 + kstep; const char* b3 = b2 + kstep;
            PG8_LDB(B0, 0, 0); PG8_LDB(B1, 0, 1); PG8_SCHED; PG8_LDA(At, 0, 0); PG8_STAGE_A(PG8_SA(1, 1), a1, 1); if (last && has_next) PG8_GOFF(ui + 1);
            PG8_WAIT_V(8); PG8_WAIT_L(0); PG8_BAR; PG8_MMA(0, 0, At, B0); PG8_MMA(0, 1, At, B1); PG8_BAR; PG8_SCHED;
            PG8_LDA(At, 0, 1); PG8_STAGE(PG8_SB(0, 0), b2, voffB); PG8_STAGE(PG8_SB(0, 1), b2 + hstepB, voffB); PG8_STAGE_A(PG8_SA(0, 0), a2, 0);
            PG8_WAIT_V(8); PG8_WAIT_L(0); PG8_BAR; PG8_MMA(1, 0, At, B0); PG8_MMA(1, 1, At, B1); PG8_BAR; PG8_SCHED;
            PG8_LDB(B0, 1, 0); PG8_LDB(B1, 1, 1); PG8_SCHED; PG8_LDA(At, 1, 0); PG8_STAGE_A(PG8_SA(0, 1), a2, 1);
            PG8_WAIT_V(8); PG8_WAIT_L(0); PG8_BAR; PG8_MMA(0, 0, At, B0); PG8_MMA(0, 1, At, B1); PG8_BAR; PG8_SCHED;
            PG8_LDA(At, 1, 1); PG8_STAGE(PG8_SB(1, 0), b3, voffB); PG8_STAGE(PG8_SB(1, 1), b3 + hstepB, voffB); PG8_STAGE_A(PG8_SA(1, 0), a3, 0);
            PG8_WAIT_V(8); PG8_WAIT_L(0); PG8_BAR; PG8_MMA(1, 0, At, B0); PG8_MMA(1, 1, At, B1); PG8_BAR; PG8_SCHED;
        }
        if (wr == 0) PG8_BAR;
        { const int l2 = ptid_w(wid) & 63; E(acc, cur, wr, wc, l2 & 15, l2 >> 4); }
        if (!has_next) break;
#pragma unroll
        for (int a = 0; a < 2; ++a)
#pragma unroll
            for (int b = 0; b < 2; ++b)
#pragma unroll
                for (int m = 0; m < 4; ++m)
#pragma unroll
                    for (int n = 0; n < 2; ++n) acc[a][b][m][n] = (f32x4){0.f, 0.f, 0.f, 0.f};
        cur = nxt; cA = nA; cB = nB; ++ui;
        if (wr == 1) PG8_BAR;
    }
    PG8_WAIT_V(0);
    PG8_BAR;
#undef PG8_SA
#undef PG8_SB
#undef PG8_STAGE
#undef PG8_STAGE_A
#undef PG8_GOFF
#undef PG8_LDA
#undef PG8_LDB
#undef PG8_MMA
#undef PG8_WAIT_V
#undef PG8_WAIT_L
#undef PG8_BAR
#undef PG8_SCHED
}

struct EpiStoreBf16 {
    static constexpr int PERM = 2;
    bf16_t* O; int ldc; float sc;
    __device__ __forceinline__ void operator()(const f32x4 (&acc)[2][2][4][2], const Unit& u, int wr, int wc, int fr, int fq) const {
        const int row0 = u.pm * BM + wr * 64 + fr, col0 = u.pn * BM + wc * 64 + 16 * fq;
#pragma unroll
        for (int ai = 0; ai < 2; ++ai)
#pragma unroll
            for (int m = 0; m < 4; ++m) { bf16_t* rowp = O + (size_t)(row0 + ai * HALF + m * 16) * ldc + col0;
#pragma unroll
                for (int bj = 0; bj < 2; ++bj) { const f32x4 v0 = acc[ai][bj][m][0] * sc, v1 = acc[ai][bj][m][1] * sc;
                    u32x4 w; w.x = cvt_pk_bf16(v0[0], v0[1]); w.y = cvt_pk_bf16(v0[2], v0[3]); w.z = cvt_pk_bf16(v1[0], v1[1]); w.w = cvt_pk_bf16(v1[2], v1[3]);
                    *(u32x4*)(rowp + bj * 8) = w; } }
    }
};
template <bool XBF16>
struct EpiResidual {
    static constexpr int PERM = 2;
    const void* xlat; const void* xctx; bf16_t* out; const float* gate;
    __device__ __forceinline__ void operator()(const f32x4 (&acc)[2][2][4][2], const Unit& u, int wr, int wc, int fr, int fq) const {
        const int row0 = u.pm * BM + wr * 64 + fr, col0 = u.pn * BM + wc * 64 + 16 * fq;
        const int bidx = (u.pm < NLAT / 256) ? (u.pm >> 4) : 8;
        const float* gp = gate + (size_t)bidx * NMOD + col0;
        f32x4 gv[2][2];
#pragma unroll
        for (int bj = 0; bj < 2; ++bj)
#pragma unroll
            for (int n = 0; n < 2; ++n) gv[bj][n] = *(const f32x4*)(gp + bj * 8 + 4 * n);
#pragma unroll
        for (int ai = 0; ai < 2; ++ai)
#pragma unroll
            for (int m = 0; m < 4; ++m) { const int row = row0 + ai * HALF + m * 16;
                bf16_t* orow = out + (size_t)row * DM + col0;
#pragma unroll
                for (int bj = 0; bj < 2; ++bj) { f32x4 x0, x1;
                    if constexpr (XBF16) { const bf16_t* xr = (row < NLAT ? (const bf16_t*)xlat + (size_t)row * DM : (const bf16_t*)xctx + (size_t)(row - NLAT) * DM) + col0 + bj * 8;
                        const u32x4 xb = *(const u32x4*)xr; x0 = (f32x4){bflo(xb.x), bfhi(xb.x), bflo(xb.y), bfhi(xb.y)}; x1 = (f32x4){bflo(xb.z), bfhi(xb.z), bflo(xb.w), bfhi(xb.w)}; }
                    else { const float* xr = (row < NLAT ? (const float*)xlat + (size_t)row * DM : (const float*)xctx + (size_t)(row - NLAT) * DM) + col0 + bj * 8;
                        x0 = *(const f32x4*)xr; x1 = *(const f32x4*)(xr + 4); }
                    const f32x4 v0 = x0 + gv[bj][0] * acc[ai][bj][m][0], v1 = x1 + gv[bj][1] * acc[ai][bj][m][1];
                    u32x4 w; w.x = cvt_pk_bf16(v0[0], v0[1]); w.y = cvt_pk_bf16(v0[2], v0[3]); w.z = cvt_pk_bf16(v1[0], v1[1]); w.w = cvt_pk_bf16(v1[2], v1[3]);
                    *(u32x4*)(orow + bj * 8) = w; } }
    }
};
struct EpiSwiGLU {
    static constexpr int PERM = 1;
    unsigned char* O; const float* bup;
    __device__ __forceinline__ void operator()(const f32x4 (&acc)[2][2][4][2], const Unit& u, int wr, int wc, int fr, int fq) const {
        const int e = u.pn >> 3, pnl = u.pn & 7;
        const int row0 = u.pm * BM + wr * 64 + fr, ac0 = pnl * 128 + wc * 32 + 8 * fq;
        const float* bp = bup + (size_t)e * 2048 + 2 * ac0;
        f32x4 bb[4];
#pragma unroll
        for (int q = 0; q < 4; ++q) bb[q] = *(const f32x4*)(bp + 4 * q);
        f32x2 bg[4], bl[4];
#pragma unroll
        for (int p = 0; p < 4; ++p) { bg[p] = (f32x2){bb[p][0], bb[p][2]}; bl[p] = (f32x2){bb[p][1] + 1.f, bb[p][3] + 1.f}; }
        unsigned char* cbase = O + (size_t)(row0 + (fq & 1) * 16) * DFF + (ac0 - 8 * (fq & 1));
#pragma unroll
        for (int ai = 0; ai < 2; ++ai)
#pragma unroll
            for (int mp = 0; mp < 2; ++mp) { u32x2 wq[2];
#pragma unroll
                for (int mi = 0; mi < 2; ++mi) { const int m = 2 * mp + mi;
                    float r[8];
#pragma unroll
                    for (int p = 0; p < 4; ++p) { const int n = p >> 1, i0 = (p & 1) * 2;
                        f32x2 gt = (f32x2){acc[ai][0][m][n][i0], acc[ai][0][m][n][i0 + 1]} * W8_INV + bg[p];
                        f32x2 ln = (f32x2){acc[ai][1][m][n][i0], acc[ai][1][m][n][i0 + 1]} * W8_INV + bl[p];
                        gt.x = fminf(gt.x, 7.f); gt.y = fminf(gt.y, 7.f);
                        ln.x = __builtin_amdgcn_fmed3f(ln.x, -6.f, 8.f); ln.y = __builtin_amdgcn_fmed3f(ln.y, -6.f, 8.f);
                        const f32x2 ex = gt * (-1.702f * 1.4426950408889634f);
                        f32x2 dn = (f32x2){__builtin_amdgcn_exp2f(ex.x), __builtin_amdgcn_exp2f(ex.y)} + 1.f;
                        dn.x = __builtin_amdgcn_rcpf(dn.x); dn.y = __builtin_amdgcn_rcpf(dn.y);
                        const f32x2 rr = (gt * dn) * ln;
                        r[2 * p] = rr.x; r[2 * p + 1] = rr.y; }
                    wq[mi].x = cvt4_fp8(r[0], r[1], r[2], r[3]); wq[mi].y = cvt4_fp8(r[4], r[5], r[6], r[7]); }
                const auto s0 = __builtin_amdgcn_permlane16_swap(wq[0].x, wq[1].x, false, false), s1 = __builtin_amdgcn_permlane16_swap(wq[0].y, wq[1].y, false, false);
                u32x4 w; w.x = s0[0]; w.y = s1[0]; w.z = s0[1]; w.w = s1[1];
                *(u32x4*)(cbase + (size_t)(ai * HALF + mp * 32) * DFF) = w; }
    }
};
struct EpiDown {
    static constexpr int PERM = 2;
    unsigned char* O; const float* bdn; const float* roww;
    __device__ __forceinline__ void operator()(const f32x4 (&acc)[2][2][4][2], const Unit& u, int wr, int wc, int fr, int fq) const {
        const int e = u.pn >> 2, pnl = u.pn & 3;
        const int row0 = u.pm * BM + wr * 64 + fr, col0 = pnl * BM + wc * 64 + 16 * fq;
        const float* bp = bdn + (size_t)e * DM + col0;
        f32x4 bv[2][2];
#pragma unroll
        for (int bj = 0; bj < 2; ++bj)
#pragma unroll
            for (int n = 0; n < 2; ++n) bv[bj][n] = *(const f32x4*)(bp + 8 * bj + 4 * n);
        float rwv[2][4];
#pragma unroll
        for (int ai = 0; ai < 2; ++ai)
#pragma unroll
            for (int m = 0; m < 4; ++m) rwv[ai][m] = roww[row0 + ai * HALF + m * 16] * YR_SCALE;
#pragma unroll
        for (int ai = 0; ai < 2; ++ai)
#pragma unroll
            for (int m = 0; m < 4; ++m) { const int row = row0 + ai * HALF + m * 16; const float w_ = rwv[ai][m];
                const f32x4 v0 = (acc[ai][0][m][0] * W8_INV + bv[0][0]) * w_, v1 = (acc[ai][0][m][1] * W8_INV + bv[0][1]) * w_;
                const f32x4 v2 = (acc[ai][1][m][0] * W8_INV + bv[1][0]) * w_, v3 = (acc[ai][1][m][1] * W8_INV + bv[1][1]) * w_;
                u32x4 w; w.x = cvt4_fp8(v0[0], v0[1], v0[2], v0[3]); w.y = cvt4_fp8(v1[0], v1[1], v1[2], v1[3]); w.z = cvt4_fp8(v2[0], v2[1], v2[2], v2[3]); w.w = cvt4_fp8(v3[0], v3[1], v3[2], v3[3]);
                *(u32x4*)(O + (size_t)row * DM + col0) = w; }
    }
};

template <int NS>
struct SchedSub {
    static constexpr bool GATHER = false; const LAS int* ltok = nullptr;
    int G, c, first, cfirst, nctx; bool rev;
    __device__ __forceinline__ bool next(int i, Unit& u) const {
        const int L = i * G + (rev ? G - 1 - c : c);
        if (L < 128 * NS) { int j; tile_order<NS>(L, 128, u.pm, j); u.pn = first + j; return true; }
        const int r = L - 128 * NS; if (r >= 8 * nctx) return false;
        const int q = (nctx == 2) ? (r >> 1) : (nctx == 4) ? (r >> 2) : (r / 6);
        u.pm = 128 + q; u.pn = cfirst + (r - q * nctx); return true;
    }
};
template <int nN>
struct SchedGrid {
    static constexpr bool GATHER = false; const LAS int* ltok = nullptr;
    int G, c, nM;
    __device__ __forceinline__ bool next(int i, Unit& u) const {
        const int L = i * G + c; if (L >= nM * nN) return false;
        tile_order<nN>(L, nM, u.pm, u.pn); return true;
    }
};
template <int nN, bool GATHER_>
struct SchedMoe {
    static constexpr bool GATHER = GATHER_;
    int G, c, nMt; const LAS int* tile_e; const LAS int* ltok;
    __device__ __forceinline__ bool next(int i, Unit& u) const {
        const int L = i * G + c; if (L >= nMt * nN) return false;
        int pm, pn; tile_order<nN>(L, nMt, pm, pn);
        const int e = __builtin_amdgcn_readfirstlane(tile_e[pm]);
        u.pm = pm; u.pn = e * nN + pn; return true;
    }
};
}

namespace att { __device__ __forceinline__ unsigned cvtpk(float lo, float hi) { unsigned r; asm volatile("v_cvt_pk_bf16_f32 %0, %1, %2" : "=v"(r) : "v"(lo), "v"(hi)); return r; } }
namespace att8 {
typedef int v8i __attribute__((ext_vector_type(8)));
typedef int v4i __attribute__((ext_vector_type(4)));
constexpr int NW = 8, QBLK = 32, KVBLK = 64;
constexpr float SCALE = 0.088388347648318440f;
constexpr float QSC = SCALE * 1.4426950408889634f;
constexpr float THR = 3.f;
constexpr float THR2 = THR * 1.4426950408889634f;
constexpr int NSLOT = 4, SLOT = 8192;
constexpr int OFF_K = 0, OFF_V = NSLOT * SLOT, OFF_WS = 2 * NSLOT * SLOT, OFF_OST = OFF_WS + 2048;
static_assert(OFF_OST + 8 * 8704 <= 163840 - 256, "att8 LDS");
__device__ __forceinline__ int crow(int r, int hi) { return (r & 3) + 8 * (r >> 2) + 4 * hi; }
__host__ __device__ __forceinline__ int kpos(int k) { const int kk = k & 31, up = k >> 5, hi = (kk >> 2) & 1, r = (kk & 3) + 4 * (kk >> 3); return 32 * hi + 16 * up + r; }
__device__ __forceinline__ v8i ld32(const char* p) { const v4i a = *(const v4i*)p, b = *(const v4i*)(p + 16); return (v8i){a[0], a[1], a[2], a[3], b[0], b[1], b[2], b[3]}; }
__device__ __forceinline__ f32x16 mma8(v8i a, v8i b, f32x16 c) { return __builtin_amdgcn_mfma_scale_f32_32x32x64_f8f6f4(a, b, c, 0, 0, 0, 0, 0, 0); }

template <bool FIRST>
__device__ __forceinline__ void partialSM(f32x16& p0, f32x16& p1, f32x16& negm, float& alpha) {
  float pmax = p0[0]; for (int r = 1; r < 16; ++r) pmax = fmaxf(pmax, p0[r]); for (int r = 0; r < 16; ++r) pmax = fmaxf(pmax, p1[r]);
  { auto rr = __builtin_amdgcn_permlane32_swap(__float_as_uint(pmax), __float_as_uint(pmax), false, false);
    pmax = fmaxf(__uint_as_float(rr[0]), __uint_as_float(rr[1])); }
  const float d = pmax - 4.f;
  if (!FIRST && __builtin_expect(__all(d <= THR2), 1)) alpha = 1.f;
  else { const float dl = FIRST ? d : fmaxf(d, 0.f); alpha = __builtin_amdgcn_exp2f(-dl);
    for (int r = 0; r < 16; ++r) { p0[r] -= dl; p1[r] -= dl; negm[r] -= dl; } }
  for (int r = 0; r < 16; ++r) p0[r] = __builtin_amdgcn_exp2f(p0[r]);
}
__device__ __forceinline__ void finishA(f32x16& p1) { for (int r = 0; r < 16; ++r) p1[r] = __builtin_amdgcn_exp2f(p1[r]); }
__device__ __forceinline__ void finishB(f32x16& p0, f32x16& p1, v8i& pa, float& lsum) {
  { float t0 = p0[0] + p1[0], t1 = p0[1] + p1[1], t2 = p0[2] + p1[2], t3 = p0[3] + p1[3];
#pragma unroll
    for (int r = 4; r < 16; r += 4) { t0 += p0[r] + p1[r]; t1 += p0[r + 1] + p1[r + 1]; t2 += p0[r + 2] + p1[r + 2]; t3 += p0[r + 3] + p1[r + 3]; }
    lsum += (t0 + t1) + (t2 + t3); }
#pragma unroll
  for (int w = 0; w < 4; ++w) { int a = pa[w], b = pa[4 + w];
    a = __builtin_amdgcn_cvt_pk_fp8_f32(p0[4 * w], p0[4 * w + 1], a, false); a = __builtin_amdgcn_cvt_pk_fp8_f32(p0[4 * w + 2], p0[4 * w + 3], a, true);
    b = __builtin_amdgcn_cvt_pk_fp8_f32(p1[4 * w], p1[4 * w + 1], b, false); b = __builtin_amdgcn_cvt_pk_fp8_f32(p1[4 * w + 2], p1[4 * w + 3], b, true);
    pa[w] = a; pa[4 + w] = b; }
}
struct KFrag { v8i a0, a1, a2, a3; };
__device__ __forceinline__ v8i ld2(const char* p, int o0, int o1) { const v4i a = *(const v4i*)(p + o0), b = *(const v4i*)(p + o1); return (v8i){a[0], a[1], a[2], a[3], b[0], b[1], b[2], b[3]}; }
__device__ __forceinline__ void kf_load(KFrag& f, const char* Ks, const int (&ka)[4]) {
  f.a0 = ld2(Ks, ka[0], ka[1]); f.a1 = ld2(Ks + 4096, ka[0], ka[1]); f.a2 = ld2(Ks, ka[2], ka[3]); f.a3 = ld2(Ks + 4096, ka[2], ka[3]);
}
__device__ __forceinline__ void qkt(f32x16& p0, f32x16& p1, const f32x16& negm, const KFrag& f, const v8i* qr) {
  p0 = mma8(f.a0, qr[0], negm); p1 = mma8(f.a1, qr[0], negm); p0 = mma8(f.a2, qr[1], p0); p1 = mma8(f.a3, qr[1], p1);
}
struct VFrag { v8i b0, b1, b2, b3; };
__device__ __forceinline__ void pv_load(VFrag& f, const char* Vs, const int (&va)[2]) {
  f.b0 = ld2(Vs, va[0], va[1]); f.b1 = ld2(Vs + 2048, va[0], va[1]); f.b2 = ld2(Vs + 4096, va[0], va[1]); f.b3 = ld2(Vs + 6144, va[0], va[1]);
}
__device__ __forceinline__ void pv(f32x16* o, const VFrag& f, v8i pa) {
  o[0] = mma8(pa, f.b0, o[0]); o[1] = mma8(pa, f.b1, o[1]); o[2] = mma8(pa, f.b2, o[2]); o[3] = mma8(pa, f.b3, o[3]);
}
template <int LDQ, int LDO>
__device__ __forceinline__ void attn_body(const unsigned char* __restrict__ Qb, const unsigned char* __restrict__ Kh, const unsigned char* __restrict__ VTh, bf16_t* __restrict__ Ob, int seq, char* lds, const int tid) {
  const int wid = tid >> 6, lane = tid & 63, r32 = lane & 31, hi = lane >> 5;
  char* V_lds = lds + OFF_V; char* K_lds = lds + OFF_K;
  float* ws = (float*)(lds + OFF_WS) + wid * 64; float* al_l = ws + 32;
  f32x16 o[4] = {}; float lsum = 0.f; v8i qr[2]; f32x16 negm;
#pragma unroll
  for (int r = 0; r < 16; ++r) negm[r] = 0.f;
  { const char* Qw = (const char*)Qb + (long)(wid * QBLK + r32) * LDQ + 32 * hi;
#pragma unroll
    for (int st = 0; st < 2; ++st) qr[st] = ld32(Qw + 64 * st); }
  unsigned kgoff, vgoff;
  { const int kr = wid * 8 + (lane >> 3), vr = wid * 16 + (lane >> 2);
    kgoff = (unsigned)(kr * 128 + (((lane & 7) ^ ((kr >> 1) & 7)) << 4)); vgoff = (unsigned)(vr * 64 + (((lane & 3) ^ ((vr >> 2) & 3)) << 4)); }
  int ka[4], va[2];
  { const int xk = (r32 >> 1) & 7, xv = (r32 >> 2) & 3;
#pragma unroll
    for (int c = 0; c < 4; ++c) ka[c] = r32 * 128 + (((4 * (c >> 1) + 2 * hi + (c & 1)) ^ xk) << 4);
#pragma unroll
    for (int c = 0; c < 2; ++c) va[c] = r32 * 64 + (((2 * hi + c) ^ xv) << 4); }
  const unsigned ldsw = (unsigned)__builtin_amdgcn_readfirstlane(wid) * 1024u;
#define DMA(t) do { const int t_ = (t); const unsigned so_ = (unsigned)(t_ & (NSLOT - 1)) * SLOT + ldsw; unsigned ko_ = kgoff, vo_ = vgoff; asm volatile("" : "+v"(ko_), "+v"(vo_)); \
    __builtin_amdgcn_global_load_lds((const unsigned*)(Kh + (size_t)t_ * SLOT + ko_), (LAS unsigned*)(lds + OFF_K + so_), 16, 0, 0); \
    __builtin_amdgcn_global_load_lds((const unsigned*)(VTh + (size_t)t_ * SLOT + vo_), (LAS unsigned*)(lds + OFF_V + so_), 16, 0, 0); } while (0)
#define WAITV2() asm volatile("s_waitcnt vmcnt(2)" ::: "memory")
#define BARX() __builtin_amdgcn_s_barrier()
#define RESC(a) do { if (__any((a) < 1.f)) { if (hi == 0) al_l[r32] = (a); asm volatile("s_waitcnt lgkmcnt(0)" ::: "memory"); \
    lsum *= (a); for (int r = 0; r < 16; ++r) { const float f_ = al_l[crow(r, hi)]; for (int d = 0; d < 4; ++d) o[d][r] *= f_; } } } while (0)
#define SBAR8() __builtin_amdgcn_sched_barrier(0)
  f32x16 pA0, pA1, pB0, pB1; float alA, alB; v8i pa = {}; const int NT = seq / KVBLK;
  DMA(0); DMA(1); WAITV2(); BARX();
  KFrag kf; kf_load(kf, K_lds, ka); qkt(pA0, pA1, negm, kf, qr); partialSM<true>(pA0, pA1, negm, alA);
  DMA(2 < NT ? 2 : NT - 1); WAITV2(); BARX();
  VFrag vf;
#define STEP(pN0, pN1, pO0, pO1, jj, alN) do { const int j_ = (jj); \
    SBAR8(); kf_load(kf, K_lds + (j_ & (NSLOT - 1)) * SLOT, ka); SBAR8(); \
    finishA(pO1); SBAR8(); \
    qkt(pN0, pN1, negm, kf, qr); SBAR8(); \
    pv_load(vf, V_lds + ((j_ - 1) & (NSLOT - 1)) * SLOT, va); SBAR8(); \
    finishB(pO0, pO1, pa, lsum); SBAR8(); \
    DMA(j_ + 2 < NT ? j_ + 2 : NT - 1); SBAR8();     \
    pv(o, vf, pa); partialSM<false>(pN0, pN1, negm, alN); \
    RESC(alN); WAITV2(); BARX(); } while (0)
  for (int j = 1; j + 1 < NT; j += 2) {
    STEP(pB0, pB1, pA0, pA1, j, alB);
    STEP(pA0, pA1, pB0, pB1, j + 1, alA);
  }
  STEP(pB0, pB1, pA0, pA1, NT - 1, alB);
  pv_load(vf, V_lds + ((NT - 1) & (NSLOT - 1)) * SLOT, va);
  finishA(pB1); finishB(pB0, pB1, pa, lsum); SBAR8();
  pv(o, vf, pa);
#undef STEP
  float rli[16];
  { auto rr = __builtin_amdgcn_permlane32_swap(__float_as_uint(lsum), __float_as_uint(lsum), false, false);
    const float rl = __builtin_amdgcn_rcpf(__uint_as_float(rr[0]) + __uint_as_float(rr[1]));
    if (hi == 0) al_l[r32] = rl; asm volatile("s_waitcnt lgkmcnt(0)" ::: "memory");
#pragma unroll
    for (int r = 0; r < 16; ++r) rli[r] = al_l[crow(r, hi)]; }
  { char* ost = lds + OFF_OST + wid * (32 * 272);
#pragma unroll
    for (int r = 0; r < 16; ++r) { const int orow = crow(r, hi);
#pragma unroll
      for (int d0 = 0; d0 < 4; ++d0) *(bf16_t*)(ost + orow * 272 + (d0 * 32 + r32) * 2) = (bf16_t)att::cvtpk(o[d0][r] * rli[r], 0.f); }
    asm volatile("s_waitcnt lgkmcnt(0)" ::: "memory");
    bf16_t* Ow = Ob + (long)(wid * QBLK) * LDO;
#pragma unroll
    for (int i = 0; i < 8; ++i) { const int idx = lane + 64 * i, row = idx >> 4, ch = idx & 15;
      *(u32x4*)(Ow + (long)row * LDO + ch * 8) = *(const u32x4*)(ost + row * 272 + ch * 16); } }
  asm volatile("s_waitcnt vmcnt(0)" ::: "memory");
  __syncthreads();
#undef DMA
#undef WAITV2
#undef BARX
#undef RESC
#undef SBAR8
}
}

#define XB_TMO      128
#define XB_XCNT(j)  (256  + 64 * (j))
#define XB_XSUB(j)  (1280 + 64 * (j))
#define XB_XGEN(j)  (2304 + 64 * (j))
#define XB_TOP      3328
#define XB_TOPGEN   3392
#define XCD_BAR_WORDS 3456
#define XB_SPIN_CAP (1u << 18)
__device__ __forceinline__ unsigned xb_ld(unsigned* p)              { return __hip_atomic_load(p, __ATOMIC_RELAXED, __HIP_MEMORY_SCOPE_AGENT); }
__device__ __forceinline__ unsigned xb_add(unsigned* p, unsigned v) { return __hip_atomic_fetch_add(p, v, __ATOMIC_RELAXED, __HIP_MEMORY_SCOPE_AGENT); }
__device__ __forceinline__ unsigned xb_xcc_id() { return (unsigned)__builtin_amdgcn_s_getreg((3 << 11) | 20) & 0xFu; }
#define XB_SPIN(cond, bar) do { unsigned _sp = 0; while (cond) { __builtin_amdgcn_s_sleep(1); \
    if ((++_sp & 255u) == 0u) { if (xb_ld(&(bar)[XB_TMO])) break; if (_sp > XB_SPIN_CAP) { atomicAdd(&(bar)[XB_TMO], 1u); break; } } } } while (0)
struct XcdBarrier { unsigned* bar; unsigned x; volatile LAS unsigned* st; };
__device__ __forceinline__ XcdBarrier xcd_barrier_post(unsigned* bar, volatile LAS unsigned* st) {
    XcdBarrier b; b.bar = bar; b.x = xb_xcc_id(); b.st = st;
    if (threadIdx.x == 0) (void)xb_add(&bar[XB_XCNT(b.x)], 1u);
    return b;
}
__device__ __forceinline__ void xcd_barrier_complete(unsigned* bar, unsigned x, unsigned& nloc, unsigned& nx) {
    const unsigned G = gridDim.x * gridDim.y * gridDim.z;
    unsigned sum, cnt, mine, sp = 0u;
    for (;;) {
        sum = 0u; cnt = 0u; mine = 0u;
#pragma unroll
        for (unsigned j = 0; j < 16; ++j) { const unsigned c = xb_ld(&bar[XB_XCNT(j)]); sum += c; cnt += (c > 0u) ? 1u : 0u; mine = (j == x) ? c : mine; }
        if (sum == G) break;
        __builtin_amdgcn_s_sleep(1);
        if ((++sp & 255u) == 0u) { if (xb_ld(&bar[XB_TMO])) break; if (sp > XB_SPIN_CAP) { atomicAdd(&bar[XB_TMO], 1u); break; } }
    }
    nloc = mine > 0u ? mine : 1u; nx = cnt > 0u ? cnt : 1u;
}
template <class Work>
__device__ __forceinline__ void xcd_barrier(const XcdBarrier& b, Work work) {
    asm volatile("s_waitcnt vmcnt(0)" ::: "memory");
    __syncthreads();
    if (threadIdx.x >= 64) work((int)threadIdx.x - 64, (int)blockDim.x - 64);
    if (threadIdx.x == 0) {
        unsigned* bar = b.bar;
        __builtin_amdgcn_s_waitcnt(0);
        unsigned nloc = b.st[0], nx = b.st[1];
        if (nloc == 0u) { xcd_barrier_complete(bar, b.x, nloc, nx); b.st[0] = nloc; b.st[1] = nx; }
        const unsigned old = xb_add(&bar[XB_XSUB(b.x)], 1u);
        const unsigned gen = old / nloc;
        if (old + 1u == (gen + 1u) * nloc) {
            __builtin_amdgcn_fence(__ATOMIC_RELEASE, "agent");
            asm volatile("s_waitcnt vmcnt(0)" ::: "memory");
            const unsigned og = xb_add(&bar[XB_TOP], 1u);
            const unsigned tg = og / nx;
            if (og + 1u == (tg + 1u) * nx) xb_add(&bar[XB_TOPGEN], 1u);
            else XB_SPIN(xb_ld(&bar[XB_TOPGEN]) == tg, bar);
            __builtin_amdgcn_fence(__ATOMIC_ACQUIRE, "agent");
            xb_add(&bar[XB_XGEN(b.x)], 1u);
            asm volatile("s_waitcnt vmcnt(0)" ::: "memory");
        } else {
            XB_SPIN(xb_ld(&bar[XB_XGEN(b.x)]) == gen, bar);
            __builtin_amdgcn_fence(__ATOMIC_ACQUIRE, "agent");
            asm volatile("s_waitcnt vmcnt(0)" ::: "memory");
        }
    }
    __syncthreads();
}

__device__ __forceinline__ unsigned char* opq(unsigned char* p) { asm volatile("" : "+s"(p)); return p; }
struct Args { const float* in[24]; float* out; unsigned char* ws; int ph_lo, ph_hi; };
__device__ __forceinline__ Args load_args() {
#if defined(__HIP_DEVICE_COMPILE__)
    auto kp = __builtin_amdgcn_kernarg_segment_ptr();
    asm volatile("" : "+s"(kp));
    return *(const __attribute__((address_space(4))) Args*)kp;
#else
    return Args{};
#endif
}
enum { I_X = 0, I_C, I_CTX, I_CCTX, I_WMOD, I_BMOD, I_NMIX, I_NFFN, I_WIN, I_QN, I_KN, I_SCW, I_CDW, I_CDB, I_CLG, I_CLB, I_WOUT, I_RW, I_RB, I_WUP, I_BUP, I_WDN, I_BDN, I_FN };

__device__ __forceinline__ void p0_mods_unit(int unit, const float* w_mod, const float* b_mod, float* mods, const LAS float* act, LAS float* red, int tid) {
    const int l = unit / 384, col0 = (unit % 384) * 16, col = tid & 15, kg = tid >> 4;
    float acc[9];
#pragma unroll
    for (int r = 0; r < 9; ++r) acc[r] = 0.f;
    const float* wp = w_mod + ((size_t)l * DM + kg * 32) * NMOD + col0 + col;
#pragma unroll 16
    for (int k = 0; k < 32; ++k) { const float w = wp[(size_t)k * NMOD];
#pragma unroll
        for (int r = 0; r < 9; ++r) acc[r] += act[r * DM + kg * 32 + k] * w; }
#pragma unroll
    for (int r = 0; r < 9; ++r) red[(kg * 9 + r) * 16 + col] = acc[r];
    __syncthreads();
    if (tid < 9 * 16) { const int r = tid >> 4, cc = tid & 15; float sm = 0.f;
#pragma unroll
        for (int g = 0; g < 32; ++g) sm += red[(g * 9 + r) * 16 + cc];
        mods[((size_t)l * 9 + r) * NMOD + col0 + cc] = sm + b_mod[(size_t)l * NMOD + col0 + cc]; }
    __syncthreads();
}
struct MapId { __device__ __forceinline__ int operator()(int n) const { return n; } };
struct MapUp { __device__ __forceinline__ int operator()(int n) const { const int a = n >> 1, j = n & 1; return ((a >> 7) << 8) + (j << 7) + (a & 127); } };
template <class NMap>
__device__ __forceinline__ void p0_transpose_item8(const float* W, int K, int N, unsigned char* WT, LAS float* scr, int kb, int nb, int lane, NMap nmap) {
    const int k0 = 64 * kb, n0 = 64 * nb;
    { const int kq = lane >> 4, n4 = (lane & 15) * 4;
#pragma unroll
        for (int i = 0; i < 16; ++i) { const f32x4 v = __builtin_nontemporal_load((const f32x4*)(W + (size_t)(k0 + 4 * i + kq) * N + n0 + n4));
            LAS float* d = scr + (4 * i + kq) * 65 + n4; d[0] = v.x; d[1] = v.y; d[2] = v.z; d[3] = v.w; } }
    LDS_WAIT(); asm volatile("" ::: "memory");
    const int c = lane & 3, rs = lane >> 2;
#pragma unroll
    for (int j = 0; j < 4; ++j) { const int nl = rs + 16 * j; const LAS float* s = scr + (16 * c) * 65 + nl;
        u32x4 o;
        o.x = pg8::cvt4_fp8(s[0 * 65] * W8_SCALE, s[1 * 65] * W8_SCALE, s[2 * 65] * W8_SCALE, s[3 * 65] * W8_SCALE); o.y = pg8::cvt4_fp8(s[4 * 65] * W8_SCALE, s[5 * 65] * W8_SCALE, s[6 * 65] * W8_SCALE, s[7 * 65] * W8_SCALE);
        o.z = pg8::cvt4_fp8(s[8 * 65] * W8_SCALE, s[9 * 65] * W8_SCALE, s[10 * 65] * W8_SCALE, s[11 * 65] * W8_SCALE); o.w = pg8::cvt4_fp8(s[12 * 65] * W8_SCALE, s[13 * 65] * W8_SCALE, s[14 * 65] * W8_SCALE, s[15 * 65] * W8_SCALE);
        *(u32x4*)(WT + (size_t)nmap(n0 + nl) * K + k0 + 16 * c) = o; }
    LDS_WAIT(); asm volatile("" ::: "memory");
}
template <class NMap>
__device__ __forceinline__ void p0_transpose_item(const float* W, int K, int N, bf16_t* WT, LAS float* scr, int kb, int nb, int lane, NMap nmap) {
    const int k0 = 64 * kb, n0 = 64 * nb;
    { const int kq = lane >> 4, n4 = (lane & 15) * 4;
#pragma unroll
        for (int i = 0; i < 16; ++i) { const f32x4 v = __builtin_nontemporal_load((const f32x4*)(W + (size_t)(k0 + 4 * i + kq) * N + n0 + n4));
            LAS float* d = scr + (4 * i + kq) * 65 + n4; d[0] = v.x; d[1] = v.y; d[2] = v.z; d[3] = v.w; } }
    LDS_WAIT(); asm volatile("" ::: "memory");
    const int c = lane & 7, rs = lane >> 3;
#pragma unroll
    for (int j = 0; j < 8; ++j) { const int nl = rs + 8 * j; const LAS float* s = scr + (8 * c) * 65 + nl;
        u32x4 o; o.x = pk2(s[0 * 65], s[1 * 65]); o.y = pk2(s[2 * 65], s[3 * 65]); o.z = pk2(s[4 * 65], s[5 * 65]); o.w = pk2(s[6 * 65], s[7 * 65]);
        *(u32x4*)(WT + (size_t)nmap(n0 + nl) * K + k0 + 8 * c) = o; }
    LDS_WAIT(); asm volatile("" ::: "memory");
}
constexpr int P0_IT_IN = 16 * 40, P0_IT_IN8 = 16 * 16, P0_IT_OUT = 20 * 16, P0_IT_UP = 16 * 32, P0_IT_DN = 16 * 16, P0_IT_LAYER = P0_IT_IN + P0_IT_IN8 + P0_IT_OUT + NE * P0_IT_UP + NE * P0_IT_DN;
constexpr int P0_ITEMS = DEPTH * P0_IT_LAYER, P0_DEFER = NE * P0_IT_DN;
constexpr int P0_WPB = 7, P0_IPW = 2  , P0_SLOTN = NWG * P0_WPB * P0_IPW, P0_NSLOT = MK_ONE_LAUNCH ? 11 : 0, P0_CNT = P0_ITEMS - P0_DEFER - P0_NSLOT * P0_SLOTN;
__host__ __device__ constexpr int p0_slot_raw(int k) { return k <= 4 ? k : k == 6 ? 5 : k == 7 ? 6 : k == 8 ? 7 : k == 10 ? 8 : k == 12 ? 9 : k == 13 ? 10 : k == 14 ? 11 : k == 16 ? 12 : -1; }
__host__ __device__ constexpr int p0_slot(int k) { return p0_slot_raw(k) < P0_NSLOT ? p0_slot_raw(k) : -1; }
static_assert(P0_CNT > 0, "p0 slots");
__device__ __forceinline__ void p0_items(const Args& a, LAS unsigned char* lds, int gw, int NGW, int it_lo, int it_hi, int tid);
__device__ __forceinline__ void p0_prologue(const Args& a, LAS unsigned char* lds, int wg, int tid) {
    const int lane = tid & 63, wave = tid >> 6;
    unsigned char* ws = a.ws;
    {
        LAS float* act = (LAS float*)lds; LAS float* red = (LAS float*)(lds + 9 * DM * 4);
        for (int i = tid; i < 9 * DM; i += NTHR) { const int r = i >> 10, k = i & 1023; const float v = (r < 8) ? a.in[I_C][r * DM + k] : a.in[I_CCTX][k]; act[i] = v * sigmoidf_(v); }
        __syncthreads();
        for (int u = wg; u < 768; u += NWG) p0_mods_unit(u, a.in[I_WMOD], a.in[I_BMOD], (float*)(ws + WS_MODS), act, red, tid);
    }
    p0_items(a, lds, wg * NWAVES + wave, NWG * NWAVES, 0, P0_CNT, tid);
}
__device__ __forceinline__ void p0_items(const Args& a, LAS unsigned char* lds, int gw, int NGW, int it_lo, int it_hi, int tid) {
    const int lane = tid & 63, wave = tid >> 6;
    unsigned char* ws = a.ws;
    LAS float* scr = (LAS float*)(lds + wave * 16640);
    constexpr int IT_IN = P0_IT_IN, IT_IN8 = P0_IT_IN8, IT_OUT = P0_IT_OUT, IT_UP = P0_IT_UP, IT_DN = P0_IT_DN, IT_LAYER = P0_IT_LAYER;
    for (int it = it_lo + gw; it < it_hi; it += NGW) {
        const int l = it / IT_LAYER; int r = it % IT_LAYER;
        if (r < IT_IN) { p0_transpose_item(a.in[I_WIN] + (size_t)l * DM * IN_W, DM, IN_W, (bf16_t*)(ws + WS_WIN) + (size_t)l * IN_W * DM, scr, r / 40, r % 40, lane, MapId()); continue; } r -= IT_IN;
        if (r < IT_IN8) { p0_transpose_item8(a.in[I_WIN] + (size_t)l * DM * IN_W, DM, IN_W, (unsigned char*)(ws + WS_WIN8) + (size_t)l * IN_W * DM, scr, r / 16, r % 16, lane, MapId()); continue; } r -= IT_IN8;
        if (r < IT_OUT) { p0_transpose_item(a.in[I_WOUT] + (size_t)l * MIX_W * DM, MIX_W, DM, (bf16_t*)(ws + WS_WOUT) + (size_t)l * DM * MIX_W, scr, r / 16, r % 16, lane, MapId()); continue; } r -= IT_OUT;
        if (r < NE * IT_UP) { const int e = r / IT_UP, q = r % IT_UP;
            p0_transpose_item8(a.in[I_WUP] + ((size_t)l * NE + e) * DM * 2048, DM, 2048, (unsigned char*)(ws + WS_WUP) + ((size_t)l * NE + e) * 2048 * DM, scr, q / 32, q % 32, lane, MapUp()); continue; } r -= NE * IT_UP;
        { const int e = r / IT_DN, q = r % IT_DN;
            p0_transpose_item8(a.in[I_WDN] + ((size_t)l * NE + e) * DFF * DM, DFF, DM, (unsigned char*)(ws + WS_WDN) + ((size_t)l * NE + e) * DM * DFF, scr, q / 16, q % 16, lane, MapId()); }
    }
}

__device__ __forceinline__ void p0_slot_items(const Args& a, LAS unsigned char* lds, int wg, int slot, int t) {
    const int w = t >> 6;
    if (w < P0_WPB) p0_items(a, lds, wg * P0_WPB + w, NWG * P0_WPB, P0_CNT + slot * P0_SLOTN, P0_CNT + (slot + 1) * P0_SLOTN, t);
}

__device__ __forceinline__ void ph_norm1(const float* xlat, const float* xctx, const float* gain, const float* mods_l, bf16_t* HA, unsigned char* HA8, int gw, int NGW, int lane) {
    const int k0 = 16 * lane;
    for (int t0 = gw * 2; t0 < NTOK; t0 += NGW * 2) {
        f32x4 v[2][4]; float ss[2];
#pragma unroll
        for (int r = 0; r < 2; ++r) { const int t = t0 + r; const float* xr = (t < NLAT) ? xlat + (size_t)t * DM : xctx + (size_t)(t - NLAT) * DM;
#pragma unroll
            for (int j = 0; j < 4; ++j) v[r][j] = *(const f32x4*)(xr + k0 + 4 * j); }
#pragma unroll
        for (int r = 0; r < 2; ++r) { float q = 0.f;
#pragma unroll
            for (int j = 0; j < 4; ++j) q += v[r][j].x * v[r][j].x + v[r][j].y * v[r][j].y + v[r][j].z * v[r][j].z + v[r][j].w * v[r][j].w;
            ss[r] = q; }
#pragma unroll
        for (int r = 0; r < 2; ++r) { const int t = t0 + r; const float* mp = mods_l + (size_t)tok_bidx(t) * NMOD;
            const float rstd = rsqrtf(wave_sum(ss[r]) * (1.f / DM) + EPS);
            u32x4 ho[2]; unsigned h8[4];
#pragma unroll
            for (int j = 0; j < 4; ++j) { const int k = k0 + 4 * j;
                const f32x4 g = *(const f32x4*)(gain + k), sh = *(const f32x4*)(mp + k), sc = *(const f32x4*)(mp + DM + k);
                const f32x4 y = (v[r][j] * rstd * g) * (sc + 1.f) + sh;
                ho[j >> 1][(j & 1) * 2] = pk2(y.x, y.y); ho[j >> 1][(j & 1) * 2 + 1] = pk2(y.z, y.w); h8[j] = pg8::cvt4_fp8(y.x, y.y, y.z, y.w); }
            *(u32x4*)(HA + (size_t)t * DM + k0) = ho[0]; *(u32x4*)(HA + (size_t)t * DM + k0 + 8) = ho[1];
            *(u32x4*)(HA8 + (size_t)t * DM + k0) = (u32x4){h8[0], h8[1], h8[2], h8[3]}; }
    }
}

__device__ __forceinline__ u32x2 qk_row(u32x4 X, const float (&g)[8], const float (&gp)[8], bool rot, float sgn, const LAS f32x2* rp) {
    float x[8] = {bflo(X.x), bfhi(X.x), bflo(X.y), bfhi(X.y), bflo(X.z), bfhi(X.z), bflo(X.w), bfhi(X.w)};
    float ss = 0.f;
#pragma unroll
    for (int i = 0; i < 8; ++i) ss += x[i] * x[i];
    ss += xor_swz<1>(ss); ss += xor_swz<2>(ss); ss += xor_swz<4>(ss); ss += xor_swz<8>(ss);
    const float rstd = rsqrtf(ss * (1.f / 128.f) + EPS);
    u32x4 P;
    P.x = (unsigned)__builtin_amdgcn_ds_swizzle((int)X.x, (4 << 10) | 0x1f); P.y = (unsigned)__builtin_amdgcn_ds_swizzle((int)X.y, (4 << 10) | 0x1f);
    P.z = (unsigned)__builtin_amdgcn_ds_swizzle((int)X.z, (4 << 10) | 0x1f); P.w = (unsigned)__builtin_amdgcn_ds_swizzle((int)X.w, (4 << 10) | 0x1f);
    const float px[8] = {bflo(P.x), bfhi(P.x), bflo(P.y), bfhi(P.y), bflo(P.z), bfhi(P.z), bflo(P.w), bfhi(P.w)};
    float o[8];
    if (rot) {
#pragma unroll
        for (int i = 0; i < 8; ++i) { const f32x2 cssn = rp[i]; o[i] = (x[i] * rstd * g[i]) * cssn.x + sgn * (px[i] * rstd * gp[i]) * cssn.y; }
    } else {
#pragma unroll
        for (int i = 0; i < 8; ++i) o[i] = x[i] * rstd * g[i];
    }
    u32x2 r; r.x = pg8::cvt4_fp8(o[0], o[1], o[2], o[3]); r.y = pg8::cvt4_fp8(o[4], o[5], o[6], o[7]); return r;
}
__device__ __forceinline__ void ph_qkv(int l, const Args& a, LAS unsigned char* lds, int wg, int tid) {
    const int lane = tid & 63, wave = tid >> 6;
    unsigned char* ws = a.ws;
    const bf16_t* U = (const bf16_t*)(ws + WS_U);
    unsigned char* QB = ws + WS_QB; unsigned char* KB = ws + WS_KB; unsigned char* VT = ws + WS_VB;
    LAS f32x2* rope = (LAS f32x2*)lds;
    for (int i = tid; i < 64 * 32; i += NTHR) { const int p = i >> 5, f = i & 31;
        const float inv = __builtin_amdgcn_exp2f(-(float)f * (2.0f / 64.0f) * 13.287712379549449f);
        float sn, cs; sincos_rev((float)p * inv * 0.15915494309189535f, sn, cs); rope[i] = (f32x2){cs, sn}; }
    __syncthreads();
    const bool last = (l == DEPTH - 1);
    const int j16 = lane & 15, d0 = j16 * 8, axis = j16 >> 3, fi0 = (j16 & 3) * 8;
    const float sgn = ((j16 >> 2) & 1) ? 1.f : -1.f;
    const float* qn = a.in[I_QN] + l * 128; const float* kn = a.in[I_KN] + l * 128;
    float qg[8], qgp[8], kg[8], kgp[8];
#pragma unroll
    for (int i = 0; i < 8; ++i) { qg[i] = qn[d0 + i] * att8::QSC; qgp[i] = qn[(d0 ^ 32) + i] * att8::QSC; kg[i] = kn[d0 + i]; kgp[i] = kn[(d0 ^ 32) + i]; }
#pragma unroll 2
    for (int t = wg * NWAVES + wave; t < NTOK; t += NWG * NWAVES) {
        const bool isctx = t >= NLAT;
        const int b = isctx ? (t - NLAT) >> 8 : t >> 12, sp = isctx ? (t - NLAT) & 255 : t & 4095, krow = isctx ? sp : CTXL + sp;
        const bool doq = !(last && isctx);
        const bf16_t* up = U + (size_t)t * IN_W;
        u32x4 A = {0u, 0u, 0u, 0u}; if (doq) A = *(const u32x4*)(up + 8 * lane);
        u32x4 B = {0u, 0u, 0u, 0u}; if (lane < 32) B = *(const u32x4*)(up + 512 + 8 * lane);
        const LAS f32x2* rp = rope + (axis ? (sp & 63) : (sp >> 6)) * 32 + fi0;
        const u32x2 qo = qk_row(A, qg, qgp, !isctx, sgn, rp);
        if (doq) *(u32x2*)(QB + (size_t)t * 512 + 8 * lane) = qo;
        const u32x2 ko = qk_row(B, kg, kgp, !isctx, sgn, rp);
        if (lane < 32) *(u32x2*)(KB + ((size_t)(b * 2 + (lane >> 4)) * SKV + krow) * 128 + d0) = ko;
    }
    __syncthreads();
    LAS unsigned char* T = (LAS unsigned char*)lds;
    for (int u = wg; u < BATCH * 2 * (SKV / 64); u += NWG) {
        const int b = u / (2 * (SKV / 64)), rem = u % (2 * (SKV / 64)), kvh = rem / (SKV / 64), tile = rem % (SKV / 64);
        { const int key = tid & 63, dch = (tid >> 6) * 16, kr = tile * 64 + key;
            const size_t tok = (kr < CTXL) ? (size_t)NLAT + b * CTXL + kr : (size_t)b * SEQ + (kr - CTXL);
            const bf16_t* src = U + tok * IN_W + 768 + kvh * 128 + dch;
            const u32x4 v0 = *(const u32x4*)src, v1 = *(const u32x4*)(src + 8);
            const unsigned w0 = pg8::cvt4_fp8(bflo(v0.x), bfhi(v0.x), bflo(v0.y), bfhi(v0.y)), w1 = pg8::cvt4_fp8(bflo(v0.z), bfhi(v0.z), bflo(v0.w), bfhi(v0.w));
            const unsigned w2 = pg8::cvt4_fp8(bflo(v1.x), bfhi(v1.x), bflo(v1.y), bfhi(v1.y)), w3 = pg8::cvt4_fp8(bflo(v1.z), bfhi(v1.z), bflo(v1.w), bfhi(v1.w));
            LAS unsigned char* dst = T + dch * 64 + att8::kpos(key);
#pragma unroll
            for (int i = 0; i < 4; ++i) { dst[(i) * 64] = (unsigned char)(w0 >> (8 * i)); dst[(4 + i) * 64] = (unsigned char)(w1 >> (8 * i)); dst[(8 + i) * 64] = (unsigned char)(w2 >> (8 * i)); dst[(12 + i) * 64] = (unsigned char)(w3 >> (8 * i)); } }
        __syncthreads();
        *(u32x4*)(VT + ((size_t)(b * 2 + kvh) * (SKV / 64) + tile) * 8192 + tid * 16) = *(const LAS u32x4*)(T + tid * 16);
        __syncthreads();
    }
}

constexpr int CV_GLU = 0, CV_D = 32768, CV_END = CV_D + 32 * 256 * 4;
__device__ __forceinline__ void ph_conv_tiles(int l, const Args& a, LAS unsigned char* lds, int wg, int tid) {
    unsigned char* ws = a.ws;
    const bf16_t* U = (const bf16_t*)(ws + WS_U); bf16_t* MIX = (bf16_t*)(ws + WS_MIX);
    const float* cdw = a.in[I_CDW] + (size_t)l * 31 * 256; const float* cdb = a.in[I_CDB] + l * 256;
    const float* clg = a.in[I_CLG] + l * 256; const float* clb = a.in[I_CLB] + l * 256; const float* scw = a.in[I_SCW] + (size_t)l * 3 * 256;
    LAS unsigned* glu = (LAS unsigned*)(lds + CV_GLU);
    LAS float* dbuf = (LAS float*)(lds + CV_D);
    const int cp = tid & 127, tg = tid >> 7;
    const int hw = tid >> 5, l32 = tid & 31;
    f32x2 w[31];
#pragma unroll
    for (int j = 0; j < 31; ++j) w[j] = *(const f32x2*)(cdw + j * 256 + 2 * cp);
    const f32x2 cbias = *(const f32x2*)(cdb + 2 * cp);
    const int ntiles = (l == DEPTH - 1) ? NLAT / 32 : NTOK / 32;
    u32x4 ra[4], rg[4];
#define CV_LOAD(TT) do { const int t0_ = (TT) * 32; const bool ic_ = t0_ >= NLAT; const int sq_ = ic_ ? (t0_ - NLAT) & 255 : t0_ & 4095, sl_ = ic_ ? CTXL : SEQ; \
        _Pragma("unroll") for (int i = 0; i < 4; ++i) { const int id = tid + NTHR * i, j = id >> 5, c8 = (id & 31) * 8, sj = sq_ - 15 + j; \
            ra[i] = (u32x4){0u, 0u, 0u, 0u}; rg[i] = ra[i]; \
            if (id < 62 * 32 && sj >= 0 && sj < sl_) { const bf16_t* up = U + (size_t)(t0_ - 15 + j) * IN_W + 2048 + c8; ra[i] = *(const u32x4*)up; rg[i] = *(const u32x4*)(up + 256); } } } while (0)
    if (wg < ntiles) CV_LOAD(wg);
    for (int tt = wg; tt < ntiles; tt += NWG) {
        const int t0 = tt * 32; const bool isctx = t0 >= NLAT;
        const int s0p = isctx ? (t0 - NLAT) & 255 : t0 & 4095, slen = isctx ? CTXL : SEQ;
#pragma unroll
        for (int i = 0; i < 4; ++i) { const int id = tid + NTHR * i;
            if (id < 62 * 32) { u32x4 o;
                o.x = pk2(bflo(ra[i].x) * sigmoidf_(bflo(rg[i].x)), bfhi(ra[i].x) * sigmoidf_(bfhi(rg[i].x))); o.y = pk2(bflo(ra[i].y) * sigmoidf_(bflo(rg[i].y)), bfhi(ra[i].y) * sigmoidf_(bfhi(rg[i].y)));
                o.z = pk2(bflo(ra[i].z) * sigmoidf_(bflo(rg[i].z)), bfhi(ra[i].z) * sigmoidf_(bfhi(rg[i].z))); o.w = pk2(bflo(ra[i].w) * sigmoidf_(bflo(rg[i].w)), bfhi(ra[i].w) * sigmoidf_(bfhi(rg[i].w)));
                *(LAS u32x4*)(glu + id * 4) = o; } }
        __syncthreads();
        if (tt + NWG < ntiles) CV_LOAD(tt + NWG);
        {
            f32x2 acc[8];
#pragma unroll
            for (int o = 0; o < 8; ++o) acc[o] = cbias;
#pragma unroll
            for (int jj = 0; jj < 38; ++jj) { const unsigned gv = glu[(tg * 8 + jj) * 128 + cp]; const f32x2 v = {bflo(gv), bfhi(gv)};
#pragma unroll
                for (int o = 0; o < 8; ++o) { const int k = jj - o; if (k >= 0 && k < 31) acc[o] += w[k] * v; } }
#pragma unroll
            for (int o = 0; o < 8; ++o) *(LAS f32x2*)(dbuf + (tg * 8 + o) * 256 + 2 * cp) = acc[o];
        }
        {
            const int c8 = (tid & 31) * 8;
#pragma unroll
            for (int q = 0; q < 2; ++q) { const int tl = (tid >> 5) + 16 * q, sj = s0p + tl; const bf16_t* up = U + (size_t)(t0 + tl) * IN_W + c8;
                u32x4 cv[3], xv[3];
#pragma unroll
                for (int d = 0; d < 3; ++d) { cv[d] = (u32x4){0u, 0u, 0u, 0u}; xv[d] = cv[d];
                    if (sj + d - 1 >= 0 && sj + d - 1 < slen) { cv[d] = *(const u32x4*)(up + (d - 1) * IN_W + 1280); xv[d] = *(const u32x4*)(up + (d - 1) * IN_W + 1536); } }
                const u32x4 bv = *(const u32x4*)(up + 1024);
                const f32x4 w0a = *(const f32x4*)(scw + c8), w0b = *(const f32x4*)(scw + c8 + 4), w1a = *(const f32x4*)(scw + 256 + c8), w1b = *(const f32x4*)(scw + 256 + c8 + 4), w2a = *(const f32x4*)(scw + 512 + c8), w2b = *(const f32x4*)(scw + 512 + c8 + 4);
                const float wt[3][8] = {{w0a.x, w0a.y, w0a.z, w0a.w, w0b.x, w0b.y, w0b.z, w0b.w}, {w1a.x, w1a.y, w1a.z, w1a.w, w1b.x, w1b.y, w1b.z, w1b.w}, {w2a.x, w2a.y, w2a.z, w2a.w, w2b.x, w2b.y, w2b.z, w2b.w}};
                float acc[8];
#pragma unroll
                for (int i = 0; i < 8; ++i) acc[i] = 0.f;
#pragma unroll
                for (int d = 0; d < 3; ++d) { const unsigned cw[4] = {cv[d].x, cv[d].y, cv[d].z, cv[d].w}, xw[4] = {xv[d].x, xv[d].y, xv[d].z, xv[d].w};
#pragma unroll
                    for (int i = 0; i < 4; ++i) { acc[2 * i] += wt[d][2 * i] * (bflo(cw[i]) * bflo(xw[i])); acc[2 * i + 1] += wt[d][2 * i + 1] * (bfhi(cw[i]) * bfhi(xw[i])); } }
                const unsigned bw[4] = {bv.x, bv.y, bv.z, bv.w}; u32x4 o;
                o.x = pk2(bflo(bw[0]) * acc[0], bfhi(bw[0]) * acc[1]); o.y = pk2(bflo(bw[1]) * acc[2], bfhi(bw[1]) * acc[3]); o.z = pk2(bflo(bw[2]) * acc[4], bfhi(bw[2]) * acc[5]); o.w = pk2(bflo(bw[3]) * acc[6], bfhi(bw[3]) * acc[7]);
                *(u32x4*)(MIX + (size_t)(t0 + tl) * MIX_W + 512 + c8) = o; }
        }
        __syncthreads();
#pragma unroll
        for (int q = 0; q < 2; ++q) { const int tok = hw * 2 + q;
            const f32x4 v0 = *(const LAS f32x4*)(dbuf + tok * 256 + l32 * 8), v1 = *(const LAS f32x4*)(dbuf + tok * 256 + l32 * 8 + 4);
            float sm = (v0.x + v0.y + v0.z + v0.w) + (v1.x + v1.y + v1.z + v1.w);
            sm += xor_swz<1>(sm); sm += xor_swz<2>(sm); sm += xor_swz<4>(sm); sm += xor_swz<8>(sm); sm += xor_swz<16>(sm);
            const float mean = sm * (1.f / 256.f);
            const f32x4 d0 = v0 - mean, d1 = v1 - mean;
            float vs = (d0.x * d0.x + d0.y * d0.y + d0.z * d0.z + d0.w * d0.w) + (d1.x * d1.x + d1.y * d1.y + d1.z * d1.z + d1.w * d1.w);
            vs += xor_swz<1>(vs); vs += xor_swz<2>(vs); vs += xor_swz<4>(vs); vs += xor_swz<8>(vs); vs += xor_swz<16>(vs);
            const float rstd = rsqrtf(vs * (1.f / 256.f) + EPS);
            const f32x4 g0 = *(const f32x4*)(clg + l32 * 8), g1 = *(const f32x4*)(clg + l32 * 8 + 4), b0 = *(const f32x4*)(clb + l32 * 8), b1 = *(const f32x4*)(clb + l32 * 8 + 4);
            f32x4 y0 = d0 * rstd * g0 + b0, y1 = d1 * rstd * g1 + b1;
            y0.x *= sigmoidf_(y0.x); y0.y *= sigmoidf_(y0.y); y0.z *= sigmoidf_(y0.z); y0.w *= sigmoidf_(y0.w);
            y1.x *= sigmoidf_(y1.x); y1.y *= sigmoidf_(y1.y); y1.z *= sigmoidf_(y1.z); y1.w *= sigmoidf_(y1.w);
            u32x4 o; o.x = pk2(y0.x, y0.y); o.y = pk2(y0.z, y0.w); o.z = pk2(y1.x, y1.y); o.w = pk2(y1.z, y1.w);
            *(u32x4*)(MIX + (size_t)(t0 + tok) * MIX_W + 1024 + l32 * 8) = o; }
    }
#undef CV_LOAD
    __syncthreads();
}

constexpr int FM_LD = 72;
constexpr int FM_WC = 0, FM_WS = 9216, FM_WSN = 18432, FM_X = 27648, FM_GRE = 36864, FM_GIM = 46080, FM_AT = 27648  , FM_OUT = 55296  , FM_OUT3 = 64512  , FM_TW = FM_OUT3 + 2 * 9216  , FM_END = FM_TW + 1024;
__device__ __forceinline__ void fm_tables(LAS unsigned char* lds, int tid) {
    LAS bf16_t* Wc = (LAS bf16_t*)(lds + FM_WC); LAS bf16_t* Ws = (LAS bf16_t*)(lds + FM_WS); LAS bf16_t* Wsn = (LAS bf16_t*)(lds + FM_WSN);
    for (int i = tid; i < 4096; i += NTHR) { const int r = i >> 6, c = i & 63; float sn, cs; sincos_rev((float)((r * c) & 63) * (1.f / 64.f), sn, cs);
        Wc[r * FM_LD + c] = (bf16_t)f2bf(cs); Ws[r * FM_LD + c] = (bf16_t)f2bf(sn); Wsn[r * FM_LD + c] = (bf16_t)f2bf(-sn); }
    __syncthreads();
}
template <bool BSWZ = false>
__device__ __forceinline__ void fm_mm(f32x16& acc, const LAS bf16_t* A, int ar0, const LAS bf16_t* Bt, int br0, int lane) {
    const int r = lane & 31, h = lane >> 5;
#pragma unroll
    for (int k0 = 0; k0 < 64; k0 += 16) {
        const int kg = (k0 >> 3) + h, kb = BSWZ ? ((kg ^ (((br0 + r) >> 3) & 7)) << 3) : (kg << 3);
        const bf16x8 av = *(const LAS bf16x8*)(A + (ar0 + r) * FM_LD + k0 + 8 * h), bv = *(const LAS bf16x8*)(Bt + (br0 + r) * FM_LD + kb);
        acc = __builtin_amdgcn_mfma_f32_32x32x16_bf16(av, bv, acc, 0, 0, 0); }
}
__device__ __forceinline__ int fm_crow(int reg, int h) { return (reg & 3) + 8 * (reg >> 2) + 4 * h; }
template <bool CTXM>
__device__ __forceinline__ void fm12_unit(int unit, const bf16_t* U, bf16_t* F2, LAS unsigned char* lds, int tid) {
    const LAS bf16_t* Wc = (const LAS bf16_t*)(lds + FM_WC); const LAS bf16_t* Ws = (const LAS bf16_t*)(lds + FM_WS); const LAS bf16_t* Wsn = (const LAS bf16_t*)(lds + FM_WSN);
    LAS bf16_t* X = (LAS bf16_t*)(lds + FM_X); LAS bf16_t* Gre = (LAS bf16_t*)(lds + FM_GRE); LAS bf16_t* Gim = (LAS bf16_t*)(lds + FM_GIM);
    int b, g, s2;
    if (!CTXM) { b = unit >> 8; g = (unit >> 6) & 3; s2 = unit & 63; } else { b = unit >> 4; g = (unit >> 2) & 3; s2 = unit & 3; }
    const int lane = tid & 63, wave = tid >> 6, r = lane & 31, h = lane >> 5, part = wave >> 2, tr = (wave >> 1) & 1, tc = wave & 1;
    { const int s1 = tid >> 3, c8 = (tid & 7) * 8;
        const size_t tok = CTXM ? (size_t)NLAT + b * CTXL + (s1 >> 4) * 64 + s2 * 16 + (s1 & 15) : (size_t)b * SEQ + s1 * 64 + s2;
        *(LAS u32x4*)(X + s1 * FM_LD + c8) = *(const u32x4*)(U + tok * IN_W + 1792 + g * 64 + c8); }
    __syncthreads();
    {
        f32x16 acc = {};
        fm_mm(acc, X, tr * 32, part ? Wsn : Wc, tc * 32, lane);
        LAS bf16_t* GT = part ? Gim : Gre;
#pragma unroll
        for (int q = 0; q < 4; ++q) { u32x2 o; o.x = pk2(acc[4 * q], acc[4 * q + 1]); o.y = pk2(acc[4 * q + 2], acc[4 * q + 3]);
            *(LAS u32x2*)(GT + (tc * 32 + r) * FM_LD + tr * 32 + 8 * q + 4 * h) = o; }
    }
    __syncthreads();
    if constexpr (!CTXM) {
    {
        f32x16 acc = {};
        fm_mm(acc, Wc, tr * 32, part ? Gim : Gre, tc * 32, lane);
        fm_mm(acc, part ? Wsn : Ws, tr * 32, part ? Gre : Gim, tc * 32, lane);
        LAS bf16_t* OUT = (LAS bf16_t*)(lds + FM_OUT) + part * 64 * FM_LD;
#pragma unroll
        for (int reg = 0; reg < 16; ++reg) OUT[(tr * 32 + fm_crow(reg, h)) * FM_LD + tc * 32 + r] = (bf16_t)f2bf(acc[reg]);
    }
    __syncthreads();
#pragma unroll
    for (int i = 0; i < 2; ++i) { const int c = tid + NTHR * i, k1 = c >> 4, pt = (c >> 3) & 1, mch = (c & 7) * 8;
        *(u32x4*)(F2 + ((((size_t)(b * 4 + g) * 64 + k1) * 64 + s2) * 2 + pt) * 64 + mch) = *(const LAS u32x4*)((LAS bf16_t*)(lds + FM_OUT) + (pt * 64 + k1) * FM_LD + mch); }
    } else {
        const int k1 = tid >> 7, s2l = (tid >> 3) & 15, m0 = (tid & 7) * 8;
        float re[8], im[8];
#pragma unroll
        for (int q = 0; q < 8; ++q) { re[q] = 0.f; im[q] = 0.f; }
#pragma unroll
        for (int s1 = 0; s1 < 4; ++s1) { const int idx = (16 * s1 * k1) & 63; const float wr = bf2f(Wc[FM_LD + idx]), wi = bf2f(Ws[FM_LD + idx]);
#pragma unroll
            for (int q = 0; q < 8; ++q) { const float gr = bf2f(Gre[(m0 + q) * FM_LD + s1 * 16 + s2l]), gi = bf2f(Gim[(m0 + q) * FM_LD + s1 * 16 + s2l]); re[q] += wr * gr + wi * gi; im[q] += wr * gi - wi * gr; } }
        bf16_t* dst = F2 + (size_t)NLAT * 512 + ((((size_t)(b * 4 + g) * 4 + k1) * 64 + s2 * 16 + s2l) * 2) * 64 + m0;
        u32x4 o; o.x = pk2(re[0], re[1]); o.y = pk2(re[2], re[3]); o.z = pk2(re[4], re[5]); o.w = pk2(re[6], re[7]); *(u32x4*)dst = o;
        o.x = pk2(im[0], im[1]); o.y = pk2(im[2], im[3]); o.z = pk2(im[4], im[5]); o.w = pk2(im[6], im[7]); *(u32x4*)(dst + 64) = o;
    }
}
template <bool CTXM>
__device__ __forceinline__ void fm3_unit(int unit, const bf16_t* F2, bf16_t* MIX, LAS unsigned char* lds, int tid) {
    const LAS bf16_t* Wc = (const LAS bf16_t*)(lds + FM_WC); const LAS bf16_t* Ws = (const LAS bf16_t*)(lds + FM_WS);
    LAS bf16_t* AT = (LAS bf16_t*)(lds + FM_AT);
    constexpr int N1 = CTXM ? 4 : 64; constexpr float NRM = CTXM ? (1.f / 128.f) : (1.f / 512.f);
    int b, g, kp;
    if (!CTXM) { b = unit >> 7; g = (unit >> 5) & 3; kp = unit & 31; } else { b = unit >> 3; g = (unit >> 1) & 3; kp = unit & 1; }
    const bf16_t* F2b = F2 + (CTXM ? (size_t)NLAT * 512 : 0);
    const size_t tok0 = CTXM ? (size_t)NLAT + b * CTXL : (size_t)b * SEQ;
    const int lane = tid & 63, wave = tid >> 6, r = lane & 31, h = lane >> 5;
    LAS f32x2* tw = (LAS f32x2*)(lds + FM_TW);
    if (tid < 128) { const int ki = tid >> 6, s2 = tid & 63; float sn, cs; sincos_rev((float)(s2 * (kp * 2 + ki)) * (1.f / (64.f * N1)), sn, cs); tw[tid] = (f32x2){cs, sn}; }
    __syncthreads();
#pragma unroll
    for (int ki = 0; ki < 2; ++ki) { const bf16_t* img = F2b + (((size_t)(b * 4 + g) * N1 + kp * 2 + ki) * 64) * 128;
        const int s2 = tid >> 3, mch = tid & 7;
        const u32x4 rv = *(const u32x4*)(img + s2 * 128 + mch * 8), iv = *(const u32x4*)(img + s2 * 128 + 64 + mch * 8);
        const f32x2 t = tw[ki * 64 + s2]; const float cs = t.x, sn = t.y;
        const float re[8] = {bflo(rv.x), bfhi(rv.x), bflo(rv.y), bfhi(rv.y), bflo(rv.z), bfhi(rv.z), bflo(rv.w), bfhi(rv.w)};
        const float im[8] = {bflo(iv.x), bfhi(iv.x), bflo(iv.y), bfhi(iv.y), bflo(iv.z), bfhi(iv.z), bflo(iv.w), bfhi(iv.w)};
        const int col = (((s2 >> 3) ^ mch) << 3) | (s2 & 7);
        LAS bf16_t* are = AT + (ki * 2 + 0) * 64 * FM_LD + (mch * 8) * FM_LD + col; LAS bf16_t* aim = AT + (ki * 2 + 1) * 64 * FM_LD + (mch * 8) * FM_LD + col;
#pragma unroll
        for (int q = 0; q < 8; ++q) { are[q * FM_LD] = (bf16_t)f2bf(re[q] * cs + im[q] * sn); aim[q * FM_LD] = (bf16_t)f2bf(im[q] * cs - re[q] * sn); }
    }
    __syncthreads();
    { const int ki = wave >> 2, tr = (wave >> 1) & 1, tc = wave & 1;
        f32x16 acc = {};
        fm_mm<true>(acc, Wc, tr * 32, AT + (ki * 2 + 0) * 64 * FM_LD, tc * 32, lane);
        fm_mm<true>(acc, Ws, tr * 32, AT + (ki * 2 + 1) * 64 * FM_LD, tc * 32, lane);
        LAS bf16_t* OUT = (LAS bf16_t*)(lds + FM_OUT3) + ki * 64 * FM_LD;
#pragma unroll
        for (int reg = 0; reg < 16; ++reg) OUT[(tr * 32 + fm_crow(reg, h)) * FM_LD + tc * 32 + r] = (bf16_t)f2bf(acc[reg] * NRM);
    }
    __syncthreads();
#pragma unroll
    for (int i = 0; i < 2; ++i) { const int c = tid + NTHR * i, ki = c >> 9, k2 = (c >> 3) & 63, mch = (c & 7) * 8;
        *(u32x4*)(MIX + (tok0 + kp * 2 + ki + N1 * k2) * MIX_W + 768 + g * 64 + mch) = *(const LAS u32x4*)((LAS bf16_t*)(lds + FM_OUT3) + (ki * 64 + k2) * FM_LD + mch); }
    __syncthreads();
}

constexpr int N2_SSQ = 0, N2_PART = 1024, N2_LG = N2_PART + 8 * 32 * 33 * 4, N2_HIST = N2_LG + 32 * 33 * 4, N2_TA = 40960, N2_TB = N2_TA + 9 * DM * 4, N2_END = N2_TB + 9 * DM * 4;
static_assert(N2_HIST + 128 <= N2_TA && N2_END <= LDS_FREE, "norm2 LDS");
__device__ __forceinline__ void hilo8(const float (&v)[8], bf16x8& hi, bf16x8& lo) {
    u32x4 H, L;
#pragma unroll
    for (int j = 0; j < 4; ++j) { const unsigned hw = pk2(v[2 * j], v[2 * j + 1]); H[j] = hw; L[j] = pk2(v[2 * j] - bflo(hw), v[2 * j + 1] - bfhi(hw)); }
    hi = __builtin_bit_cast(bf16x8, H); lo = __builtin_bit_cast(bf16x8, L);
}
__device__ __forceinline__ void n2_tables(int l, const Args& a, LAS unsigned char* lds, int t, int nt) {
    const float* mods_l = (const float*)(a.ws + WS_MODS) + (size_t)l * 9 * NMOD; const float* gain = a.in[I_NFFN] + l * DM;
    LAS float* TA = (LAS float*)(lds + N2_TA); LAS float* TB = (LAS float*)(lds + N2_TB); LAS int* hist = (LAS int*)(lds + N2_HIST);
    if (t < NE) hist[t] = 0;
    for (int i = t; i < 9 * DM; i += nt) { const int rr = i >> 10, k = i & 1023; TA[i] = gain[k] * (1.f + mods_l[(size_t)rr * NMOD + 4 * DM + k]); TB[i] = mods_l[(size_t)rr * NMOD + 3 * DM + k]; }
}
template <bool PRE>
__device__ __forceinline__ void ph_norm2(int l, int ntok, const Args& a, LAS unsigned char* lds, int wg, int tid) {
    const int lane = tid & 63, wave = tid >> 6, r = lane & 31, h = lane >> 5;
    unsigned char* ws = a.ws;
    const bf16_t* XA = (const bf16_t*)(ws + WS_XA); unsigned char* H8 = (unsigned char*)(ws + WS_H8);
    const float* mods_l = (const float*)(ws + WS_MODS) + (size_t)l * 9 * NMOD;
    const float* gain = a.in[I_NFFN] + l * DM; const float* rw = a.in[I_RW] + (size_t)l * DM * NE; const float* rb = a.in[I_RB] + l * NE;
    int* tok_e = (int*)(ws + WS_TOKE); float* tok_p = (float*)(ws + WS_TOKP); int* counts = (int*)(ws + WS_CNT);
    LAS float* ssq = (LAS float*)(lds + N2_SSQ); LAS float* part = (LAS float*)(lds + N2_PART); LAS float* lg = (LAS float*)(lds + N2_LG); LAS int* hist = (LAS int*)(lds + N2_HIST);
    LAS float* TA = (LAS float*)(lds + N2_TA); LAS float* TB = (LAS float*)(lds + N2_TB);
    if (!PRE) n2_tables(l, a, lds, tid, NTHR);
    bf16x8 Bhi[8], Blo[8];
#pragma unroll
    for (int s = 0; s < 8; ++s) { float v[8];
#pragma unroll
        for (int j = 0; j < 8; ++j) v[j] = rw[(size_t)(128 * wave + 16 * s + 8 * h + j) * NE + r];
        hilo8(v, Bhi[s], Blo[s]); }
    __syncthreads();
    const int ntile = ntok / 32;
    u32x4 xraw[8];
    if (wg < ntile) { const bf16_t* xr0 = XA + (size_t)(wg * 32 + r) * DM + 128 * wave + 8 * h;
#pragma unroll
        for (int s = 0; s < 8; ++s) xraw[s] = *(const u32x4*)(xr0 + 16 * s); }
    for (int tile = wg; tile < ntile; tile += NWG) {
        const int t = tile * 32 + r;
        f32x4 xv[8][2]; float ss = 0.f;
#pragma unroll
        for (int s = 0; s < 8; ++s) { xv[s][0] = (f32x4){bflo(xraw[s].x), bfhi(xraw[s].x), bflo(xraw[s].y), bfhi(xraw[s].y)}; xv[s][1] = (f32x4){bflo(xraw[s].z), bfhi(xraw[s].z), bflo(xraw[s].w), bfhi(xraw[s].w)}; }
        if (tile + NWG < ntile) { const bf16_t* xrn = XA + (size_t)((tile + NWG) * 32 + r) * DM + 128 * wave + 8 * h;
#pragma unroll
            for (int s = 0; s < 8; ++s) xraw[s] = *(const u32x4*)(xrn + 16 * s); }
#pragma unroll
        for (int s = 0; s < 8; ++s) ss += (xv[s][0].x * xv[s][0].x + xv[s][0].y * xv[s][0].y + xv[s][0].z * xv[s][0].z + xv[s][0].w * xv[s][0].w) + (xv[s][1].x * xv[s][1].x + xv[s][1].y * xv[s][1].y + xv[s][1].z * xv[s][1].z + xv[s][1].w * xv[s][1].w);
        { auto rr = __builtin_amdgcn_permlane32_swap(__float_as_uint(ss), __float_as_uint(ss), false, false); ss = __uint_as_float(rr[0]) + __uint_as_float(rr[1]); }
        if (h == 0) ssq[wave * 32 + r] = ss;
        __syncthreads();
        float tot = 0.f;
#pragma unroll
        for (int w = 0; w < 8; ++w) tot += ssq[w * 32 + r];
        const float rstd = rsqrtf(tot * (1.f / DM) + EPS);
        f32x16 acc = {};
        const LAS float* ta = TA + tok_bidx(tile * 32) * DM + 128 * wave + 8 * h; const LAS float* tb = TB + tok_bidx(tile * 32) * DM + 128 * wave + 8 * h;
#pragma unroll
        for (int s = 0; s < 8; ++s) {
            const f32x4 y0 = (xv[s][0] * rstd) * *(const LAS f32x4*)(ta + 16 * s) + *(const LAS f32x4*)(tb + 16 * s), y1 = (xv[s][1] * rstd) * *(const LAS f32x4*)(ta + 16 * s + 4) + *(const LAS f32x4*)(tb + 16 * s + 4);
            const float v[8] = {y0.x, y0.y, y0.z, y0.w, y1.x, y1.y, y1.z, y1.w};
            u32x2 o8; o8.x = pg8::cvt4_fp8(v[0], v[1], v[2], v[3]); o8.y = pg8::cvt4_fp8(v[4], v[5], v[6], v[7]);
            *(u32x2*)(H8 + (size_t)t * DM + 128 * wave + 16 * s + 8 * h) = o8;
            bf16x8 ahi, alo; hilo8(v, ahi, alo);
            acc = __builtin_amdgcn_mfma_f32_32x32x16_bf16(ahi, Bhi[s], acc, 0, 0, 0);
            acc = __builtin_amdgcn_mfma_f32_32x32x16_bf16(alo, Bhi[s], acc, 0, 0, 0);
            acc = __builtin_amdgcn_mfma_f32_32x32x16_bf16(ahi, Blo[s], acc, 0, 0, 0); }
#pragma unroll
        for (int reg = 0; reg < 16; ++reg) part[(wave * 32 + fm_crow(reg, h)) * 33 + r] = acc[reg];
        __syncthreads();
#pragma unroll
        for (int q = 0; q < 2; ++q) { const int idx = tid + NTHR * q, tk = idx >> 5, e = idx & 31; float sm = rb[e];
#pragma unroll
            for (int w = 0; w < 8; ++w) sm += part[(w * 32 + tk) * 33 + e];
            lg[tk * 33 + e] = sm; }
        __syncthreads();
#pragma unroll
        for (int q = 0; q < 2; ++q) { const int tk = wave * 4 + q * 2 + h;
            float v = lg[tk * 33 + r]; float bv[4]; int be[4];
#pragma unroll
            for (int j = 0; j < 4; ++j) { float m = v;
                m = fmaxf(m, xor_swz<1>(m)); m = fmaxf(m, xor_swz<2>(m)); m = fmaxf(m, xor_swz<4>(m)); m = fmaxf(m, xor_swz<8>(m)); m = fmaxf(m, xor_swz<16>(m));
                const unsigned long long bal = __ballot(v == m); const unsigned mine = (unsigned)(bal >> (32 * h));
                const int idx = __builtin_ctz(mine);
                bv[j] = m; be[j] = idx; if (r == idx) v = -3.0e38f; }
            if (r == 0) { const float e1 = __expf(bv[1] - bv[0]), e2 = __expf(bv[2] - bv[0]), e3 = __expf(bv[3] - bv[0]); const float inv = __builtin_amdgcn_rcpf(1.f + e1 + e2 + e3);
                const int tt = tile * 32 + tk;
                *(int4*)(tok_e + (size_t)tt * 4) = make_int4(be[0], be[1], be[2], be[3]);
                *(float4*)(tok_p + (size_t)tt * 4) = make_float4(inv, e1 * inv, e2 * inv, e3 * inv);
#pragma unroll
                for (int j = 0; j < 4; ++j) atomicAdd((int*)&hist[be[j]], 1); } }
    }
    __syncthreads();
    if (tid < NE) counts[wg * NE + tid] = hist[tid];
}

constexpr int RT_PSUM = 0, RT_PPRE = 2048, RT_TOT = 4096, RT_BASE = 4224, RT_OFF = 4352, RT_POS = 4608;
__device__ __forceinline__ void ph_route(int ntok, const Args& a, LAS unsigned char* lds, int wg, int tid) {
    const int lane = tid & 63, wave = tid >> 6;
    unsigned char* ws = a.ws;
    const int* counts = (const int*)(ws + WS_CNT); int* eoff = (int*)(ws + WS_EOFF);
    const int* tok_e = (const int*)(ws + WS_TOKE); const float* tok_p = (const float*)(ws + WS_TOKP); int* tokpos = (int*)(ws + WS_TOKPOS); float* roww = (float*)(ws + WS_ROWW);
    int* rowtok = (int*)(ws + WS_ROWTOK);
    LAS int* psum = (LAS int*)(lds + RT_PSUM); LAS int* ppre = (LAS int*)(lds + RT_PPRE); LAS int* tot = (LAS int*)(lds + RT_TOT); LAS int* base = (LAS int*)(lds + RT_BASE); LAS int* off = (LAS int*)(lds + RT_OFF); LAS int* posb = (LAS int*)(lds + RT_POS);
    { const int e = tid & 31, part = tid >> 5; int s = 0, pre = 0;
        for (int w = part * 16; w < part * 16 + 16; ++w) { const int c = counts[w * NE + e]; if (w < wg) pre += c; s += c; }
        psum[part * 32 + e] = s; ppre[part * 32 + e] = pre; }
    __syncthreads();
    if (tid < NE) { int s = 0, pre = 0;
        for (int p = 0; p < 16; ++p) { s += psum[p * 32 + tid]; pre += ppre[p * 32 + tid]; }
        tot[tid] = s; base[tid] = pre; }
    __syncthreads();
    if (tid == 0) { int o = 0; for (int e = 0; e < NE; ++e) { off[e] = o; o += (tot[e] + 255) & ~255; } off[NE] = o; }
    __syncthreads();
    if (wg == 0 && tid <= NE) eoff[tid] = off[tid];
    { LAS int* tab = (LAS int*)(lds + LDS_TAB); const int nMt_ = off[NE] >> 8;
        for (int i = tid; i < nMt_; i += NTHR) { const int row = i << 8; int e = 0;
            for (int q = 1; q < NE; ++q) if (off[q] <= row) e = q;
            tab[i] = e; }
        if (tid == 0) tab[LDS_TAB_NMT] = nMt_; }
    const int ntile = ntok / 32, ntw = (ntile - wg + NWG - 1) / NWG, nas = ntw * 128;
#define RT_TOK(ai) ((wg + NWG * ((ai) >> 7)) * 32 + (((ai) >> 2) & 31))
    if (wave == 0) {
        constexpr int MAXCH = 10; static_assert((NTOK / 32 + NWG - 1) / NWG * 128 <= MAXCH * 64, "route chunks");
        if (lane < NE) posb[lane] = off[lane] + base[lane];
        int ev[MAXCH]; float pw[MAXCH];
#pragma unroll
        for (int k = 0; k < MAXCH; ++k) { const int aidx = 64 * k + lane; const bool valid = aidx < nas; const size_t gi = valid ? (size_t)RT_TOK(aidx) * 4 + (aidx & 3) : 0;
            ev[k] = valid ? tok_e[gi] : -1; pw[k] = valid ? tok_p[gi] : 0.f; }
#pragma unroll
        for (int k = 0; k < MAXCH; ++k) if (64 * k < nas) {
            const int e = ev[k], aidx = 64 * k + lane; const bool valid = e >= 0;
            unsigned long long m = __ballot(valid);
#pragma unroll
            for (int b = 0; b < 5; ++b) { const bool bit = (e >> b) & 1; const unsigned long long bb = __ballot(bit); m &= bit ? bb : ~bb; }
            const int rank = (int)__builtin_amdgcn_mbcnt_hi((unsigned)(m >> 32), __builtin_amdgcn_mbcnt_lo((unsigned)m, 0u));
            const int rs = posb[valid ? e : 0];
            if (valid && rank == 0) posb[e] = rs + __popcll(m);
            if (valid) { const size_t gi = (size_t)RT_TOK(aidx) * 4 + (aidx & 3); const int pos = rs + rank; tokpos[gi] = pos; roww[pos] = pw[k]; rowtok[pos] = RT_TOK(aidx); } }
    }
    if (wg < NE) { const int p0 = off[wg] + tot[wg], p1 = off[wg + 1]; for (int p = p0 + tid; p < p1; p += NTHR) rowtok[p] = 0; }
#undef RT_TOK
}
__device__ __forceinline__ int moe_tiles(const unsigned char* ws, LAS unsigned char* lds, int tid) {
    const int* eoff = (const int*)(ws + WS_EOFF); LAS int* tab = (LAS int*)(lds + LDS_TAB);
    const int total = eoff[NE];
    const int nMt = total >> 8;
    for (int i = tid; i < nMt; i += NTHR) { const int row = i << 8; int e = 0;
        for (int q = 1; q < NE; ++q) if (eoff[q] <= row) e = q;
        tab[i] = e; }
    __syncthreads();
    return __builtin_amdgcn_readfirstlane(nMt);
}

__device__ __forceinline__ f32x4 fp8x4_to_f32(unsigned w) {
    const f32x2 lo = __builtin_amdgcn_cvt_pk_f32_fp8((int)w, false), hi = __builtin_amdgcn_cvt_pk_f32_fp8((int)w, true);
    return (f32x4){lo.x, lo.y, hi.x, hi.y};
}
constexpr int CB_G2 = 0, CB_SH = 9 * DM * 4, CB_SC = 2 * 9 * DM * 4, CB_GN = 3 * 9 * DM * 4, CB_END = CB_GN + DM * 4;
static_assert(CB_END <= LDS_FREE, "combine LDS");
__device__ __forceinline__ void fp8x16_acc(f32x4 (&acc)[4], const u32x4 y) {
    const unsigned w[4] = {y.x, y.y, y.z, y.w};
#pragma unroll
    for (int i = 0; i < 4; ++i) { const f32x2 lo = __builtin_amdgcn_cvt_pk_f32_fp8((int)w[i], false), hi = __builtin_amdgcn_cvt_pk_f32_fp8((int)w[i], true); acc[i] += (f32x4){lo.x, lo.y, hi.x, hi.y}; }
}
__device__ __forceinline__ void cb_tables(int l, const Args& a, LAS unsigned char* lds, int t, int nt) {
    const float* mods_l = (const float*)(a.ws + WS_MODS) + (size_t)l * 9 * NMOD; const bool more = l < DEPTH - 1;
    LAS float* Lg2 = (LAS float*)(lds + CB_G2); LAS float* Lsh = (LAS float*)(lds + CB_SH); LAS float* Lsc = (LAS float*)(lds + CB_SC); LAS float* Lgn = (LAS float*)(lds + CB_GN);
    for (int i = t; i < 9 * DM; i += nt) { const int r = i >> 10, k = i & 1023;
        Lg2[i] = mods_l[(size_t)r * NMOD + 5 * DM + k] * YR_INV;
        if (more) { Lsh[i] = mods_l[(size_t)(9 + r) * NMOD + k]; Lsc[i] = mods_l[(size_t)(9 + r) * NMOD + DM + k] + 1.f; } }
    for (int i = t; i < DM; i += nt) Lgn[i] = more ? a.in[I_NMIX][(l + 1) * DM + i] : a.in[I_FN][i];
}
template <bool PRE>
__device__ __forceinline__ void ph_combine(int l, int ntok, const Args& a, LAS unsigned char* lds, int gw, int NGW, int tid) {
    const int lane = tid & 63;
    unsigned char* ws = a.ws;
    const bf16_t* XA = (const bf16_t*)(ws + WS_XA); bf16_t* XB = (bf16_t*)(ws + WS_XB); const unsigned char* YR = (const unsigned char*)(ws + WS_YR);
    const int* tokpos = (const int*)(ws + WS_TOKPOS);
    const float* mods_l = (const float*)(ws + WS_MODS) + (size_t)l * 9 * NMOD;
    const bool more = l < DEPTH - 1;
    LAS float* Lg2 = (LAS float*)(lds + CB_G2); LAS float* Lsh = (LAS float*)(lds + CB_SH); LAS float* Lsc = (LAS float*)(lds + CB_SC); LAS float* Lgn = (LAS float*)(lds + CB_GN);
    if (!PRE) cb_tables(l, a, lds, tid, NTHR);
    __syncthreads();
    bf16_t* HA = (bf16_t*)(ws + WS_HA); unsigned char* HA8 = ws + WS_HA8;
    const int k0 = 16 * lane;
    for (int t0 = gw * 2; t0 < ntok; t0 += NGW * 2) {
        u32x4 y[2][4], xr[2][2];
#pragma unroll
        for (int r = 0; r < 2; ++r) { const int t = t0 + r; const int4 pp = *(const int4*)(tokpos + (size_t)t * 4);
            y[r][0] = *(const u32x4*)(YR + (size_t)pp.x * DM + k0); y[r][1] = *(const u32x4*)(YR + (size_t)pp.y * DM + k0);
            y[r][2] = *(const u32x4*)(YR + (size_t)pp.z * DM + k0); y[r][3] = *(const u32x4*)(YR + (size_t)pp.w * DM + k0);
            xr[r][0] = *(const u32x4*)(XA + (size_t)t * DM + k0); xr[r][1] = *(const u32x4*)(XA + (size_t)t * DM + k0 + 8); }
#pragma unroll
        for (int r = 0; r < 2; ++r) { const int t = t0 + r, bi = tok_bidx(t);
            int kt = k0; asm volatile("" : "+v"(kt));
            f32x4 ff[4] = {{0.f, 0.f, 0.f, 0.f}, {0.f, 0.f, 0.f, 0.f}, {0.f, 0.f, 0.f, 0.f}, {0.f, 0.f, 0.f, 0.f}};
            fp8x16_acc(ff, y[r][0]); fp8x16_acc(ff, y[r][1]); fp8x16_acc(ff, y[r][2]); fp8x16_acc(ff, y[r][3]);
            const unsigned xw[8] = {xr[r][0].x, xr[r][0].y, xr[r][0].z, xr[r][0].w, xr[r][1].x, xr[r][1].y, xr[r][1].z, xr[r][1].w};
            f32x4 v[4]; float ss = 0.f;
#pragma unroll
            for (int j = 0; j < 4; ++j) { const f32x4 xv = {bflo(xw[2 * j]), bfhi(xw[2 * j]), bflo(xw[2 * j + 1]), bfhi(xw[2 * j + 1])};
                v[j] = xv + *(const LAS f32x4*)(Lg2 + bi * DM + kt + 4 * j) * ff[j];
                ss += v[j].x * v[j].x + v[j].y * v[j].y + v[j].z * v[j].z + v[j].w * v[j].w; }
            const float rstd = rsqrtf(wave_sum(ss) * (1.f / DM) + EPS);
            if (more) {
                u32x4 xo[2], ho[2]; unsigned h8[4];
#pragma unroll
                for (int j = 0; j < 4; ++j) { const f32x4 y2 = (v[j] * rstd * *(const LAS f32x4*)(Lgn + kt + 4 * j)) * *(const LAS f32x4*)(Lsc + bi * DM + kt + 4 * j) + *(const LAS f32x4*)(Lsh + bi * DM + kt + 4 * j);
                    xo[j >> 1][(j & 1) * 2] = pk2(v[j].x, v[j].y); xo[j >> 1][(j & 1) * 2 + 1] = pk2(v[j].z, v[j].w);
                    ho[j >> 1][(j & 1) * 2] = pk2(y2.x, y2.y); ho[j >> 1][(j & 1) * 2 + 1] = pk2(y2.z, y2.w); h8[j] = pg8::cvt4_fp8(y2.x, y2.y, y2.z, y2.w); }
                *(u32x4*)(XB + (size_t)t * DM + k0) = xo[0]; *(u32x4*)(XB + (size_t)t * DM + k0 + 8) = xo[1];
                *(u32x4*)(HA + (size_t)t * DM + k0) = ho[0]; *(u32x4*)(HA + (size_t)t * DM + k0 + 8) = ho[1];
                *(u32x4*)(HA8 + (size_t)t * DM + k0) = (u32x4){h8[0], h8[1], h8[2], h8[3]};
            } else {
#pragma unroll
                for (int j = 0; j < 4; ++j) *(f32x4*)(a.out + (size_t)t * DM + k0 + 4 * j) = v[j] * rstd * *(const LAS f32x4*)(Lgn + kt + 4 * j);
            } }
    }
    __syncthreads();
}

constexpr int PH_PER_LAYER = 10, N_PHASES = 1 + DEPTH * PH_PER_LAYER;
#if MK_ONE_LAUNCH
#define GRID_BAR() do { XcdBarrier b_ = bar; asm volatile("" : "+s"(b_.bar), "+s"(b_.x)); xcd_barrier(b_, [](int, int) {}); } while (0)
#define GRID_BAR_W(...) do { XcdBarrier b_ = bar; asm volatile("" : "+s"(b_.bar), "+s"(b_.x)); xcd_barrier(b_, [&](int t_, int nt_) { __VA_ARGS__; }); } while (0)
#define GRID_BAR_P(k) do { if constexpr (p0_slot(k) >= 0) GRID_BAR_W((void)nt_; p0_slot_items(load_args(), lds, wg, p0_slot(k), t_)); else GRID_BAR(); } while (0)
#else
#define GRID_BAR() do {} while (0)
#define GRID_BAR_W(...) do {} while (0)
#define GRID_BAR_P(k) do {} while (0)
#endif
#define IN(k) (lo <= (k) && (k) < hi)
#define BOTH(k) (IN(k) && IN((k) + 1))
#define REPEAT(R) _Pragma("unroll") for (int rp_ = 0; rp_ < (R); ++rp_)
#define GWAVE() (wg * NWAVES + wv)
#define ptid() ptid_w(wv)
template <int LAYER>
__device__ __forceinline__ void layer_phases(LAS unsigned char* lds, unsigned char* lds_raw, const XcdBarrier& bar, int lo, int hi, int wg, int G, int wv) {
        constexpr int l = LAYER, pb = 1 + PH_PER_LAYER * l;
        constexpr bool last = (l == DEPTH - 1);
        constexpr int ntok_l = last ? NLAT : NTOK;

        if (IN(pb + 0) && l == 0) { REPEAT(REP_NORM1) { const Args a = load_args();
                const float* xlat = (l == 0) ? a.in[I_X] : (const float*)(a.ws + WS_XB);
                const float* xctx = (l == 0) ? a.in[I_CTX] : (const float*)(a.ws + WS_XB) + (size_t)NLAT * DM;
                ph_norm1(xlat, xctx, a.in[I_NMIX] + l * DM, (const float*)(a.ws + WS_MODS) + (size_t)l * 9 * NMOD, (bf16_t*)(a.ws + WS_HA), a.ws + WS_HA8, GWAVE(), G * NWAVES, ptid() & 63); }
            if (BOTH(pb + 0)) GRID_BAR_P(pb + 0); }

        if (IN(pb + 1)) {
            const Args a = load_args();
            REPEAT(REP_GEMM) {
            { pg8::Gemm g{a.ws + WS_HA8, a.ws + WS_WIN8 + (size_t)l * IN_W * DM, DM};
                constexpr int G8 = last ? 256 : 208;
                pg8::SchedSub<4> S; S.G = (G == 256) ? G8 : G; S.c = wg; S.first = 0; S.cfirst = last ? 2 : 0; S.nctx = last ? 2 : 4; S.rev = false;
                pg8::EpiStoreBf16 E{(bf16_t*)(a.ws + WS_U), IN_W, W8_INV};
                if (wg < S.G) pg8::gemm_phase<true>(lds, g, S, E, ptid()); }
            { pg8::Gemm g{a.ws + WS_HA, (const bf16_t*)(a.ws + WS_WIN) + (size_t)l * IN_W * DM, DM * 2};
                pg8::SchedSub<6> S; S.G = G; S.c = wg; S.first = 4; S.cfirst = 4; S.nctx = last ? 0 : 6; S.rev = true;
                pg8::EpiStoreBf16 E{(bf16_t*)(a.ws + WS_U), IN_W, 1.f};
                pg8::gemm_phase<false>(lds, g, S, E, ptid()); }
            }
            if (BOTH(pb + 1)) GRID_BAR_P(pb + 1);
        }

        if (IN(pb + 2)) REPEAT(REP_PREP) {
            const Args a = load_args();
            ph_qkv(l, a, lds, wg, ptid());
            ph_conv_tiles(l, a, lds, wg, ptid());
            const bf16_t* U = (const bf16_t*)(a.ws + WS_U); bf16_t* F2 = (bf16_t*)(a.ws + WS_F2);
            fm_tables(lds, ptid());
            if (!last && wg >= 128) fm12_unit<true>(wg - 128, U, F2, lds, ptid());
            for (int u = wg; u < 2048; u += G) fm12_unit<false>(u, U, F2, lds, ptid());
            __syncthreads();
            if (rp_ + 1 == REP_PREP && BOTH(pb + 2)) GRID_BAR_P(pb + 2);
        }

        if (IN(pb + 3)) REPEAT(REP_ATTN) {
            const Args a = load_args();
            const unsigned char* QB = a.ws + WS_QB; const unsigned char* KB = a.ws + WS_KB; const unsigned char* VT = a.ws + WS_VB; bf16_t* MIX = (bf16_t*)(a.ws + WS_MIX);
            const int x = wg & 7, rk = wg >> 3;
            const int nun = (!last && wg < 32) ? 3 : 2;
            for (int i = 0; i < nun; ++i) {
                int b, h, kvh, seq; size_t trow;
                if (i < 2) { const int set = i * 8 + x; b = set >> 1; kvh = set & 1; h = kvh * 2 + (rk >> 4); trow = (size_t)b * SEQ + (rk & 15) * 256; seq = SKV; }
                else { b = wg >> 2; h = wg & 3; kvh = h >> 1; trow = (size_t)NLAT + b * CTXL; seq = CTXL; }
                att8::attn_body<512, MIX_W>(QB + trow * 512 + h * 128, KB + (size_t)(b * 2 + kvh) * SKV * 128, VT + (size_t)(b * 2 + kvh) * SKV * 128, MIX + trow * MIX_W + h * 128, seq, (char*)lds_raw, ptid()); }
            const bf16_t* F2 = (const bf16_t*)(a.ws + WS_F2);
            fm_tables(lds, ptid());
            if (!last && wg >= 192) fm3_unit<true>(wg - 192, F2, MIX, lds, ptid());
            for (int u = wg; u < 1024; u += G) fm3_unit<false>(u, F2, MIX, lds, ptid());
            if (rp_ + 1 == REP_ATTN && BOTH(pb + 3)) GRID_BAR_P(pb + 3);
        }

        if (IN(pb + 4)) {
            const Args a = load_args();
            pg8::Gemm g{a.ws + WS_MIX, (const bf16_t*)(a.ws + WS_WOUT) + (size_t)l * DM * MIX_W, MIX_W * 2};
            pg8::SchedGrid<4> S; S.G = G; S.c = wg; S.nM = ntok_l / 256;
            const float* gate = (const float*)(a.ws + WS_MODS) + (size_t)l * 9 * NMOD + 2 * DM;
            if (l == 0) { pg8::EpiResidual<false> E{a.in[I_X], a.in[I_CTX], (bf16_t*)(a.ws + WS_XA), gate};
                REPEAT(REP_GEMM) pg8::gemm_phase<false>(lds, g, S, E, ptid());
                if (G == NWG && wg >= 32) { const int t_ = ptid(); p0_items(a, lds, (wg - 32) * NWAVES + (t_ >> 6), (NWG - 32) * NWAVES, P0_ITEMS - P0_DEFER, P0_ITEMS, t_); __syncthreads(); }
                else if (G != NWG) { const int t_ = ptid(); p0_items(a, lds, wg * NWAVES + (t_ >> 6), G * NWAVES, P0_ITEMS - P0_DEFER, P0_ITEMS, t_); __syncthreads(); } }
            else { pg8::EpiResidual<true> E{a.ws + WS_XB, a.ws + WS_XB + (size_t)NLAT * DM * 2, (bf16_t*)(a.ws + WS_XA), gate};
                REPEAT(REP_GEMM) pg8::gemm_phase<false>(lds, g, S, E, ptid()); }
            if (BOTH(pb + 4)) GRID_BAR_W(n2_tables(l, load_args(), lds, t_, nt_));
        }

        if (IN(pb + 5)) { REPEAT(REP_N2) { const Args a = load_args(); ph_norm2<MK_ONE_LAUNCH != 0>(l, ntok_l, a, lds, wg, ptid()); __syncthreads(); } if (BOTH(pb + 5)) GRID_BAR_P(pb + 5); }
        if (IN(pb + 6)) { REPEAT(REP_ROUTE) { const Args a = load_args(); ph_route(ntok_l, a, lds, wg, ptid()); __syncthreads(); } if (BOTH(pb + 6)) GRID_BAR_P(pb + 6); }

        if (IN(pb + 7)) {
            const Args a = load_args();
#if MK_ONE_LAUNCH
            const int nMt = __builtin_amdgcn_readfirstlane(((const LAS int*)(lds + LDS_TAB))[LDS_TAB_NMT]);
#else
            const int nMt = moe_tiles(a.ws, lds, ptid());
#endif
            { const int* rowtok = (const int*)(a.ws + WS_ROWTOK); LAS int* ltok = (LAS int*)(lds + LDS_LTOK); const int t_ = ptid();
                const int nun = (nMt * 8 - wg + G - 1) / G;
                for (int idx = t_; idx < nun * 256; idx += NTHR) { int pm, pn; pg8::tile_order<8>((idx >> 8) * G + wg, nMt, pm, pn); ltok[idx] = rowtok[pm * 256 + (idx & 255)]; }
                __syncthreads(); }
            pg8::Gemm g{a.ws + WS_H8, a.ws + WS_WUP + (size_t)l * NE * 2048 * DM, DM};
            pg8::SchedMoe<8, true> S{G, wg, nMt, (const LAS int*)(lds + LDS_TAB), (const LAS int*)(lds + LDS_LTOK)};
            pg8::EpiSwiGLU E{(unsigned char*)(a.ws + WS_ACT), a.in[I_BUP] + (size_t)l * NE * 2048};
            REPEAT(REP_MOE) pg8::gemm_phase<true>(lds, g, S, E, ptid());
            if (BOTH(pb + 7)) GRID_BAR_P(pb + 7);
        }
        if (IN(pb + 8)) {
            const Args a = load_args();
#if MK_ONE_LAUNCH
            const int nMt = __builtin_amdgcn_readfirstlane(((const LAS int*)(lds + LDS_TAB))[LDS_TAB_NMT]);
#else
            const int nMt = moe_tiles(a.ws, lds, ptid());
#endif
            pg8::Gemm g{a.ws + WS_ACT, a.ws + WS_WDN + (size_t)l * NE * DM * DFF, DFF};
            pg8::SchedMoe<4, false> S{G, wg, nMt, (const LAS int*)(lds + LDS_TAB), nullptr};
            pg8::EpiDown E{(unsigned char*)(a.ws + WS_YR), a.in[I_BDN] + (size_t)l * NE * DM, (const float*)(a.ws + WS_ROWW)};
            REPEAT(REP_MOE) pg8::gemm_phase<true>(lds, g, S, E, ptid());
            if (BOTH(pb + 8)) GRID_BAR_W(cb_tables(l, load_args(), lds, t_, nt_));
        }
        if (IN(pb + 9)) { REPEAT(REP_COMB) { const Args a = load_args(); ph_combine<MK_ONE_LAUNCH != 0>(l, ntok_l, a, lds, GWAVE(), G * NWAVES, ptid()); } if (BOTH(pb + 9)) GRID_BAR_P(pb + 9); }
}

__global__ void __launch_bounds__(NTHR, 2) mk_fwd(Args a_kernarg) {
    extern __shared__ __attribute__((aligned(16))) unsigned char lds_raw[];
    LAS unsigned char* lds = (LAS unsigned char*)lds_raw;
    const int wg = blockIdx.x, G = gridDim.x, wv = __builtin_amdgcn_readfirstlane(threadIdx.x >> 6);
    volatile LAS unsigned* lctl = (volatile LAS unsigned*)(lds + LDS_CTL);
    if (threadIdx.x < 64) lctl[threadIdx.x] = 0u;
    __syncthreads();
#if MK_ONE_LAUNCH
    XcdBarrier bar = xcd_barrier_post((unsigned*)(a_kernarg.ws + WS_CTL) + 4096, lctl);
#else
    XcdBarrier bar; bar.bar = nullptr; bar.x = 0; bar.st = nullptr;
#endif
    const int lo = a_kernarg.ph_lo, hi = a_kernarg.ph_hi;
    if (IN(0)) { REPEAT(REP_P0) { const Args a = load_args(); p0_prologue(a, lds, wg, ptid()); __syncthreads(); } if (BOTH(0)) GRID_BAR_P(0); }

    layer_phases<0>(lds, lds_raw, bar, lo, hi, wg, G, wv);
    layer_phases<1>(lds, lds_raw, bar, lo, hi, wg, G, wv);
}

extern "C" void kernel_launch(void* const* d_in, const int* in_sizes, int n_in, void* d_out, int out_size, void* d_ws, size_t ws_size, hipStream_t stream) {
    static int ok = 0;
    if (ok == 0) {
        if (n_in != 24 || in_sizes[0] != NLAT * DM || out_size != NLAT * DM || ws_size < WS_END) {
            fprintf(stderr, "kernel_launch: shape mismatch (n_in %d, in0 %d, out %d, ws %zu; need ws >= %zu)\n", n_in, n_in > 0 ? in_sizes[0] : -1, out_size, ws_size, (size_t)WS_END); ok = -1; return; }
        if (hipFuncSetAttribute((const void*)mk_fwd, hipFuncAttributeMaxDynamicSharedMemorySize, LDS_BYTES) != hipSuccess) { fprintf(stderr, "kernel_launch: hipFuncSetAttribute failed\n"); ok = -1; return; }
        int per_cu = 0;
        if (hipOccupancyMaxActiveBlocksPerMultiprocessor(&per_cu, (const void*)mk_fwd, NTHR, LDS_BYTES) != hipSuccess || per_cu < 1)
            fprintf(stderr, "kernel_launch: note: occupancy query reports %d workgroups per CU\n", per_cu);
        (void)hipGetLastError();
        ok = 1;
    }
    if (ok < 0) return;
    if (hipMemsetAsync((char*)d_ws + WS_CTL, 0, CTL_ZERO_BYTES, stream) != hipSuccess) { fprintf(stderr, "kernel_launch: memset failed\n"); return; }
    Args a{};
    for (int i = 0; i < 24; ++i) a.in[i] = (const float*)d_in[i];
    a.out = (float*)d_out; a.ws = (unsigned char*)d_ws;
#if MK_ONE_LAUNCH
    a.ph_lo = 0; a.ph_hi = N_PHASES;
    hipLaunchKernelGGL(mk_fwd, dim3(NWG), dim3(NTHR), LDS_BYTES, stream, a);
#else
    for (int p = 0; p < N_PHASES; ++p) { a.ph_lo = p; a.ph_hi = p + 1; hipLaunchKernelGGL(mk_fwd, dim3(NWG), dim3(NTHR), LDS_BYTES, stream, a); }
#endif
    const hipError_t le = hipPeekAtLastError();
    if (le != hipSuccess) fprintf(stderr, "kernel_launch: launch failed: %s\n", hipGetErrorName(le));
}
```

```cpp
#include <hip/hip_runtime.h>
#include <cstdio>
#include <cstdint>

#ifndef MK_ONE_LAUNCH
#define MK_ONE_LAUNCH 1
#endif

#ifndef REP_P0
#define REP_P0 1
#endif
#ifndef REP_NORM1
#define REP_NORM1 1
#endif
#ifndef REP_PREP
#define REP_PREP 1
#endif
#ifndef REP_N2
#define REP_N2 1
#endif
#ifndef REP_ROUTE
#define REP_ROUTE 1
#endif
#ifndef REP_COMB
#define REP_COMB 1
#endif
#ifndef REP_GEMM
#define REP_GEMM 1
#endif
#ifndef REP_ATTN
#define REP_ATTN 1
#endif
#ifndef REP_MOE
#define REP_MOE 1
#endif
#define LAS __attribute__((address_space(3)))
#define GAS __attribute__((address_space(1)))
typedef unsigned short bf16_t;
typedef short bf16x8 __attribute__((ext_vector_type(8)));
typedef short s16x4 __attribute__((ext_vector_type(4)));
typedef float f32x2 __attribute__((ext_vector_type(2)));
typedef float f32x4 __attribute__((ext_vector_type(4)));
typedef float f32x8 __attribute__((ext_vector_type(8)));
typedef float f32x16 __attribute__((ext_vector_type(16)));
typedef unsigned u32x2 __attribute__((ext_vector_type(2)));
typedef unsigned u32x4 __attribute__((ext_vector_type(4)));

constexpr int DM = 1024, BATCH = 8, SEQ = 4096, CTXL = 256, DEPTH = 2;
constexpr int NLAT = BATCH * SEQ, NCTX = BATCH * CTXL, NTOK = NLAT + NCTX;
constexpr int IN_W = 2560, MIX_W = 1280, NE = 32, TOPK = 4, DFF = 1024;
constexpr int SKV = CTXL + SEQ;
constexpr int NMOD = 6 * DM;
constexpr int MPAD = (NTOK * TOPK / 256 + NE) * 256;
constexpr float EPS = 1e-6f;
constexpr int NWG = 256, NTHR = 512, NWAVES = 8;

constexpr size_t MiB = 1u << 20;
constexpr size_t WS_CTL = 0, CTL_ZERO_BYTES = 1 * MiB;
constexpr size_t WS_MODS = 1 * MiB;
constexpr size_t WS_CNT = 2 * MiB;
constexpr size_t WS_EOFF = WS_CNT + 64 * 1024;
constexpr size_t WS_TOKE = 3 * MiB;
constexpr size_t WS_TOKP = 4 * MiB;
constexpr size_t WS_TOKPOS = 5 * MiB;
constexpr size_t WS_ROWW = 6 * MiB;
constexpr size_t WS_ROWTOK = 7 * MiB;
constexpr size_t WS_WIN = 8 * MiB;
constexpr size_t WS_WOUT = 18 * MiB;
constexpr size_t WS_WUP = 24 * MiB;
constexpr size_t WS_WDN = 152 * MiB;
constexpr size_t WS_H8 = 216 * MiB;
constexpr size_t WS_HA8 = 252 * MiB;
constexpr size_t WS_WIN8 = 288 * MiB;
constexpr size_t WS_HA = 408 * MiB;
constexpr size_t WS_XA = 476 * MiB;
constexpr size_t WS_XB = 612 * MiB;
constexpr size_t WS_S = 748 * MiB;
constexpr size_t WS_U = WS_S;
constexpr size_t WS_QB = WS_S + 170 * MiB;
constexpr size_t WS_KB = WS_S + 204 * MiB;
constexpr size_t WS_VB = WS_S + 221 * MiB;
constexpr size_t WS_MIX = WS_S + 238 * MiB;
constexpr size_t WS_F2 = WS_S + 323 * MiB;
constexpr size_t WS_ACT = WS_S + 360 * MiB;
constexpr size_t WS_YR = WS_S;
constexpr size_t WS_END = WS_S + 648 * MiB;
static_assert(WS_F2 + (size_t)NTOK * 512 * 2 <= WS_ACT && WS_YR + (size_t)MPAD * 1024 * 2 <= WS_ACT && WS_H8 + (size_t)NTOK * 1024 <= WS_HA && WS_WDN + 2ull * 32 * 1024 * 1024 <= WS_H8, "ws map");
constexpr float YR_SCALE = 16.f, YR_INV = 1.f / 16.f;
constexpr float W8_SCALE = 64.f, W8_INV = 1.f / 64.f;

constexpr int LDS_BYTES = 163840;
constexpr int LDS_LTOK = 131072;
constexpr int LDS_TAB = 159744;
constexpr int LDS_TAB_NMT = 700;
constexpr int LDS_CTL = 163584;
constexpr int LDS_FREE = 159744;

typedef float f32x2_t_ __attribute__((ext_vector_type(2)));
typedef __bf16 bf16x2_t_ __attribute__((ext_vector_type(2)));
__device__ __forceinline__ unsigned f2bf(float f) { const __bf16 b = (__bf16)f; return (unsigned)__builtin_bit_cast(unsigned short, b); }
__device__ __forceinline__ unsigned pk2(float lo, float hi) { const f32x2_t_ v = {lo, hi}; const bf16x2_t_ b = __builtin_convertvector(v, bf16x2_t_); return __builtin_bit_cast(unsigned, b); }
__device__ __forceinline__ float bf2f(unsigned h) { return __builtin_bit_cast(float, h << 16); }
__device__ __forceinline__ float bflo(unsigned w) { return __builtin_bit_cast(float, w << 16); }
__device__ __forceinline__ float bfhi(unsigned w) { return __builtin_bit_cast(float, w & 0xffff0000u); }
template <int M> __device__ __forceinline__ float xor_swz(float v) { return __builtin_bit_cast(float, __builtin_amdgcn_ds_swizzle(__builtin_bit_cast(int, v), (M << 10) | 0x1f)); }
__device__ __forceinline__ float xor32(float v, bool upper) { auto r = __builtin_amdgcn_permlane32_swap(__float_as_uint(v), __float_as_uint(v), false, false); return __uint_as_float(upper ? r[0] : r[1]); }
__device__ __forceinline__ float wave_sum(float v) {
    v += xor_swz<1>(v); v += xor_swz<2>(v); v += xor_swz<4>(v); v += xor_swz<8>(v); v += xor_swz<16>(v);
    auto r = __builtin_amdgcn_permlane32_swap(__float_as_uint(v), __float_as_uint(v), false, false);
    return __uint_as_float(r[0]) + __uint_as_float(r[1]);
}
__device__ __forceinline__ float sigmoidf_(float x) { return __builtin_amdgcn_rcpf(1.f + __builtin_amdgcn_exp2f(x * -1.4426950408889634f)); }
__device__ __forceinline__ void sincos_rev(float rev, float& sn, float& cs) { const float fr = __builtin_amdgcn_fractf(rev); sn = __builtin_amdgcn_sinf(fr); cs = __builtin_amdgcn_cosf(fr); }
__device__ __forceinline__ int tok_bidx(int t) { return t < NLAT ? (t >> 12) : 8; }
#define LDS_WAIT() asm volatile("s_waitcnt lgkmcnt(0)" ::: "memory")

__device__ __forceinline__ int ptid_w(int wv) { unsigned m = ~0u; asm volatile("" : "+s"(m)); int l = (int)__builtin_amdgcn_mbcnt_hi(m, __builtin_amdgcn_mbcnt_lo(m, 0u)); asm volatile("" : "+v"(l)); return (wv << 6) | l; }

namespace pg8 {
#define PG8_LAS __attribute__((address_space(3)))
constexpr int BM = 256, BK = 64, HALF = 128, HTB = HALF * BK * 2, STAGE_BYTES = 8 * HTB;
__host__ __device__ __forceinline__ int lds_byte(int r, int c) { const int st = (r >> 4) * 2 + (c >> 5), rr = r & 15, cc = c & 31, ob = rr * 64 + cc * 2; return st * 1024 + (ob ^ (((ob >> 9) & 1) << 5)); }
__host__ __device__ __forceinline__ void stage_rc(int b, int& R, int& C) { const int st = b / 1024, sb = b % 1024, swz = sb ^ (((sb >> 9) & 1) << 5); R = (st >> 1) * 16 + swz / 64; C = (st & 1) * 32 + (swz % 64) / 2; }
__host__ __device__ __forceinline__ int perm32(int rho) { const int n = rho >> 4, i = rho & 15; return 8 * (i >> 2) + 4 * n + (i & 3); }
__host__ __device__ __forceinline__ int perm64(int R) { return (R >> 5) * 64 + ((R >> 2) & 3) * 16 + ((R >> 4) & 1) * 4 + (R & 3); }
struct Unit { int pm, pn; };
struct Gemm { const void* A; const void* Bt; int Kb; };
__device__ __forceinline__ unsigned cvt_pk_bf16(float lo, float hi) { unsigned r; asm volatile("v_cvt_pk_bf16_f32 %0, %1, %2" : "=v"(r) : "v"(lo), "v"(hi)); return r; }
typedef int v8i __attribute__((ext_vector_type(8)));
typedef int v4i __attribute__((ext_vector_type(4)));
__device__ __forceinline__ v8i cat8(bf16x8 a, bf16x8 b) { const v4i x = __builtin_bit_cast(v4i, a), y = __builtin_bit_cast(v4i, b); return (v8i){x[0], x[1], x[2], x[3], y[0], y[1], y[2], y[3]}; }
__device__ __forceinline__ unsigned cvt4_fp8(float a, float b, float c, float d) { int r = 0; r = __builtin_amdgcn_cvt_pk_fp8_f32(a, b, r, false); r = __builtin_amdgcn_cvt_pk_fp8_f32(c, d, r, true); return (unsigned)r; }

template <int nN>
__device__ __forceinline__ void tile_order(int L, int nM, int& pm, int& pn) {
    const int nwg = nM * nN; int wgid = L;
    { const int q = nwg >> 3, r = nwg & 7, xcd = wgid & 7, off = wgid >> 3; wgid = (xcd < r ? xcd * (q + 1) : r * (q + 1) + (xcd - r) * q) + off; }
    constexpr int nig = 8 * nN; const int gid = wgid / nig, fm = gid * 8, gsz = (nM - fm) < 8 ? (nM - fm) : 8, rem = wgid - gid * nig;
    if (gsz == 8) { pm = fm + (rem & 7); pn = rem >> 3; } else { pn = rem / gsz; pm = fm + (rem - pn * gsz); }
}

template <bool FP8, class Epi, class Sched>
__device__ __forceinline__ void gemm_phase(PG8_LAS unsigned char* lds, const Gemm g, const Sched& S, const Epi& E, const int tid) {
    const int wid = __builtin_amdgcn_readfirstlane(tid >> 6), lane = tid & 63, wr = wid >> 2, wc = wid & 3, fr = lane & 15, fq = lane >> 4;
    const int Kb = g.Kb, nt = Kb / (BK * 2);
    constexpr bool GATHER = Sched::GATHER;
    unsigned voffA[2], voffB[2]; int rcA[2];
#pragma unroll
    for (int i = 0; i < 2; ++i) { int R, C; stage_rc(tid * 16 + i * 8192, R, C); const int Rb = Epi::PERM == 2 ? perm64(R) : Epi::PERM ? ((R & ~31) + perm32(R & 31)) : R;
        voffA[i] = (unsigned)(R * Kb + C * 2); voffB[i] = (unsigned)(Rb * Kb + C * 2); rcA[i] = (R << 8) | (C * 2); }
    unsigned gc[2][2];
#define PG8_GOFF(uidx) do { if constexpr (GATHER) { _Pragma("unroll") for (int h_ = 0; h_ < 2; ++h_) _Pragma("unroll") for (int i_ = 0; i_ < 2; ++i_) \
        gc[h_][i_] = (unsigned)S.ltok[(uidx) * 256 + h_ * 128 + (rcA[i_] >> 8)] * (unsigned)Kb + (unsigned)(rcA[i_] & 255); } } while (0)
#define PG8_STAGE_A(bufoff, kptr, half) do { if constexpr (GATHER) PG8_STAGE(bufoff, kptr, gc[half]); else PG8_STAGE(bufoff, (kptr) + (half) * hstep, voffA); } while (0)
    const size_t kstep = (size_t)(BK * 2);
    const size_t hstep = (size_t)HALF * Kb;
    const size_t tstep = 2 * hstep;
    const size_t hstepB = Epi::PERM == 2 ? (size_t)8 * Kb : hstep;
    const unsigned ldsw = (unsigned)wid * 1024u;
    const int aoff = lds_byte(wr * 64 + fr, fq * 8), boff = lds_byte(wc * 32 + fr, fq * 8);
#define PG8_SA(b, h) (((b) * 2 + (h)) * HTB)
#define PG8_SB(b, h) ((4 + (b) * 2 + (h)) * HTB)
#define PG8_STAGE(bufoff, gbase, voff) do { _Pragma("unroll") for (int _i = 0; _i < 2; ++_i) { unsigned _vo = (voff)[_i]; asm volatile("" : "+v"(_vo));   \
        __builtin_amdgcn_global_load_lds((const unsigned*)((const char*)(gbase) + _vo), (PG8_LAS unsigned*)(lds + (bufoff) + ldsw + _i * 8192), 16, 0, 0); } } while (0)
#define PG8_LDA(dst, b, h) do { _Pragma("unroll") for (int m = 0; m < 4; ++m) _Pragma("unroll") for (int k = 0; k < 2; ++k) dst[m][k] = *(const PG8_LAS bf16x8*)(lds + PG8_SA(b, h) + aoff + m * 2048 + k * 1024); } while (0)
#define PG8_LDB(dst, b, h) do { _Pragma("unroll") for (int n = 0; n < 2; ++n) _Pragma("unroll") for (int k = 0; k < 2; ++k) dst[n][k] = *(const PG8_LAS bf16x8*)(lds + PG8_SB(b, h) + boff + n * 2048 + k * 1024); } while (0)
#define PG8_MMA(ai, bj, At, Bt) do { __builtin_amdgcn_s_setprio(1); _Pragma("unroll") for (int m = 0; m < 4; ++m) _Pragma("unroll") for (int n = 0; n < 2; ++n) { \
        if constexpr (FP8) acc[ai][bj][m][n] = __builtin_amdgcn_mfma_scale_f32_16x16x128_f8f6f4(cat8(Bt[n][0], Bt[n][1]), cat8(At[m][0], At[m][1]), acc[ai][bj][m][n], 0, 0, 0, 0, 0, 0); \
        else { _Pragma("unroll") for (int k = 0; k < 2; ++k) acc[ai][bj][m][n] = __builtin_amdgcn_mfma_f32_16x16x32_bf16(Bt[n][k], At[m][k], acc[ai][bj][m][n], 0, 0, 0); } } \
        __builtin_amdgcn_s_setprio(0); } while (0)
#define PG8_WAIT_V(n) asm volatile("s_waitcnt vmcnt(" #n ")" ::: "memory")
#define PG8_WAIT_L(n) asm volatile("s_waitcnt lgkmcnt(" #n ")" ::: "memory")
#define PG8_BAR __builtin_amdgcn_s_barrier()
#define PG8_SCHED __builtin_amdgcn_sched_barrier(0)
    Unit cur, nxt; int ui = 0;
    if (!S.next(0, cur)) return;
    f32x4 acc[2][2][4][2];
#pragma unroll
    for (int a = 0; a < 2; ++a)
#pragma unroll
        for (int b = 0; b < 2; ++b)
#pragma unroll
            for (int m = 0; m < 4; ++m)
#pragma unroll
                for (int n = 0; n < 2; ++n) acc[a][b][m][n] = (f32x4){0.f, 0.f, 0.f, 0.f};
    bf16x8 At[4][2], B0[2][2], B1[2][2];
    const char* cA = (const char*)g.A + (GATHER ? (size_t)0 : (size_t)cur.pm * tstep); const char* cB = (const char*)g.Bt + (size_t)cur.pn * tstep;
    PG8_GOFF(0);
    PG8_STAGE(PG8_SB(0, 0), cB, voffB); PG8_STAGE(PG8_SB(0, 1), cB + hstepB, voffB); PG8_STAGE_A(PG8_SA(0, 0), cA, 0); PG8_STAGE_A(PG8_SA(0, 1), cA, 1);
    if (wr == 1) PG8_BAR;
    PG8_WAIT_V(2); PG8_BAR;
    PG8_STAGE(PG8_SB(1, 0), cB + kstep, voffB); PG8_STAGE_A(PG8_SA(1, 0), cA + kstep, 0); PG8_STAGE(PG8_SB(1, 1), cB + hstepB + kstep, voffB);
    PG8_WAIT_V(6); PG8_BAR;
    for (;;) {
        const bool has_next = S.next(ui + 1, nxt);
        const char* nA = (has_next && !GATHER) ? (const char*)g.A + (size_t)nxt.pm * tstep : cA; const char* nB = has_next ? (const char*)g.Bt + (size_t)nxt.pn * tstep : cB;
        for (int t = 0; t < nt; t += 2) {
            const bool last = (t == nt - 2);
            const char* a1 = cA + (size_t)(t + 1) * kstep;
            const char* a2 = last ? nA : cA + (size_t)(t + 2) * kstep; const char* b2 = last ? nB : cB + (size_t)(t + 2) * kstep;
            const char* a3 = a2 + kstep; const char* b3 = b2 + kstep;
            PG8_LDB(B0, 0, 0); PG8_LDB(B1, 0, 1); PG8_SCHED; PG8_LDA(At, 0, 0); PG8_STAGE_A(PG8_SA(1, 1), a1, 1); if (last && has_next) PG8_GOFF(ui + 1);
            PG8_WAIT_V(8); PG8_WAIT_L(0); PG8_BAR; PG8_MMA(0, 0, At, B0); PG8_MMA(0, 1, At, B1); PG8_BAR; PG8_SCHED;
            PG8_LDA(At, 0, 1); PG8_STAGE(PG8_SB(0, 0), b2, voffB); PG8_STAGE(PG8_SB(0, 1), b2 + hstepB, voffB); PG8_STAGE_A(PG8_SA(0, 0), a2, 0);
            PG8_WAIT_V(8); PG8_WAIT_L(0); PG8_BAR; PG8_MMA(1, 0, At, B0); PG8_MMA(1, 1, At, B1); PG8_BAR; PG8_SCHED;
            PG8_LDB(B0, 1, 0); PG8_LDB(B1, 1, 1); PG8_SCHED; PG8_LDA(At, 1, 0); PG8_STAGE_A(PG8_SA(0, 1), a2, 1);
            PG8_WAIT_V(8); PG8_WAIT_L(0); PG8_BAR; PG8_MMA(0, 0, At, B0); PG8_MMA(0, 1, At, B1); PG8_BAR; PG8_SCHED;
            PG8_LDA(At, 1, 1); PG8_STAGE(PG8_SB(1, 0), b3, voffB); PG8_STAGE(PG8_SB(1, 1), b3 + hstepB, voffB); PG8_STAGE_A(PG8_SA(1, 0), a3, 0);
            PG8_WAIT_V(8); PG8_WAIT_L(0); PG8_BAR; PG8_MMA(1, 0, At, B0); PG8_MMA(1, 1, At, B1); PG8_BAR; PG8_SCHED;
        }
        if (wr == 0) PG8_BAR;
        { const int l2 = ptid_w(wid) & 63; E(acc, cur, wr, wc, l2 & 15, l2 >> 4); }
        if (!has_next) break;
#pragma unroll
        for (int a = 0; a < 2; ++a)
#pragma unroll
            for (int b = 0; b < 2; ++b)
#pragma unroll
                for (int m = 0; m < 4; ++m)
#pragma unroll
                    for (int n = 0; n < 2; ++n) acc[a][b][m][n] = (f32x4){0.f, 0.f, 0.f, 0.f};
        cur = nxt; cA = nA; cB = nB; ++ui;
        if (wr == 1) PG8_BAR;
    }
    PG8_WAIT_V(0);
    PG8_BAR;
#undef PG8_SA
#undef PG8_SB
#undef PG8_STAGE
#undef PG8_STAGE_A
#undef PG8_GOFF
#undef PG8_LDA
#undef PG8_LDB
#undef PG8_MMA
#undef PG8_WAIT_V
#undef PG8_WAIT_L
#undef PG8_BAR
#undef PG8_SCHED
}

struct EpiStoreBf16 {
    static constexpr int PERM = 2;
    bf16_t* O; int ldc; float sc;
    __device__ __forceinline__ void operator()(const f32x4 (&acc)[2][2][4][2], const Unit& u, int wr, int wc, int fr, int fq) const {
        const int row0 = u.pm * BM + wr * 64 + fr, col0 = u.pn * BM + wc * 64 + 16 * fq;
#pragma unroll
        for (int ai = 0; ai < 2; ++ai)
#pragma unroll
            for (int m = 0; m < 4; ++m) { bf16_t* rowp = O + (size_t)(row0 + ai * HALF + m * 16) * ldc + col0;
#pragma unroll
                for (int bj = 0; bj < 2; ++bj) { const f32x4 v0 = acc[ai][bj][m][0] * sc, v1 = acc[ai][bj][m][1] * sc;
                    u32x4 w; w.x = cvt_pk_bf16(v0[0], v0[1]); w.y = cvt_pk_bf16(v0[2], v0[3]); w.z = cvt_pk_bf16(v1[0], v1[1]); w.w = cvt_pk_bf16(v1[2], v1[3]);
                    *(u32x4*)(rowp + bj * 8) = w; } }
    }
};
template <bool XBF16>
struct EpiResidual {
    static constexpr int PERM = 2;
    const void* xlat; const void* xctx; bf16_t* out; const float* gate;
    __device__ __forceinline__ void operator()(const f32x4 (&acc)[2][2][4][2], const Unit& u, int wr, int wc, int fr, int fq) const {
        const int row0 = u.pm * BM + wr * 64 + fr, col0 = u.pn * BM + wc * 64 + 16 * fq;
        const int bidx = (u.pm < NLAT / 256) ? (u.pm >> 4) : 8;
        const float* gp = gate + (size_t)bidx * NMOD + col0;
        f32x4 gv[2][2];
#pragma unroll
        for (int bj = 0; bj < 2; ++bj)
#pragma unroll
            for (int n = 0; n < 2; ++n) gv[bj][n] = *(const f32x4*)(gp + bj * 8 + 4 * n);
#pragma unroll
        for (int ai = 0; ai < 2; ++ai)
#pragma unroll
            for (int m = 0; m < 4; ++m) { const int row = row0 + ai * HALF + m * 16;
                bf16_t* orow = out + (size_t)row * DM + col0;
#pragma unroll
                for (int bj = 0; bj < 2; ++bj) { f32x4 x0, x1;
                    if constexpr (XBF16) { const bf16_t* xr = (row < NLAT ? (const bf16_t*)xlat + (size_t)row * DM : (const bf16_t*)xctx + (size_t)(row - NLAT) * DM) + col0 + bj * 8;
                        const u32x4 xb = *(const u32x4*)xr; x0 = (f32x4){bflo(xb.x), bfhi(xb.x), bflo(xb.y), bfhi(xb.y)}; x1 = (f32x4){bflo(xb.z), bfhi(xb.z), bflo(xb.w), bfhi(xb.w)}; }
                    else { const float* xr = (row < NLAT ? (const float*)xlat + (size_t)row * DM : (const float*)xctx + (size_t)(row - NLAT) * DM) + col0 + bj * 8;
                        x0 = *(const f32x4*)xr; x1 = *(const f32x4*)(xr + 4); }
                    const f32x4 v0 = x0 + gv[bj][0] * acc[ai][bj][m][0], v1 = x1 + gv[bj][1] * acc[ai][bj][m][1];
                    u32x4 w; w.x = cvt_pk_bf16(v0[0], v0[1]); w.y = cvt_pk_bf16(v0[2], v0[3]); w.z = cvt_pk_bf16(v1[0], v1[1]); w.w = cvt_pk_bf16(v1[2], v1[3]);
                    *(u32x4*)(orow + bj * 8) = w; } }
    }
};
struct EpiSwiGLU {
    static constexpr int PERM = 1;
    unsigned char* O; const float* bup;
    __device__ __forceinline__ void operator()(const f32x4 (&acc)[2][2][4][2], const Unit& u, int wr, int wc, int fr, int fq) const {
        const int e = u.pn >> 3, pnl = u.pn & 7;
        const int row0 = u.pm * BM + wr * 64 + fr, ac0 = pnl * 128 + wc * 32 + 8 * fq;
        const float* bp = bup + (size_t)e * 2048 + 2 * ac0;
        f32x4 bb[4];
#pragma unroll
        for (int q = 0; q < 4; ++q) bb[q] = *(const f32x4*)(bp + 4 * q);
        f32x2 bg[4], bl[4];
#pragma unroll
        for (int p = 0; p < 4; ++p) { bg[p] = (f32x2){bb[p][0], bb[p][2]}; bl[p] = (f32x2){bb[p][1] + 1.f, bb[p][3] + 1.f}; }
        unsigned char* cbase = O + (size_t)(row0 + (fq & 1) * 16) * DFF + (ac0 - 8 * (fq & 1));
#pragma unroll
        for (int ai = 0; ai < 2; ++ai)
#pragma unroll
            for (int mp = 0; mp < 2; ++mp) { u32x2 wq[2];
#pragma unroll
                for (int mi = 0; mi < 2; ++mi) { const int m = 2 * mp + mi;
                    float r[8];
#pragma unroll
                    for (int p = 0; p < 4; ++p) { const int n = p >> 1, i0 = (p & 1) * 2;
                        f32x2 gt = (f32x2){acc[ai][0][m][n][i0], acc[ai][0][m][n][i0 + 1]} * W8_INV + bg[p];
                        f32x2 ln = (f32x2){acc[ai][1][m][n][i0], acc[ai][1][m][n][i0 + 1]} * W8_INV + bl[p];
                        gt.x = fminf(gt.x, 7.f); gt.y = fminf(gt.y, 7.f);
                        ln.x = __builtin_amdgcn_fmed3f(ln.x, -6.f, 8.f); ln.y = __builtin_amdgcn_fmed3f(ln.y, -6.f, 8.f);
                        const f32x2 ex = gt * (-1.702f * 1.4426950408889634f);
                        f32x2 dn = (f32x2){__builtin_amdgcn_exp2f(ex.x), __builtin_amdgcn_exp2f(ex.y)} + 1.f;
                        dn.x = __builtin_amdgcn_rcpf(dn.x); dn.y = __builtin_amdgcn_rcpf(dn.y);
                        const f32x2 rr = (gt * dn) * ln;
                        r[2 * p] = rr.x; r[2 * p + 1] = rr.y; }
                    wq[mi].x = cvt4_fp8(r[0], r[1], r[2], r[3]); wq[mi].y = cvt4_fp8(r[4], r[5], r[6], r[7]); }
                const auto s0 = __builtin_amdgcn_permlane16_swap(wq[0].x, wq[1].x, false, false), s1 = __builtin_amdgcn_permlane16_swap(wq[0].y, wq[1].y, false, false);
                u32x4 w; w.x = s0[0]; w.y = s1[0]; w.z = s0[1]; w.w = s1[1];
                *(u32x4*)(cbase + (size_t)(ai * HALF + mp * 32) * DFF) = w; }
    }
};
struct EpiDown {
    static constexpr int PERM = 2;
    unsigned char* O; const float* bdn; const float* roww;
    __device__ __forceinline__ void operator()(const f32x4 (&acc)[2][2][4][2], const Unit& u, int wr, int wc, int fr, int fq) const {
        const int e = u.pn >> 2, pnl = u.pn & 3;
        const int row0 = u.pm * BM + wr * 64 + fr, col0 = pnl * BM + wc * 64 + 16 * fq;
        const float* bp = bdn + (size_t)e * DM + col0;
        f32x4 bv[2][2];
#pragma unroll
        for (int bj = 0; bj < 2; ++bj)
#pragma unroll
            for (int n = 0; n < 2; ++n) bv[bj][n] = *(const f32x4*)(bp + 8 * bj + 4 * n);
        float rwv[2][4];
#pragma unroll
        for (int ai = 0; ai < 2; ++ai)
#pragma unroll
            for (int m = 0; m < 4; ++m) rwv[ai][m] = roww[row0 + ai * HALF + m * 16] * YR_SCALE;
#pragma unroll
        for (int ai = 0; ai < 2; ++ai)
#pragma unroll
            for (int m = 0; m < 4; ++m) { const int row = row0 + ai * HALF + m * 16; const float w_ = rwv[ai][m];
                const f32x4 v0 = (acc[ai][0][m][0] * W8_INV + bv[0][0]) * w_, v1 = (acc[ai][0][m][1] * W8_INV + bv[0][1]) * w_;
                const f32x4 v2 = (acc[ai][1][m][0] * W8_INV + bv[1][0]) * w_, v3 = (acc[ai][1][m][1] * W8_INV + bv[1][1]) * w_;
                u32x4 w; w.x = cvt4_fp8(v0[0], v0[1], v0[2], v0[3]); w.y = cvt4_fp8(v1[0], v1[1], v1[2], v1[3]); w.z = cvt4_fp8(v2[0], v2[1], v2[2], v2[3]); w.w = cvt4_fp8(v3[0], v3[1], v3[2], v3[3]);
                *(u32x4*)(O + (size_t)row * DM + col0) = w; }
    }
};

template <int NS>
struct SchedSub {
    static constexpr bool GATHER = false; const LAS int* ltok = nullptr;
    int G, c, first, cfirst, nctx; bool rev;
    __device__ __forceinline__ bool next(int i, Unit& u) const {
        const int L = i * G + (rev ? G - 1 - c : c);
        if (L < 128 * NS) { int j; tile_order<NS>(L, 128, u.pm, j); u.pn = first + j; return true; }
        const int r = L - 128 * NS; if (r >= 8 * nctx) return false;
        const int q = (nctx == 2) ? (r >> 1) : (nctx == 4) ? (r >> 2) : (r / 6);
        u.pm = 128 + q; u.pn = cfirst + (r - q * nctx); return true;
    }
};
template <int nN>
struct SchedGrid {
    static constexpr bool GATHER = false; const LAS int* ltok = nullptr;
    int G, c, nM;
    __device__ __forceinline__ bool next(int i, Unit& u) const {
        const int L = i * G + c; if (L >= nM * nN) return false;
        tile_order<nN>(L, nM, u.pm, u.pn); return true;
    }
};
template <int nN, bool GATHER_>
struct SchedMoe {
    static constexpr bool GATHER = GATHER_;
    int G, c, nMt; const LAS int* tile_e; const LAS int* ltok;
    __device__ __forceinline__ bool next(int i, Unit& u) const {
        const int L = i * G + c; if (L >= nMt * nN) return false;
        int pm, pn; tile_order<nN>(L, nMt, pm, pn);
        const int e = __builtin_amdgcn_readfirstlane(tile_e[pm]);
        u.pm = pm; u.pn = e * nN + pn; return true;
    }
};
}

namespace att { __device__ __forceinline__ unsigned cvtpk(float lo, float hi) { unsigned r; asm volatile("v_cvt_pk_bf16_f32 %0, %1, %2" : "=v"(r) : "v"(lo), "v"(hi)); return r; } }
namespace att8 {
typedef int v8i __attribute__((ext_vector_type(8)));
typedef int v4i __attribute__((ext_vector_type(4)));
constexpr int NW = 8, QBLK = 32, KVBLK = 64;
constexpr float SCALE = 0.088388347648318440f;
constexpr float QSC = SCALE * 1.4426950408889634f;
constexpr float THR = 3.f;
constexpr float THR2 = THR * 1.4426950408889634f;
constexpr int NSLOT = 4, SLOT = 8192;
constexpr int OFF_K = 0, OFF_V = NSLOT * SLOT, OFF_WS = 2 * NSLOT * SLOT, OFF_OST = OFF_WS + 2048;
static_assert(OFF_OST + 8 * 8704 <= 163840 - 256, "att8 LDS");
__device__ __forceinline__ int crow(int r, int hi) { return (r & 3) + 8 * (r >> 2) + 4 * hi; }
__host__ __device__ __forceinline__ int kpos(int k) { const int kk = k & 31, up = k >> 5, hi = (kk >> 2) & 1, r = (kk & 3) + 4 * (kk >> 3); return 32 * hi + 16 * up + r; }
__device__ __forceinline__ v8i ld32(const char* p) { const v4i a = *(const v4i*)p, b = *(const v4i*)(p + 16); return (v8i){a[0], a[1], a[2], a[3], b[0], b[1], b[2], b[3]}; }
__device__ __forceinline__ f32x16 mma8(v8i a, v8i b, f32x16 c) { return __builtin_amdgcn_mfma_scale_f32_32x32x64_f8f6f4(a, b, c, 0, 0, 0, 0, 0, 0); }

template <bool FIRST>
__device__ __forceinline__ void partialSM(f32x16& p0, f32x16& p1, f32x16& negm, float& alpha) {
  float pmax = p0[0]; for (int r = 1; r < 16; ++r) pmax = fmaxf(pmax, p0[r]); for (int r = 0; r < 16; ++r) pmax = fmaxf(pmax, p1[r]);
  { auto rr = __builtin_amdgcn_permlane32_swap(__float_as_uint(pmax), __float_as_uint(pmax), false, false);
    pmax = fmaxf(__uint_as_float(rr[0]), __uint_as_float(rr[1])); }
  const float d = pmax - 4.f;
  if (!FIRST && __builtin_expect(__all(d <= THR2), 1)) alpha = 1.f;
  else { const float dl = FIRST ? d : fmaxf(d, 0.f); alpha = __builtin_amdgcn_exp2f(-dl);
    for (int r = 0; r < 16; ++r) { p0[r] -= dl; p1[r] -= dl; negm[r] -= dl; } }
  for (int r = 0; r < 16; ++r) p0[r] = __builtin_amdgcn_exp2f(p0[r]);
}
__device__ __forceinline__ void finishA(f32x16& p1) { for (int r = 0; r < 16; ++r) p1[r] = __builtin_amdgcn_exp2f(p1[r]); }
__device__ __forceinline__ void finishB(f32x16& p0, f32x16& p1, v8i& pa, float& lsum) {
  { float t0 = p0[0] + p1[0], t1 = p0[1] + p1[1], t2 = p0[2] + p1[2], t3 = p0[3] + p1[3];
#pragma unroll
    for (int r = 4; r < 16; r += 4) { t0 += p0[r] + p1[r]; t1 += p0[r + 1] + p1[r + 1]; t2 += p0[r + 2] + p1[r + 2]; t3 += p0[r + 3] + p1[r + 3]; }
    lsum += (t0 + t1) + (t2 + t3); }
#pragma unroll
  for (int w = 0; w < 4; ++w) { int a = pa[w], b = pa[4 + w];
    a = __builtin_amdgcn_cvt_pk_fp8_f32(p0[4 * w], p0[4 * w + 1], a, false); a = __builtin_amdgcn_cvt_pk_fp8_f32(p0[4 * w + 2], p0[4 * w + 3], a, true);
    b = __builtin_amdgcn_cvt_pk_fp8_f32(p1[4 * w], p1[4 * w + 1], b, false); b = __builtin_amdgcn_cvt_pk_fp8_f32(p1[4 * w + 2], p1[4 * w + 3], b, true);
    pa[w] = a; pa[4 + w] = b; }
}
struct KFrag { v8i a0, a1, a2, a3; };
__device__ __forceinline__ v8i ld2(const char* p, int o0, int o1) { const v4i a = *(const v4i*)(p + o0), b = *(const v4i*)(p + o1); return (v8i){a[0], a[1], a[2], a[3], b[0], b[1], b[2], b[3]}; }
__device__ __forceinline__ void kf_load(KFrag& f, const char* Ks, const int (&ka)[4]) {
  f.a0 = ld2(Ks, ka[0], ka[1]); f.a1 = ld2(Ks + 4096, ka[0], ka[1]); f.a2 = ld2(Ks, ka[2], ka[3]); f.a3 = ld2(Ks + 4096, ka[2], ka[3]);
}
__device__ __forceinline__ void qkt(f32x16& p0, f32x16& p1, const f32x16& negm, const KFrag& f, const v8i* qr) {
  p0 = mma8(f.a0, qr[0], negm); p1 = mma8(f.a1, qr[0], negm); p0 = mma8(f.a2, qr[1], p0); p1 = mma8(f.a3, qr[1], p1);
}
struct VFrag { v8i b0, b1, b2, b3; };
__device__ __forceinline__ void pv_load(VFrag& f, const char* Vs, const int (&va)[2]) {
  f.b0 = ld2(Vs, va[0], va[1]); f.b1 = ld2(Vs + 2048, va[0], va[1]); f.b2 = ld2(Vs + 4096, va[0], va[1]); f.b3 = ld2(Vs + 6144, va[0], va[1]);
}
__device__ __forceinline__ void pv(f32x16* o, const VFrag& f, v8i pa) {
  o[0] = mma8(pa, f.b0, o[0]); o[1] = mma8(pa, f.b1, o[1]); o[2] = mma8(pa, f.b2, o[2]); o[3] = mma8(pa, f.b3, o[3]);
}
template <int LDQ, int LDO>
__device__ __forceinline__ void attn_body(const unsigned char* __restrict__ Qb, const unsigned char* __restrict__ Kh, const unsigned char* __restrict__ VTh, bf16_t* __restrict__ Ob, int seq, char* lds, const int tid) {
  const int wid = tid >> 6, lane = tid & 63, r32 = lane & 31, hi = lane >> 5;
  char* V_lds = lds + OFF_V; char* K_lds = lds + OFF_K;
  float* ws = (float*)(lds + OFF_WS) + wid * 64; float* al_l = ws + 32;
  f32x16 o[4] = {}; float lsum = 0.f; v8i qr[2]; f32x16 negm;
#pragma unroll
  for (int r = 0; r < 16; ++r) negm[r] = 0.f;
  { const char* Qw = (const char*)Qb + (long)(wid * QBLK + r32) * LDQ + 32 * hi;
#pragma unroll
    for (int st = 0; st < 2; ++st) qr[st] = ld32(Qw + 64 * st); }
  unsigned kgoff, vgoff;
  { const int kr = wid * 8 + (lane >> 3), vr = wid * 16 + (lane >> 2);
    kgoff = (unsigned)(kr * 128 + (((lane & 7) ^ ((kr >> 1) & 7)) << 4)); vgoff = (unsigned)(vr * 64 + (((lane & 3) ^ ((vr >> 2) & 3)) << 4)); }
  int ka[4], va[2];
  { const int xk = (r32 >> 1) & 7, xv = (r32 >> 2) & 3;
#pragma unroll
    for (int c = 0; c < 4; ++c) ka[c] = r32 * 128 + (((4 * (c >> 1) + 2 * hi + (c & 1)) ^ xk) << 4);
#pragma unroll
    for (int c = 0; c < 2; ++c) va[c] = r32 * 64 + (((2 * hi + c) ^ xv) << 4); }
  const unsigned ldsw = (unsigned)__builtin_amdgcn_readfirstlane(wid) * 1024u;
#define DMA(t) do { const int t_ = (t); const unsigned so_ = (unsigned)(t_ & (NSLOT - 1)) * SLOT + ldsw; unsigned ko_ = kgoff, vo_ = vgoff; asm volatile("" : "+v"(ko_), "+v"(vo_)); \
    __builtin_amdgcn_global_load_lds((const unsigned*)(Kh + (size_t)t_ * SLOT + ko_), (LAS unsigned*)(lds + OFF_K + so_), 16, 0, 0); \
    __builtin_amdgcn_global_load_lds((const unsigned*)(VTh + (size_t)t_ * SLOT + vo_), (LAS unsigned*)(lds + OFF_V + so_), 16, 0, 0); } while (0)
#define WAITV2() asm volatile("s_waitcnt vmcnt(2)" ::: "memory")
#define BARX() __builtin_amdgcn_s_barrier()
#define RESC(a) do { if (__any((a) < 1.f)) { if (hi == 0) al_l[r32] = (a); asm volatile("s_waitcnt lgkmcnt(0)" ::: "memory"); \
    lsum *= (a); for (int r = 0; r < 16; ++r) { const float f_ = al_l[crow(r, hi)]; for (int d = 0; d < 4; ++d) o[d][r] *= f_; } } } while (0)
#define SBAR8() __builtin_amdgcn_sched_barrier(0)
  f32x16 pA0, pA1, pB0, pB1; float alA, alB; v8i pa = {}; const int NT = seq / KVBLK;
  DMA(0); DMA(1); WAITV2(); BARX();
  KFrag kf; kf_load(kf, K_lds, ka); qkt(pA0, pA1, negm, kf, qr); partialSM<true>(pA0, pA1, negm, alA);
  DMA(2 < NT ? 2 : NT - 1); WAITV2(); BARX();
  VFrag vf;
#define STEP(pN0, pN1, pO0, pO1, jj, alN) do { const int j_ = (jj); \
    SBAR8(); kf_load(kf, K_lds + (j_ & (NSLOT - 1)) * SLOT, ka); SBAR8(); \
    finishA(pO1); SBAR8(); \
    qkt(pN0, pN1, negm, kf, qr); SBAR8(); \
    pv_load(vf, V_lds + ((j_ - 1) & (NSLOT - 1)) * SLOT, va); SBAR8(); \
    finishB(pO0, pO1, pa, lsum); SBAR8(); \
    DMA(j_ + 2 < NT ? j_ + 2 : NT - 1); SBAR8();     \
    pv(o, vf, pa); partialSM<false>(pN0, pN1, negm, alN); \
    RESC(alN); WAITV2(); BARX(); } while (0)
  for (int j = 1; j + 1 < NT; j += 2) {
    STEP(pB0, pB1, pA0, pA1, j, alB);
    STEP(pA0, pA1, pB0, pB1, j + 1, alA);
  }
  STEP(pB0, pB1, pA0, pA1, NT - 1, alB);
  pv_load(vf, V_lds + ((NT - 1) & (NSLOT - 1)) * SLOT, va);
  finishA(pB1); finishB(pB0, pB1, pa, lsum); SBAR8();
  pv(o, vf, pa);
#undef STEP
  float rli[16];
  { auto rr = __builtin_amdgcn_permlane32_swap(__float_as_uint(lsum), __float_as_uint(lsum), false, false);
    const float rl = __builtin_amdgcn_rcpf(__uint_as_float(rr[0]) + __uint_as_float(rr[1]));
    if (hi == 0) al_l[r32] = rl; asm volatile("s_waitcnt lgkmcnt(0)" ::: "memory");
#pragma unroll
    for (int r = 0; r < 16; ++r) rli[r] = al_l[crow(r, hi)]; }
  { char* ost = lds + OFF_OST + wid * (32 * 272);
#pragma unroll
    for (int r = 0; r < 16; ++r) { const int orow = crow(r, hi);
#pragma unroll
      for (int d0 = 0; d0 < 4; ++d0) *(bf16_t*)(ost + orow * 272 + (d0 * 32 + r32) * 2) = (bf16_t)att::cvtpk(o[d0][r] * rli[r], 0.f); }
    asm volatile("s_waitcnt lgkmcnt(0)" ::: "memory");
    bf16_t* Ow = Ob + (long)(wid * QBLK) * LDO;
#pragma unroll
    for (int i = 0; i < 8; ++i) { const int idx = lane + 64 * i, row = idx >> 4, ch = idx & 15;
      *(u32x4*)(Ow + (long)row * LDO + ch * 8) = *(const u32x4*)(ost + row * 272 + ch * 16); } }
  asm volatile("s_waitcnt vmcnt(0)" ::: "memory");
  __syncthreads();
#undef DMA
#undef WAITV2
#undef BARX
#undef RESC
#undef SBAR8
}
}

#define XB_TMO      128
#define XB_XCNT(j)  (256  + 64 * (j))
#define XB_XSUB(j)  (1280 + 64 * (j))
#define XB_XGEN(j)  (2304 + 64 * (j))
#define XB_TOP      3328
#define XB_TOPGEN   3392
#define XCD_BAR_WORDS 3456
#define XB_SPIN_CAP (1u << 18)
__device__ __forceinline__ unsigned xb_ld(unsigned* p)              { return __hip_atomic_load(p, __ATOMIC_RELAXED, __HIP_MEMORY_SCOPE_AGENT); }
__device__ __forceinline__ unsigned xb_add(unsigned* p, unsigned v) { return __hip_atomic_fetch_add(p, v, __ATOMIC_RELAXED, __HIP_MEMORY_SCOPE_AGENT); }
__device__ __forceinline__ unsigned xb_xcc_id() { return (unsigned)__builtin_amdgcn_s_getreg((3 << 11) | 20) & 0xFu; }
#define XB_SPIN(cond, bar) do { unsigned _sp = 0; while (cond) { __builtin_amdgcn_s_sleep(1); \
    if ((++_sp & 255u) == 0u) { if (xb_ld(&(bar)[XB_TMO])) break; if (_sp > XB_SPIN_CAP) { atomicAdd(&(bar)[XB_TMO], 1u); break; } } } } while (0)
struct XcdBarrier { unsigned* bar; unsigned x; volatile LAS unsigned* st; };
__device__ __forceinline__ XcdBarrier xcd_barrier_post(unsigned* bar, volatile LAS unsigned* st) {
    XcdBarrier b; b.bar = bar; b.x = xb_xcc_id(); b.st = st;
    if (threadIdx.x == 0) (void)xb_add(&bar[XB_XCNT(b.x)], 1u);
    return b;
}
__device__ __forceinline__ void xcd_barrier_complete(unsigned* bar, unsigned x, unsigned& nloc, unsigned& nx) {
    const unsigned G = gridDim.x * gridDim.y * gridDim.z;
    unsigned sum, cnt, mine, sp = 0u;
    for (;;) {
        sum = 0u; cnt = 0u; mine = 0u;
#pragma unroll
        for (unsigned j = 0; j < 16; ++j) { const unsigned c = xb_ld(&bar[XB_XCNT(j)]); sum += c; cnt += (c > 0u) ? 1u : 0u; mine = (j == x) ? c : mine; }
        if (sum == G) break;
        __builtin_amdgcn_s_sleep(1);
        if ((++sp & 255u) == 0u) { if (xb_ld(&bar[XB_TMO])) break; if (sp > XB_SPIN_CAP) { atomicAdd(&bar[XB_TMO], 1u); break; } }
    }
    nloc = mine > 0u ? mine : 1u; nx = cnt > 0u ? cnt : 1u;
}
template <class Work>
__device__ __forceinline__ void xcd_barrier(const XcdBarrier& b, Work work) {
    asm volatile("s_waitcnt vmcnt(0)" ::: "memory");
    __syncthreads();
    if (threadIdx.x >= 64) work((int)threadIdx.x - 64, (int)blockDim.x - 64);
    if (threadIdx.x == 0) {
        unsigned* bar = b.bar;
        __builtin_amdgcn_s_waitcnt(0);
        unsigned nloc = b.st[0], nx = b.st[1];
        if (nloc == 0u) { xcd_barrier_complete(bar, b.x, nloc, nx); b.st[0] = nloc; b.st[1] = nx; }
        const unsigned old = xb_add(&bar[XB_XSUB(b.x)], 1u);
        const unsigned gen = old / nloc;
        if (old + 1u == (gen + 1u) * nloc) {
            __builtin_amdgcn_fence(__ATOMIC_RELEASE, "agent");
            asm volatile("s_waitcnt vmcnt(0)" ::: "memory");
            const unsigned og = xb_add(&bar[XB_TOP], 1u);
            const unsigned tg = og / nx;
            if (og + 1u == (tg + 1u) * nx) xb_add(&bar[XB_TOPGEN], 1u);
            else XB_SPIN(xb_ld(&bar[XB_TOPGEN]) == tg, bar);
            __builtin_amdgcn_fence(__ATOMIC_ACQUIRE, "agent");
            xb_add(&bar[XB_XGEN(b.x)], 1u);
            asm volatile("s_waitcnt vmcnt(0)" ::: "memory");
        } else {
            XB_SPIN(xb_ld(&bar[XB_XGEN(b.x)]) == gen, bar);
            __builtin_amdgcn_fence(__ATOMIC_ACQUIRE, "agent");
            asm volatile("s_waitcnt vmcnt(0)" ::: "memory");
        }
    }
    __syncthreads();
}

__device__ __forceinline__ unsigned char* opq(unsigned char* p) { asm volatile("" : "+s"(p)); return p; }
struct Args { const float* in[24]; float* out; unsigned char* ws; int ph_lo, ph_hi; };
__device__ __forceinline__ Args load_args() {
#if defined(__HIP_DEVICE_COMPILE__)
    auto kp = __builtin_amdgcn_kernarg_segment_ptr();
    asm volatile("" : "+s"(kp));
    return *(const __attribute__((address_space(4))) Args*)kp;
#else
    return Args{};
#endif
}
enum { I_X = 0, I_C, I_CTX, I_CCTX, I_WMOD, I_BMOD, I_NMIX, I_NFFN, I_WIN, I_QN, I_KN, I_SCW, I_CDW, I_CDB, I_CLG, I_CLB, I_WOUT, I_RW, I_RB, I_WUP, I_BUP, I_WDN, I_BDN, I_FN };

__device__ __forceinline__ void p0_mods_unit(int unit, const float* w_mod, const float* b_mod, float* mods, const LAS float* act, LAS float* red, int tid) {
    const int l = unit / 384, col0 = (unit % 384) * 16, col = tid & 15, kg = tid >> 4;
    float acc[9];
#pragma unroll
    for (int r = 0; r < 9; ++r) acc[r] = 0.f;
    const float* wp = w_mod + ((size_t)l * DM + kg * 32) * NMOD + col0 + col;
#pragma unroll 16
    for (int k = 0; k < 32; ++k) { const float w = wp[(size_t)k * NMOD];
#pragma unroll
        for (int r = 0; r < 9; ++r) acc[r] += act[r * DM + kg * 32 + k] * w; }
#pragma unroll
    for (int r = 0; r < 9; ++r) red[(kg * 9 + r) * 16 + col] = acc[r];
    __syncthreads();
    if (tid < 9 * 16) { const int r = tid >> 4, cc = tid & 15; float sm = 0.f;
#pragma unroll
        for (int g = 0; g < 32; ++g) sm += red[(g * 9 + r) * 16 + cc];
        mods[((size_t)l * 9 + r) * NMOD + col0 + cc] = sm + b_mod[(size_t)l * NMOD + col0 + cc]; }
    __syncthreads();
}
struct MapId { __device__ __forceinline__ int operator()(int n) const { return n; } };
struct MapUp { __device__ __forceinline__ int operator()(int n) const { const int a = n >> 1, j = n & 1; return ((a >> 7) << 8) + (j << 7) + (a & 127); } };
template <class NMap>
__device__ __forceinline__ void p0_transpose_item8(const float* W, int K, int N, unsigned char* WT, LAS float* scr, int kb, int nb, int lane, NMap nmap) {
    const int k0 = 64 * kb, n0 = 64 * nb;
    { const int kq = lane >> 4, n4 = (lane & 15) * 4;
#pragma unroll
        for (int i = 0; i < 16; ++i) { const f32x4 v = __builtin_nontemporal_load((const f32x4*)(W + (size_t)(k0 + 4 * i + kq) * N + n0 + n4));
            LAS float* d = scr + (4 * i + kq) * 65 + n4; d[0] = v.x; d[1] = v.y; d[2] = v.z; d[3] = v.w; } }
    LDS_WAIT(); asm volatile("" ::: "memory");
    const int c = lane & 3, rs = lane >> 2;
#pragma unroll
    for (int j = 0; j < 4; ++j) { const int nl = rs + 16 * j; const LAS float* s = scr + (16 * c) * 65 + nl;
        u32x4 o;
        o.x = pg8::cvt4_fp8(s[0 * 65] * W8_SCALE, s[1 * 65] * W8_SCALE, s[2 * 65] * W8_SCALE, s[3 * 65] * W8_SCALE); o.y = pg8::cvt4_fp8(s[4 * 65] * W8_SCALE, s[5 * 65] * W8_SCALE, s[6 * 65] * W8_SCALE, s[7 * 65] * W8_SCALE);
        o.z = pg8::cvt4_fp8(s[8 * 65] * W8_SCALE, s[9 * 65] * W8_SCALE, s[10 * 65] * W8_SCALE, s[11 * 65] * W8_SCALE); o.w = pg8::cvt4_fp8(s[12 * 65] * W8_SCALE, s[13 * 65] * W8_SCALE, s[14 * 65] * W8_SCALE, s[15 * 65] * W8_SCALE);
        *(u32x4*)(WT + (size_t)nmap(n0 + nl) * K + k0 + 16 * c) = o; }
    LDS_WAIT(); asm volatile("" ::: "memory");
}
template <class NMap>
__device__ __forceinline__ void p0_transpose_item(const float* W, int K, int N, bf16_t* WT, LAS float* scr, int kb, int nb, int lane, NMap nmap) {
    const int k0 = 64 * kb, n0 = 64 * nb;
    { const int kq = lane >> 4, n4 = (lane & 15) * 4;
#pragma unroll
        for (int i = 0; i < 16; ++i) { const f32x4 v = __builtin_nontemporal_load((const f32x4*)(W + (size_t)(k0 + 4 * i + kq) * N + n0 + n4));
            LAS float* d = scr + (4 * i + kq) * 65 + n4; d[0] = v.x; d[1] = v.y; d[2] = v.z; d[3] = v.w; } }
    LDS_WAIT(); asm volatile("" ::: "memory");
    const int c = lane & 7, rs = lane >> 3;
#pragma unroll
    for (int j = 0; j < 8; ++j) { const int nl = rs + 8 * j; const LAS float* s = scr + (8 * c) * 65 + nl;
        u32x4 o; o.x = pk2(s[0 * 65], s[1 * 65]); o.y = pk2(s[2 * 65], s[3 * 65]); o.z = pk2(s[4 * 65], s[5 * 65]); o.w = pk2(s[6 * 65], s[7 * 65]);
        *(u32x4*)(WT + (size_t)nmap(n0 + nl) * K + k0 + 8 * c) = o; }
    LDS_WAIT(); asm volatile("" ::: "memory");
}
constexpr int P0_IT_IN = 16 * 40, P0_IT_IN8 = 16 * 16, P0_IT_OUT = 20 * 16, P0_IT_UP = 16 * 32, P0_IT_DN = 16 * 16, P0_IT_LAYER = P0_IT_IN + P0_IT_IN8 + P0_IT_OUT + NE * P0_IT_UP + NE * P0_IT_DN;
constexpr int P0_ITEMS = DEPTH * P0_IT_LAYER, P0_DEFER = NE * P0_IT_DN;
constexpr int P0_WPB = 7, P0_IPW = 2  , P0_SLOTN = NWG * P0_WPB * P0_IPW, P0_NSLOT = MK_ONE_LAUNCH ? 12 : 0, P0_CNT = MK_ONE_LAUNCH ? 1024 : P0_ITEMS - P0_DEFER;
__host__ __device__ constexpr int p0_slot_raw(int k) { return k <= 4 ? k : k == 6 ? 5 : k == 7 ? 6 : k == 8 ? 7 : k == 10 ? 8 : k == 12 ? 9 : k == 13 ? 10 : k == 14 ? 11 : k == 16 ? 12 : -1; }
__host__ __device__ constexpr int p0_slot(int k) { return p0_slot_raw(k) < P0_NSLOT ? p0_slot_raw(k) : -1; }
static_assert(P0_CNT + P0_NSLOT * P0_SLOTN >= P0_ITEMS - P0_DEFER && P0_CNT + 7 * P0_SLOTN >= P0_IT_LAYER || !MK_ONE_LAUNCH, "p0 slots");
__device__ __forceinline__ void p0_items(const Args& a, LAS unsigned char* lds, int gw, int NGW, int it_lo, int it_hi, int tid);
__device__ __forceinline__ void p0_prologue(const Args& a, LAS unsigned char* lds, int wg, int tid) {
    const int lane = tid & 63, wave = tid >> 6;
    unsigned char* ws = a.ws;
    {
        LAS float* act = (LAS float*)lds; LAS float* red = (LAS float*)(lds + 9 * DM * 4);
        for (int i = tid; i < 9 * DM; i += NTHR) { const int r = i >> 10, k = i & 1023; const float v = (r < 8) ? a.in[I_C][r * DM + k] : a.in[I_CCTX][k]; act[i] = v * sigmoidf_(v); }
        __syncthreads();
        for (int u = wg; u < 768; u += NWG) p0_mods_unit(u, a.in[I_WMOD], a.in[I_BMOD], (float*)(ws + WS_MODS), act, red, tid);
    }
    p0_items(a, lds, wg * NWAVES + wave, NWG * NWAVES, 0, P0_CNT, tid);
}
__device__ __forceinline__ void p0_items(const Args& a, LAS unsigned char* lds, int gw, int NGW, int it_lo, int it_hi, int tid) {
    const int lane = tid & 63, wave = tid >> 6;
    unsigned char* ws = a.ws;
    LAS float* scr = (LAS float*)(lds + wave * 16640);
    constexpr int IT_IN = P0_IT_IN, IT_IN8 = P0_IT_IN8, IT_OUT = P0_IT_OUT, IT_UP = P0_IT_UP, IT_DN = P0_IT_DN, IT_LAYER = P0_IT_LAYER;
    for (int it = it_lo + gw; it < it_hi; it += NGW) {
        const int l = it / IT_LAYER; int r = it % IT_LAYER;
        if (r < IT_IN) { p0_transpose_item(a.in[I_WIN] + (size_t)l * DM * IN_W, DM, IN_W, (bf16_t*)(ws + WS_WIN) + (size_t)l * IN_W * DM, scr, r / 40, r % 40, lane, MapId()); continue; } r -= IT_IN;
        if (r < IT_IN8) { p0_transpose_item8(a.in[I_WIN] + (size_t)l * DM * IN_W, DM, IN_W, (unsigned char*)(ws + WS_WIN8) + (size_t)l * IN_W * DM, scr, r / 16, r % 16, lane, MapId()); continue; } r -= IT_IN8;
        if (r < IT_OUT) { p0_transpose_item(a.in[I_WOUT] + (size_t)l * MIX_W * DM, MIX_W, DM, (bf16_t*)(ws + WS_WOUT) + (size_t)l * DM * MIX_W, scr, r / 16, r % 16, lane, MapId()); continue; } r -= IT_OUT;
        if (r < NE * IT_UP) { const int e = r / IT_UP, q = r % IT_UP;
            p0_transpose_item8(a.in[I_WUP] + ((size_t)l * NE + e) * DM * 2048, DM, 2048, (unsigned char*)(ws + WS_WUP) + ((size_t)l * NE + e) * 2048 * DM, scr, q / 32, q % 32, lane, MapUp()); continue; } r -= NE * IT_UP;
        { const int e = r / IT_DN, q = r % IT_DN;
            p0_transpose_item8(a.in[I_WDN] + ((size_t)l * NE + e) * DFF * DM, DFF, DM, (unsigned char*)(ws + WS_WDN) + ((size_t)l * NE + e) * DM * DFF, scr, q / 16, q % 16, lane, MapId()); }
    }
}

__device__ __forceinline__ void p0_slot_items(const Args& a, LAS unsigned char* lds, int wg, int slot, int t) {
    const int w = t >> 6;
    const int hi_ = P0_CNT + (slot + 1) * P0_SLOTN;
    if (w < P0_WPB) p0_items(a, lds, wg * P0_WPB + w, NWG * P0_WPB, P0_CNT + slot * P0_SLOTN, hi_ < P0_ITEMS - P0_DEFER ? hi_ : P0_ITEMS - P0_DEFER, t);
}

__device__ __forceinline__ void ph_norm1(const float* xlat, const float* xctx, const float* gain, const float* mods_l, bf16_t* HA, unsigned char* HA8, int gw, int NGW, int lane) {
    const int k0 = 16 * lane;
    for (int t0 = gw * 2; t0 < NTOK; t0 += NGW * 2) {
        f32x4 v[2][4]; float ss[2];
#pragma unroll
        for (int r = 0; r < 2; ++r) { const int t = t0 + r; const float* xr = (t < NLAT) ? xlat + (size_t)t * DM : xctx + (size_t)(t - NLAT) * DM;
#pragma unroll
            for (int j = 0; j < 4; ++j) v[r][j] = *(const f32x4*)(xr + k0 + 4 * j); }
#pragma unroll
        for (int r = 0; r < 2; ++r) { float q = 0.f;
#pragma unroll
            for (int j = 0; j < 4; ++j) q += v[r][j].x * v[r][j].x + v[r][j].y * v[r][j].y + v[r][j].z * v[r][j].z + v[r][j].w * v[r][j].w;
            ss[r] = q; }
#pragma unroll
        for (int r = 0; r < 2; ++r) { const int t = t0 + r; const float* mp = mods_l + (size_t)tok_bidx(t) * NMOD;
            const float rstd = rsqrtf(wave_sum(ss[r]) * (1.f / DM) + EPS);
            u32x4 ho[2]; unsigned h8[4];
#pragma unroll
            for (int j = 0; j < 4; ++j) { const int k = k0 + 4 * j;
                const f32x4 g = *(const f32x4*)(gain + k), sh = *(const f32x4*)(mp + k), sc = *(const f32x4*)(mp + DM + k);
                const f32x4 y = (v[r][j] * rstd * g) * (sc + 1.f) + sh;
                ho[j >> 1][(j & 1) * 2] = pk2(y.x, y.y); ho[j >> 1][(j & 1) * 2 + 1] = pk2(y.z, y.w); h8[j] = pg8::cvt4_fp8(y.x, y.y, y.z, y.w); }
            *(u32x4*)(HA + (size_t)t * DM + k0) = ho[0]; *(u32x4*)(HA + (size_t)t * DM + k0 + 8) = ho[1];
            *(u32x4*)(HA8 + (size_t)t * DM + k0) = (u32x4){h8[0], h8[1], h8[2], h8[3]}; }
    }
}

__device__ __forceinline__ u32x2 qk_row(u32x4 X, const float (&g)[8], const float (&gp)[8], bool rot, float sgn, const LAS f32x2* rp) {
    float x[8] = {bflo(X.x), bfhi(X.x), bflo(X.y), bfhi(X.y), bflo(X.z), bfhi(X.z), bflo(X.w), bfhi(X.w)};
    float ss = 0.f;
#pragma unroll
    for (int i = 0; i < 8; ++i) ss += x[i] * x[i];
    ss += xor_swz<1>(ss); ss += xor_swz<2>(ss); ss += xor_swz<4>(ss); ss += xor_swz<8>(ss);
    const float rstd = rsqrtf(ss * (1.f / 128.f) + EPS);
    u32x4 P;
    P.x = (unsigned)__builtin_amdgcn_ds_swizzle((int)X.x, (4 << 10) | 0x1f); P.y = (unsigned)__builtin_amdgcn_ds_swizzle((int)X.y, (4 << 10) | 0x1f);
    P.z = (unsigned)__builtin_amdgcn_ds_swizzle((int)X.z, (4 << 10) | 0x1f); P.w = (unsigned)__builtin_amdgcn_ds_swizzle((int)X.w, (4 << 10) | 0x1f);
    const float px[8] = {bflo(P.x), bfhi(P.x), bflo(P.y), bfhi(P.y), bflo(P.z), bfhi(P.z), bflo(P.w), bfhi(P.w)};
    float o[8];
    if (rot) {
#pragma unroll
        for (int i = 0; i < 8; ++i) { const f32x2 cssn = rp[i]; o[i] = (x[i] * rstd * g[i]) * cssn.x + sgn * (px[i] * rstd * gp[i]) * cssn.y; }
    } else {
#pragma unroll
        for (int i = 0; i < 8; ++i) o[i] = x[i] * rstd * g[i];
    }
    u32x2 r; r.x = pg8::cvt4_fp8(o[0], o[1], o[2], o[3]); r.y = pg8::cvt4_fp8(o[4], o[5], o[6], o[7]); return r;
}
__device__ __forceinline__ void ph_qkv(int l, const Args& a, LAS unsigned char* lds, int wg, int tid) {
    const int lane = tid & 63, wave = tid >> 6;
    unsigned char* ws = a.ws;
    const bf16_t* U = (const bf16_t*)(ws + WS_U);
    unsigned char* QB = ws + WS_QB; unsigned char* KB = ws + WS_KB; unsigned char* VT = ws + WS_VB;
    LAS f32x2* rope = (LAS f32x2*)lds;
    for (int i = tid; i < 64 * 32; i += NTHR) { const int p = i >> 5, f = i & 31;
        const float inv = __builtin_amdgcn_exp2f(-(float)f * (2.0f / 64.0f) * 13.287712379549449f);
        float sn, cs; sincos_rev((float)p * inv * 0.15915494309189535f, sn, cs); rope[i] = (f32x2){cs, sn}; }
    __syncthreads();
    const bool last = (l == DEPTH - 1);
    const int j16 = lane & 15, d0 = j16 * 8, axis = j16 >> 3, fi0 = (j16 & 3) * 8;
    const float sgn = ((j16 >> 2) & 1) ? 1.f : -1.f;
    const float* qn = a.in[I_QN] + l * 128; const float* kn = a.in[I_KN] + l * 128;
    float qg[8], qgp[8], kg[8], kgp[8];
#pragma unroll
    for (int i = 0; i < 8; ++i) { qg[i] = qn[d0 + i] * att8::QSC; qgp[i] = qn[(d0 ^ 32) + i] * att8::QSC; kg[i] = kn[d0 + i]; kgp[i] = kn[(d0 ^ 32) + i]; }
#pragma unroll 2
    for (int t = wg * NWAVES + wave; t < NTOK; t += NWG * NWAVES) {
        const bool isctx = t >= NLAT;
        const int b = isctx ? (t - NLAT) >> 8 : t >> 12, sp = isctx ? (t - NLAT) & 255 : t & 4095, krow = isctx ? sp : CTXL + sp;
        const bool doq = !(last && isctx);
        const bf16_t* up = U + (size_t)t * IN_W;
        u32x4 A = {0u, 0u, 0u, 0u}; if (doq) A = *(const u32x4*)(up + 8 * lane);
        u32x4 B = {0u, 0u, 0u, 0u}; if (lane < 32) B = *(const u32x4*)(up + 512 + 8 * lane);
        const LAS f32x2* rp = rope + (axis ? (sp & 63) : (sp >> 6)) * 32 + fi0;
        const u32x2 qo = qk_row(A, qg, qgp, !isctx, sgn, rp);
        if (doq) *(u32x2*)(QB + (size_t)t * 512 + 8 * lane) = qo;
        const u32x2 ko = qk_row(B, kg, kgp, !isctx, sgn, rp);
        if (lane < 32) *(u32x2*)(KB + ((size_t)(b * 2 + (lane >> 4)) * SKV + krow) * 128 + d0) = ko;
    }
    __syncthreads();
    LAS unsigned char* T = (LAS unsigned char*)lds;
    for (int u = wg; u < BATCH * 2 * (SKV / 64); u += NWG) {
        const int b = u / (2 * (SKV / 64)), rem = u % (2 * (SKV / 64)), kvh = rem / (SKV / 64), tile = rem % (SKV / 64);
        { const int key = tid & 63, dch = (tid >> 6) * 16, kr = tile * 64 + key;
            const size_t tok = (kr < CTXL) ? (size_t)NLAT + b * CTXL + kr : (size_t)b * SEQ + (kr - CTXL);
            const bf16_t* src = U + tok * IN_W + 768 + kvh * 128 + dch;
            const u32x4 v0 = *(const u32x4*)src, v1 = *(const u32x4*)(src + 8);
            const unsigned w0 = pg8::cvt4_fp8(bflo(v0.x), bfhi(v0.x), bflo(v0.y), bfhi(v0.y)), w1 = pg8::cvt4_fp8(bflo(v0.z), bfhi(v0.z), bflo(v0.w), bfhi(v0.w));
            const unsigned w2 = pg8::cvt4_fp8(bflo(v1.x), bfhi(v1.x), bflo(v1.y), bfhi(v1.y)), w3 = pg8::cvt4_fp8(bflo(v1.z), bfhi(v1.z), bflo(v1.w), bfhi(v1.w));
            LAS unsigned char* dst = T + dch * 64 + att8::kpos(key);
#pragma unroll
            for (int i = 0; i < 4; ++i) { dst[(i) * 64] = (unsigned char)(w0 >> (8 * i)); dst[(4 + i) * 64] = (unsigned char)(w1 >> (8 * i)); dst[(8 + i) * 64] = (unsigned char)(w2 >> (8 * i)); dst[(12 + i) * 64] = (unsigned char)(w3 >> (8 * i)); } }
        __syncthreads();
        *(u32x4*)(VT + ((size_t)(b * 2 + kvh) * (SKV / 64) + tile) * 8192 + tid * 16) = *(const LAS u32x4*)(T + tid * 16);
        __syncthreads();
    }
}

constexpr int CV_GLU = 0, CV_D = 32768, CV_END = CV_D + 32 * 256 * 4;
__device__ __forceinline__ void ph_conv_tiles(int l, const Args& a, LAS unsigned char* lds, int wg, int tid) {
    unsigned char* ws = a.ws;
    const bf16_t* U = (const bf16_t*)(ws + WS_U); bf16_t* MIX = (bf16_t*)(ws + WS_MIX);
    const float* cdw = a.in[I_CDW] + (size_t)l * 31 * 256; const float* cdb = a.in[I_CDB] + l * 256;
    const float* clg = a.in[I_CLG] + l * 256; const float* clb = a.in[I_CLB] + l * 256; const float* scw = a.in[I_SCW] + (size_t)l * 3 * 256;
    LAS unsigned* glu = (LAS unsigned*)(lds + CV_GLU);
    LAS float* dbuf = (LAS float*)(lds + CV_D);
    const int cp = tid & 127, tg = tid >> 7;
    const int hw = tid >> 5, l32 = tid & 31;
    f32x2 w[31];
#pragma unroll
    for (int j = 0; j < 31; ++j) w[j] = *(const f32x2*)(cdw + j * 256 + 2 * cp);
    const f32x2 cbias = *(const f32x2*)(cdb + 2 * cp);
    const int ntiles = (l == DEPTH - 1) ? NLAT / 32 : NTOK / 32;
    u32x4 ra[4], rg[4];
#define CV_LOAD(TT) do { const int t0_ = (TT) * 32; const bool ic_ = t0_ >= NLAT; const int sq_ = ic_ ? (t0_ - NLAT) & 255 : t0_ & 4095, sl_ = ic_ ? CTXL : SEQ; \
        _Pragma("unroll") for (int i = 0; i < 4; ++i) { const int id = tid + NTHR * i, j = id >> 5, c8 = (id & 31) * 8, sj = sq_ - 15 + j; \
            ra[i] = (u32x4){0u, 0u, 0u, 0u}; rg[i] = ra[i]; \
            if (id < 62 * 32 && sj >= 0 && sj < sl_) { const bf16_t* up = U + (size_t)(t0_ - 15 + j) * IN_W + 2048 + c8; ra[i] = *(const u32x4*)up; rg[i] = *(const u32x4*)(up + 256); } } } while (0)
    if (wg < ntiles) CV_LOAD(wg);
    for (int tt = wg; tt < ntiles; tt += NWG) {
        const int t0 = tt * 32; const bool isctx = t0 >= NLAT;
        const int s0p = isctx ? (t0 - NLAT) & 255 : t0 & 4095, slen = isctx ? CTXL : SEQ;
#pragma unroll
        for (int i = 0; i < 4; ++i) { const int id = tid + NTHR * i;
            if (id < 62 * 32) { u32x4 o;
                o.x = pk2(bflo(ra[i].x) * sigmoidf_(bflo(rg[i].x)), bfhi(ra[i].x) * sigmoidf_(bfhi(rg[i].x))); o.y = pk2(bflo(ra[i].y) * sigmoidf_(bflo(rg[i].y)), bfhi(ra[i].y) * sigmoidf_(bfhi(rg[i].y)));
                o.z = pk2(bflo(ra[i].z) * sigmoidf_(bflo(rg[i].z)), bfhi(ra[i].z) * sigmoidf_(bfhi(rg[i].z))); o.w = pk2(bflo(ra[i].w) * sigmoidf_(bflo(rg[i].w)), bfhi(ra[i].w) * sigmoidf_(bfhi(rg[i].w)));
                *(LAS u32x4*)(glu + id * 4) = o; } }
        __syncthreads();
        if (tt + NWG < ntiles) CV_LOAD(tt + NWG);
        {
            f32x2 acc[8];
#pragma unroll
            for (int o = 0; o < 8; ++o) acc[o] = cbias;
#pragma unroll
            for (int jj = 0; jj < 38; ++jj) { const unsigned gv = glu[(tg * 8 + jj) * 128 + cp]; const f32x2 v = {bflo(gv), bfhi(gv)};
#pragma unroll
                for (int o = 0; o < 8; ++o) { const int k = jj - o; if (k >= 0 && k < 31) acc[o] += w[k] * v; } }
#pragma unroll
            for (int o = 0; o < 8; ++o) *(LAS f32x2*)(dbuf + (tg * 8 + o) * 256 + 2 * cp) = acc[o];
        }
        {
            const int c8 = (tid & 31) * 8;
#pragma unroll
            for (int q = 0; q < 2; ++q) { const int tl = (tid >> 5) + 16 * q, sj = s0p + tl; const bf16_t* up = U + (size_t)(t0 + tl) * IN_W + c8;
                u32x4 cv[3], xv[3];
#pragma unroll
                for (int d = 0; d < 3; ++d) { cv[d] = (u32x4){0u, 0u, 0u, 0u}; xv[d] = cv[d];
                    if (sj + d - 1 >= 0 && sj + d - 1 < slen) { cv[d] = *(const u32x4*)(up + (d - 1) * IN_W + 1280); xv[d] = *(const u32x4*)(up + (d - 1) * IN_W + 1536); } }
                const u32x4 bv = *(const u32x4*)(up + 1024);
                const f32x4 w0a = *(const f32x4*)(scw + c8), w0b = *(const f32x4*)(scw + c8 + 4), w1a = *(const f32x4*)(scw + 256 + c8), w1b = *(const f32x4*)(scw + 256 + c8 + 4), w2a = *(const f32x4*)(scw + 512 + c8), w2b = *(const f32x4*)(scw + 512 + c8 + 4);
                const float wt[3][8] = {{w0a.x, w0a.y, w0a.z, w0a.w, w0b.x, w0b.y, w0b.z, w0b.w}, {w1a.x, w1a.y, w1a.z, w1a.w, w1b.x, w1b.y, w1b.z, w1b.w}, {w2a.x, w2a.y, w2a.z, w2a.w, w2b.x, w2b.y, w2b.z, w2b.w}};
                float acc[8];
#pragma unroll
                for (int i = 0; i < 8; ++i) acc[i] = 0.f;
#pragma unroll
                for (int d = 0; d < 3; ++d) { const unsigned cw[4] = {cv[d].x, cv[d].y, cv[d].z, cv[d].w}, xw[4] = {xv[d].x, xv[d].y, xv[d].z, xv[d].w};
#pragma unroll
                    for (int i = 0; i < 4; ++i) { acc[2 * i] += wt[d][2 * i] * (bflo(cw[i]) * bflo(xw[i])); acc[2 * i + 1] += wt[d][2 * i + 1] * (bfhi(cw[i]) * bfhi(xw[i])); } }
                const unsigned bw[4] = {bv.x, bv.y, bv.z, bv.w}; u32x4 o;
                o.x = pk2(bflo(bw[0]) * acc[0], bfhi(bw[0]) * acc[1]); o.y = pk2(bflo(bw[1]) * acc[2], bfhi(bw[1]) * acc[3]); o.z = pk2(bflo(bw[2]) * acc[4], bfhi(bw[2]) * acc[5]); o.w = pk2(bflo(bw[3]) * acc[6], bfhi(bw[3]) * acc[7]);
                *(u32x4*)(MIX + (size_t)(t0 + tl) * MIX_W + 512 + c8) = o; }
        }
        __syncthreads();
#pragma unroll
        for (int q = 0; q < 2; ++q) { const int tok = hw * 2 + q;
            const f32x4 v0 = *(const LAS f32x4*)(dbuf + tok * 256 + l32 * 8), v1 = *(const LAS f32x4*)(dbuf + tok * 256 + l32 * 8 + 4);
            float sm = (v0.x + v0.y + v0.z + v0.w) + (v1.x + v1.y + v1.z + v1.w);
            sm += xor_swz<1>(sm); sm += xor_swz<2>(sm); sm += xor_swz<4>(sm); sm += xor_swz<8>(sm); sm += xor_swz<16>(sm);
            const float mean = sm * (1.f / 256.f);
            const f32x4 d0 = v0 - mean, d1 = v1 - mean;
            float vs = (d0.x * d0.x + d0.y * d0.y + d0.z * d0.z + d0.w * d0.w) + (d1.x * d1.x + d1.y * d1.y + d1.z * d1.z + d1.w * d1.w);
            vs += xor_swz<1>(vs); vs += xor_swz<2>(vs); vs += xor_swz<4>(vs); vs += xor_swz<8>(vs); vs += xor_swz<16>(vs);
            const float rstd = rsqrtf(vs * (1.f / 256.f) + EPS);
            const f32x4 g0 = *(const f32x4*)(clg + l32 * 8), g1 = *(const f32x4*)(clg + l32 * 8 + 4), b0 = *(const f32x4*)(clb + l32 * 8), b1 = *(const f32x4*)(clb + l32 * 8 + 4);
            f32x4 y0 = d0 * rstd * g0 + b0, y1 = d1 * rstd * g1 + b1;
            y0.x *= sigmoidf_(y0.x); y0.y *= sigmoidf_(y0.y); y0.z *= sigmoidf_(y0.z); y0.w *= sigmoidf_(y0.w);
            y1.x *= sigmoidf_(y1.x); y1.y *= sigmoidf_(y1.y); y1.z *= sigmoidf_(y1.z); y1.w *= sigmoidf_(y1.w);
            u32x4 o; o.x = pk2(y0.x, y0.y); o.y = pk2(y0.z, y0.w); o.z = pk2(y1.x, y1.y); o.w = pk2(y1.z, y1.w);
            *(u32x4*)(MIX + (size_t)(t0 + tok) * MIX_W + 1024 + l32 * 8) = o; }
    }
#undef CV_LOAD
    __syncthreads();
}

constexpr int FM_LD = 72;
constexpr int FM_WC = 0, FM_WS = 9216, FM_WSN = 18432, FM_X = 27648, FM_GRE = 36864, FM_GIM = 46080, FM_AT = 27648  , FM_OUT = 55296  , FM_OUT3 = 64512  , FM_TW = FM_OUT3 + 2 * 9216  , FM_END = FM_TW + 1024;
__device__ __forceinline__ void fm_tables(LAS unsigned char* lds, int tid) {
    LAS bf16_t* Wc = (LAS bf16_t*)(lds + FM_WC); LAS bf16_t* Ws = (LAS bf16_t*)(lds + FM_WS); LAS bf16_t* Wsn = (LAS bf16_t*)(lds + FM_WSN);
    for (int i = tid; i < 4096; i += NTHR) { const int r = i >> 6, c = i & 63; float sn, cs; sincos_rev((float)((r * c) & 63) * (1.f / 64.f), sn, cs);
        Wc[r * FM_LD + c] = (bf16_t)f2bf(cs); Ws[r * FM_LD + c] = (bf16_t)f2bf(sn); Wsn[r * FM_LD + c] = (bf16_t)f2bf(-sn); }
    __syncthreads();
}
template <bool BSWZ = false>
__device__ __forceinline__ void fm_mm(f32x16& acc, const LAS bf16_t* A, int ar0, const LAS bf16_t* Bt, int br0, int lane) {
    const int r = lane & 31, h = lane >> 5;
#pragma unroll
    for (int k0 = 0; k0 < 64; k0 += 16) {
        const int kg = (k0 >> 3) + h, kb = BSWZ ? ((kg ^ (((br0 + r) >> 3) & 7)) << 3) : (kg << 3);
        const bf16x8 av = *(const LAS bf16x8*)(A + (ar0 + r) * FM_LD + k0 + 8 * h), bv = *(const LAS bf16x8*)(Bt + (br0 + r) * FM_LD + kb);
        acc = __builtin_amdgcn_mfma_f32_32x32x16_bf16(av, bv, acc, 0, 0, 0); }
}
__device__ __forceinline__ int fm_crow(int reg, int h) { return (reg & 3) + 8 * (reg >> 2) + 4 * h; }
template <bool CTXM>
__device__ __forceinline__ void fm12_unit(int unit, const bf16_t* U, bf16_t* F2, LAS unsigned char* lds, int tid) {
    const LAS bf16_t* Wc = (const LAS bf16_t*)(lds + FM_WC); const LAS bf16_t* Ws = (const LAS bf16_t*)(lds + FM_WS); const LAS bf16_t* Wsn = (const LAS bf16_t*)(lds + FM_WSN);
    LAS bf16_t* X = (LAS bf16_t*)(lds + FM_X); LAS bf16_t* Gre = (LAS bf16_t*)(lds + FM_GRE); LAS bf16_t* Gim = (LAS bf16_t*)(lds + FM_GIM);
    int b, g, s2;
    if (!CTXM) { b = unit >> 8; g = (unit >> 6) & 3; s2 = unit & 63; } else { b = unit >> 4; g = (unit >> 2) & 3; s2 = unit & 3; }
    const int lane = tid & 63, wave = tid >> 6, r = lane & 31, h = lane >> 5, part = wave >> 2, tr = (wave >> 1) & 1, tc = wave & 1;
    { const int s1 = tid >> 3, c8 = (tid & 7) * 8;
        const size_t tok = CTXM ? (size_t)NLAT + b * CTXL + (s1 >> 4) * 64 + s2 * 16 + (s1 & 15) : (size_t)b * SEQ + s1 * 64 + s2;
        *(LAS u32x4*)(X + s1 * FM_LD + c8) = *(const u32x4*)(U + tok * IN_W + 1792 + g * 64 + c8); }
    __syncthreads();
    {
        f32x16 acc = {};
        fm_mm(acc, X, tr * 32, part ? Wsn : Wc, tc * 32, lane);
        LAS bf16_t* GT = part ? Gim : Gre;
#pragma unroll
        for (int q = 0; q < 4; ++q) { u32x2 o; o.x = pk2(acc[4 * q], acc[4 * q + 1]); o.y = pk2(acc[4 * q + 2], acc[4 * q + 3]);
            *(LAS u32x2*)(GT + (tc * 32 + r) * FM_LD + tr * 32 + 8 * q + 4 * h) = o; }
    }
    __syncthreads();
    if constexpr (!CTXM) {
    {
        f32x16 acc = {};
        fm_mm(acc, Wc, tr * 32, part ? Gim : Gre, tc * 32, lane);
        fm_mm(acc, part ? Wsn : Ws, tr * 32, part ? Gre : Gim, tc * 32, lane);
        LAS bf16_t* OUT = (LAS bf16_t*)(lds + FM_OUT) + part * 64 * FM_LD;
#pragma unroll
        for (int reg = 0; reg < 16; ++reg) OUT[(tr * 32 + fm_crow(reg, h)) * FM_LD + tc * 32 + r] = (bf16_t)f2bf(acc[reg]);
    }
    __syncthreads();
#pragma unroll
    for (int i = 0; i < 2; ++i) { const int c = tid + NTHR * i, k1 = c >> 4, pt = (c >> 3) & 1, mch = (c & 7) * 8;
        *(u32x4*)(F2 + ((((size_t)(b * 4 + g) * 64 + k1) * 64 + s2) * 2 + pt) * 64 + mch) = *(const LAS u32x4*)((LAS bf16_t*)(lds + FM_OUT) + (pt * 64 + k1) * FM_LD + mch); }
    } else {
        const int k1 = tid >> 7, s2l = (tid >> 3) & 15, m0 = (tid & 7) * 8;
        float re[8], im[8];
#pragma unroll
        for (int q = 0; q < 8; ++q) { re[q] = 0.f; im[q] = 0.f; }
#pragma unroll
        for (int s1 = 0; s1 < 4; ++s1) { const int idx = (16 * s1 * k1) & 63; const float wr = bf2f(Wc[FM_LD + idx]), wi = bf2f(Ws[FM_LD + idx]);
#pragma unroll
            for (int q = 0; q < 8; ++q) { const float gr = bf2f(Gre[(m0 + q) * FM_LD + s1 * 16 + s2l]), gi = bf2f(Gim[(m0 + q) * FM_LD + s1 * 16 + s2l]); re[q] += wr * gr + wi * gi; im[q] += wr * gi - wi * gr; } }
        bf16_t* dst = F2 + (size_t)NLAT * 512 + ((((size_t)(b * 4 + g) * 4 + k1) * 64 + s2 * 16 + s2l) * 2) * 64 + m0;
        u32x4 o; o.x = pk2(re[0], re[1]); o.y = pk2(re[2], re[3]); o.z = pk2(re[4], re[5]); o.w = pk2(re[6], re[7]); *(u32x4*)dst = o;
        o.x = pk2(im[0], im[1]); o.y = pk2(im[2], im[3]); o.z = pk2(im[4], im[5]); o.w = pk2(im[6], im[7]); *(u32x4*)(dst + 64) = o;
    }
}
template <bool CTXM>
__device__ __forceinline__ void fm3_unit(int unit, const bf16_t* F2, bf16_t* MIX, LAS unsigned char* lds, int tid) {
    const LAS bf16_t* Wc = (const LAS bf16_t*)(lds + FM_WC); const LAS bf16_t* Ws = (const LAS bf16_t*)(lds + FM_WS);
    LAS bf16_t* AT = (LAS bf16_t*)(lds + FM_AT);
    constexpr int N1 = CTXM ? 4 : 64; constexpr float NRM = CTXM ? (1.f / 128.f) : (1.f / 512.f);
    int b, g, kp;
    if (!CTXM) { b = unit >> 7; g = (unit >> 5) & 3; kp = unit & 31; } else { b = unit >> 3; g = (unit >> 1) & 3; kp = unit & 1; }
    const bf16_t* F2b = F2 + (CTXM ? (size_t)NLAT * 512 : 0);
    const size_t tok0 = CTXM ? (size_t)NLAT + b * CTXL : (size_t)b * SEQ;
    const int lane = tid & 63, wave = tid >> 6, r = lane & 31, h = lane >> 5;
    LAS f32x2* tw = (LAS f32x2*)(lds + FM_TW);
    if (tid < 128) { const int ki = tid >> 6, s2 = tid & 63; float sn, cs; sincos_rev((float)(s2 * (kp * 2 + ki)) * (1.f / (64.f * N1)), sn, cs); tw[tid] = (f32x2){cs, sn}; }
    __syncthreads();
#pragma unroll
    for (int ki = 0; ki < 2; ++ki) { const bf16_t* img = F2b + (((size_t)(b * 4 + g) * N1 + kp * 2 + ki) * 64) * 128;
        const int s2 = tid >> 3, mch = tid & 7;
        const u32x4 rv = *(const u32x4*)(img + s2 * 128 + mch * 8), iv = *(const u32x4*)(img + s2 * 128 + 64 + mch * 8);
        const f32x2 t = tw[ki * 64 + s2]; const float cs = t.x, sn = t.y;
        const float re[8] = {bflo(rv.x), bfhi(rv.x), bflo(rv.y), bfhi(rv.y), bflo(rv.z), bfhi(rv.z), bflo(rv.w), bfhi(rv.w)};
        const float im[8] = {bflo(iv.x), bfhi(iv.x), bflo(iv.y), bfhi(iv.y), bflo(iv.z), bfhi(iv.z), bflo(iv.w), bfhi(iv.w)};
        const int col = (((s2 >> 3) ^ mch) << 3) | (s2 & 7);
        LAS bf16_t* are = AT + (ki * 2 + 0) * 64 * FM_LD + (mch * 8) * FM_LD + col; LAS bf16_t* aim = AT + (ki * 2 + 1) * 64 * FM_LD + (mch * 8) * FM_LD + col;
#pragma unroll
        for (int q = 0; q < 8; ++q) { are[q * FM_LD] = (bf16_t)f2bf(re[q] * cs + im[q] * sn); aim[q * FM_LD] = (bf16_t)f2bf(im[q] * cs - re[q] * sn); }
    }
    __syncthreads();
    { const int ki = wave >> 2, tr = (wave >> 1) & 1, tc = wave & 1;
        f32x16 acc = {};
        fm_mm<true>(acc, Wc, tr * 32, AT + (ki * 2 + 0) * 64 * FM_LD, tc * 32, lane);
        fm_mm<true>(acc, Ws, tr * 32, AT + (ki * 2 + 1) * 64 * FM_LD, tc * 32, lane);
        LAS bf16_t* OUT = (LAS bf16_t*)(lds + FM_OUT3) + ki * 64 * FM_LD;
#pragma unroll
        for (int reg = 0; reg < 16; ++reg) OUT[(tr * 32 + fm_crow(reg, h)) * FM_LD + tc * 32 + r] = (bf16_t)f2bf(acc[reg] * NRM);
    }
    __syncthreads();
#pragma unroll
    for (int i = 0; i < 2; ++i) { const int c = tid + NTHR * i, ki = c >> 9, k2 = (c >> 3) & 63, mch = (c & 7) * 8;
        *(u32x4*)(MIX + (tok0 + kp * 2 + ki + N1 * k2) * MIX_W + 768 + g * 64 + mch) = *(const LAS u32x4*)((LAS bf16_t*)(lds + FM_OUT3) + (ki * 64 + k2) * FM_LD + mch); }
    __syncthreads();
}

constexpr int N2_SSQ = 0, N2_PART = 1024, N2_LG = N2_PART + 8 * 32 * 33 * 4, N2_HIST = N2_LG + 32 * 33 * 4, N2_TA = 40960, N2_TB = N2_TA + 9 * DM * 4, N2_END = N2_TB + 9 * DM * 4;
static_assert(N2_HIST + 128 <= N2_TA && N2_END <= LDS_FREE, "norm2 LDS");
__device__ __forceinline__ void hilo8(const float (&v)[8], bf16x8& hi, bf16x8& lo) {
    u32x4 H, L;
#pragma unroll
    for (int j = 0; j < 4; ++j) { const unsigned hw = pk2(v[2 * j], v[2 * j + 1]); H[j] = hw; L[j] = pk2(v[2 * j] - bflo(hw), v[2 * j + 1] - bfhi(hw)); }
    hi = __builtin_bit_cast(bf16x8, H); lo = __builtin_bit_cast(bf16x8, L);
}
__device__ __forceinline__ void n2_tables(int l, const Args& a, LAS unsigned char* lds, int t, int nt) {
    const float* mods_l = (const float*)(a.ws + WS_MODS) + (size_t)l * 9 * NMOD; const float* gain = a.in[I_NFFN] + l * DM;
    LAS float* TA = (LAS float*)(lds + N2_TA); LAS float* TB = (LAS float*)(lds + N2_TB); LAS int* hist = (LAS int*)(lds + N2_HIST);
    if (t < NE) hist[t] = 0;
    for (int i = t; i < 9 * DM; i += nt) { const int rr = i >> 10, k = i & 1023; TA[i] = gain[k] * (1.f + mods_l[(size_t)rr * NMOD + 4 * DM + k]); TB[i] = mods_l[(size_t)rr * NMOD + 3 * DM + k]; }
}
template <bool PRE>
__device__ __forceinline__ void ph_norm2(int l, int ntok, const Args& a, LAS unsigned char* lds, int wg, int tid) {
    const int lane = tid & 63, wave = tid >> 6, r = lane & 31, h = lane >> 5;
    unsigned char* ws = a.ws;
    const bf16_t* XA = (const bf16_t*)(ws + WS_XA); unsigned char* H8 = (unsigned char*)(ws + WS_H8);
    const float* mods_l = (const float*)(ws + WS_MODS) + (size_t)l * 9 * NMOD;
    const float* gain = a.in[I_NFFN] + l * DM; const float* rw = a.in[I_RW] + (size_t)l * DM * NE; const float* rb = a.in[I_RB] + l * NE;
    int* tok_e = (int*)(ws + WS_TOKE); float* tok_p = (float*)(ws + WS_TOKP); int* counts = (int*)(ws + WS_CNT);
    LAS float* ssq = (LAS float*)(lds + N2_SSQ); LAS float* part = (LAS float*)(lds + N2_PART); LAS float* lg = (LAS float*)(lds + N2_LG); LAS int* hist = (LAS int*)(lds + N2_HIST);
    LAS float* TA = (LAS float*)(lds + N2_TA); LAS float* TB = (LAS float*)(lds + N2_TB);
    if (!PRE) n2_tables(l, a, lds, tid, NTHR);
    bf16x8 Bhi[8], Blo[8];
#pragma unroll
    for (int s = 0; s < 8; ++s) { float v[8];
#pragma unroll
        for (int j = 0; j < 8; ++j) v[j] = rw[(size_t)(128 * wave + 16 * s + 8 * h + j) * NE + r];
        hilo8(v, Bhi[s], Blo[s]); }
    __syncthreads();
    const int ntile = ntok / 32;
    u32x4 xraw[8];
    if (wg < ntile) { const bf16_t* xr0 = XA + (size_t)(wg * 32 + r) * DM + 128 * wave + 8 * h;
#pragma unroll
        for (int s = 0; s < 8; ++s) xraw[s] = *(const u32x4*)(xr0 + 16 * s); }
    for (int tile = wg; tile < ntile; tile += NWG) {
        const int t = tile * 32 + r;
        f32x4 xv[8][2]; float ss = 0.f;
#pragma unroll
        for (int s = 0; s < 8; ++s) { xv[s][0] = (f32x4){bflo(xraw[s].x), bfhi(xraw[s].x), bflo(xraw[s].y), bfhi(xraw[s].y)}; xv[s][1] = (f32x4){bflo(xraw[s].z), bfhi(xraw[s].z), bflo(xraw[s].w), bfhi(xraw[s].w)}; }
        if (tile + NWG < ntile) { const bf16_t* xrn = XA + (size_t)((tile + NWG) * 32 + r) * DM + 128 * wave + 8 * h;
#pragma unroll
            for (int s = 0; s < 8; ++s) xraw[s] = *(const u32x4*)(xrn + 16 * s); }
#pragma unroll
        for (int s = 0; s < 8; ++s) ss += (xv[s][0].x * xv[s][0].x + xv[s][0].y * xv[s][0].y + xv[s][0].z * xv[s][0].z + xv[s][0].w * xv[s][0].w) + (xv[s][1].x * xv[s][1].x + xv[s][1].y * xv[s][1].y + xv[s][1].z * xv[s][1].z + xv[s][1].w * xv[s][1].w);
        { auto rr = __builtin_amdgcn_permlane32_swap(__float_as_uint(ss), __float_as_uint(ss), false, false); ss = __uint_as_float(rr[0]) + __uint_as_float(rr[1]); }
        if (h == 0) ssq[wave * 32 + r] = ss;
        __syncthreads();
        float tot = 0.f;
#pragma unroll
        for (int w = 0; w < 8; ++w) tot += ssq[w * 32 + r];
        const float rstd = rsqrtf(tot * (1.f / DM) + EPS);
        f32x16 acc = {};
        const LAS float* ta = TA + tok_bidx(tile * 32) * DM + 128 * wave + 8 * h; const LAS float* tb = TB + tok_bidx(tile * 32) * DM + 128 * wave + 8 * h;
#pragma unroll
        for (int s = 0; s < 8; ++s) {
            const f32x4 y0 = (xv[s][0] * rstd) * *(const LAS f32x4*)(ta + 16 * s) + *(const LAS f32x4*)(tb + 16 * s), y1 = (xv[s][1] * rstd) * *(const LAS f32x4*)(ta + 16 * s + 4) + *(const LAS f32x4*)(tb + 16 * s + 4);
            const float v[8] = {y0.x, y0.y, y0.z, y0.w, y1.x, y1.y, y1.z, y1.w};
            u32x2 o8; o8.x = pg8::cvt4_fp8(v[0], v[1], v[2], v[3]); o8.y = pg8::cvt4_fp8(v[4], v[5], v[6], v[7]);
            *(u32x2*)(H8 + (size_t)t * DM + 128 * wave + 16 * s + 8 * h) = o8;
            bf16x8 ahi, alo; hilo8(v, ahi, alo);
            acc = __builtin_amdgcn_mfma_f32_32x32x16_bf16(ahi, Bhi[s], acc, 0, 0, 0);
            acc = __builtin_amdgcn_mfma_f32_32x32x16_bf16(alo, Bhi[s], acc, 0, 0, 0);
            acc = __builtin_amdgcn_mfma_f32_32x32x16_bf16(ahi, Blo[s], acc, 0, 0, 0); }
#pragma unroll
        for (int reg = 0; reg < 16; ++reg) part[(wave * 32 + fm_crow(reg, h)) * 33 + r] = acc[reg];
        __syncthreads();
#pragma unroll
        for (int q = 0; q < 2; ++q) { const int idx = tid + NTHR * q, tk = idx >> 5, e = idx & 31; float sm = rb[e];
#pragma unroll
            for (int w = 0; w < 8; ++w) sm += part[(w * 32 + tk) * 33 + e];
            lg[tk * 33 + e] = sm; }
        __syncthreads();
#pragma unroll
        for (int q = 0; q < 2; ++q) { const int tk = wave * 4 + q * 2 + h;
            float v = lg[tk * 33 + r]; float bv[4]; int be[4];
#pragma unroll
            for (int j = 0; j < 4; ++j) { float m = v;
                m = fmaxf(m, xor_swz<1>(m)); m = fmaxf(m, xor_swz<2>(m)); m = fmaxf(m, xor_swz<4>(m)); m = fmaxf(m, xor_swz<8>(m)); m = fmaxf(m, xor_swz<16>(m));
                const unsigned long long bal = __ballot(v == m); const unsigned mine = (unsigned)(bal >> (32 * h));
                const int idx = __builtin_ctz(mine);
                bv[j] = m; be[j] = idx; if (r == idx) v = -3.0e38f; }
            if (r == 0) { const float e1 = __expf(bv[1] - bv[0]), e2 = __expf(bv[2] - bv[0]), e3 = __expf(bv[3] - bv[0]); const float inv = __builtin_amdgcn_rcpf(1.f + e1 + e2 + e3);
                const int tt = tile * 32 + tk;
                *(int4*)(tok_e + (size_t)tt * 4) = make_int4(be[0], be[1], be[2], be[3]);
                *(float4*)(tok_p + (size_t)tt * 4) = make_float4(inv, e1 * inv, e2 * inv, e3 * inv);
#pragma unroll
                for (int j = 0; j < 4; ++j) atomicAdd((int*)&hist[be[j]], 1); } }
    }
    __syncthreads();
    if (tid < NE) counts[wg * NE + tid] = hist[tid];
}

constexpr int RT_PSUM = 0, RT_PPRE = 2048, RT_TOT = 4096, RT_BASE = 4224, RT_OFF = 4352, RT_POS = 4608;
__device__ __forceinline__ void ph_route(int ntok, const Args& a, LAS unsigned char* lds, int wg, int tid) {
    const int lane = tid & 63, wave = tid >> 6;
    unsigned char* ws = a.ws;
    const int* counts = (const int*)(ws + WS_CNT); int* eoff = (int*)(ws + WS_EOFF);
    const int* tok_e = (const int*)(ws + WS_TOKE); const float* tok_p = (const float*)(ws + WS_TOKP); int* tokpos = (int*)(ws + WS_TOKPOS); float* roww = (float*)(ws + WS_ROWW);
    int* rowtok = (int*)(ws + WS_ROWTOK);
    LAS int* psum = (LAS int*)(lds + RT_PSUM); LAS int* ppre = (LAS int*)(lds + RT_PPRE); LAS int* tot = (LAS int*)(lds + RT_TOT); LAS int* base = (LAS int*)(lds + RT_BASE); LAS int* off = (LAS int*)(lds + RT_OFF); LAS int* posb = (LAS int*)(lds + RT_POS);
    { const int e = tid & 31, part = tid >> 5; int s = 0, pre = 0;
        for (int w = part * 16; w < part * 16 + 16; ++w) { const int c = counts[w * NE + e]; if (w < wg) pre += c; s += c; }
        psum[part * 32 + e] = s; ppre[part * 32 + e] = pre; }
    __syncthreads();
    if (tid < NE) { int s = 0, pre = 0;
        for (int p = 0; p < 16; ++p) { s += psum[p * 32 + tid]; pre += ppre[p * 32 + tid]; }
        tot[tid] = s; base[tid] = pre; }
    __syncthreads();
    if (tid == 0) { int o = 0; for (int e = 0; e < NE; ++e) { off[e] = o; o += (tot[e] + 255) & ~255; } off[NE] = o; }
    __syncthreads();
    if (wg == 0 && tid <= NE) eoff[tid] = off[tid];
    { LAS int* tab = (LAS int*)(lds + LDS_TAB); const int nMt_ = off[NE] >> 8;
        for (int i = tid; i < nMt_; i += NTHR) { const int row = i << 8; int e = 0;
            for (int q = 1; q < NE; ++q) if (off[q] <= row) e = q;
            tab[i] = e; }
        if (tid == 0) tab[LDS_TAB_NMT] = nMt_; }
    const int ntile = ntok / 32, ntw = (ntile - wg + NWG - 1) / NWG, nas = ntw * 128;
#define RT_TOK(ai) ((wg + NWG * ((ai) >> 7)) * 32 + (((ai) >> 2) & 31))
    if (wave == 0) {
        constexpr int MAXCH = 10; static_assert((NTOK / 32 + NWG - 1) / NWG * 128 <= MAXCH * 64, "route chunks");
        if (lane < NE) posb[lane] = off[lane] + base[lane];
        int ev[MAXCH]; float pw[MAXCH];
#pragma unroll
        for (int k = 0; k < MAXCH; ++k) { const int aidx = 64 * k + lane; const bool valid = aidx < nas; const size_t gi = valid ? (size_t)RT_TOK(aidx) * 4 + (aidx & 3) : 0;
            ev[k] = valid ? tok_e[gi] : -1; pw[k] = valid ? tok_p[gi] : 0.f; }
#pragma unroll
        for (int k = 0; k < MAXCH; ++k) if (64 * k < nas) {
            const int e = ev[k], aidx = 64 * k + lane; const bool valid = e >= 0;
            unsigned long long m = __ballot(valid);
#pragma unroll
            for (int b = 0; b < 5; ++b) { const bool bit = (e >> b) & 1; const unsigned long long bb = __ballot(bit); m &= bit ? bb : ~bb; }
            const int rank = (int)__builtin_amdgcn_mbcnt_hi((unsigned)(m >> 32), __builtin_amdgcn_mbcnt_lo((unsigned)m, 0u));
            const int rs = posb[valid ? e : 0];
            if (valid && rank == 0) posb[e] = rs + __popcll(m);
            if (valid) { const size_t gi = (size_t)RT_TOK(aidx) * 4 + (aidx & 3); const int pos = rs + rank; tokpos[gi] = pos; roww[pos] = pw[k]; rowtok[pos] = RT_TOK(aidx); } }
    }
    if (wg < NE) { const int p0 = off[wg] + tot[wg], p1 = off[wg + 1]; for (int p = p0 + tid; p < p1; p += NTHR) rowtok[p] = 0; }
#undef RT_TOK
}
__device__ __forceinline__ int moe_tiles(const unsigned char* ws, LAS unsigned char* lds, int tid) {
    const int* eoff = (const int*)(ws + WS_EOFF); LAS int* tab = (LAS int*)(lds + LDS_TAB);
    const int total = eoff[NE];
    const int nMt = total >> 8;
    for (int i = tid; i < nMt; i += NTHR) { const int row = i << 8; int e = 0;
        for (int q = 1; q < NE; ++q) if (eoff[q] <= row) e = q;
        tab[i] = e; }
    __syncthreads();
    return __builtin_amdgcn_readfirstlane(nMt);
}

__device__ __forceinline__ f32x4 fp8x4_to_f32(unsigned w) {
    const f32x2 lo = __builtin_amdgcn_cvt_pk_f32_fp8((int)w, false), hi = __builtin_amdgcn_cvt_pk_f32_fp8((int)w, true);
    return (f32x4){lo.x, lo.y, hi.x, hi.y};
}
constexpr int CB_G2 = 0, CB_SH = 9 * DM * 4, CB_SC = 2 * 9 * DM * 4, CB_GN = 3 * 9 * DM * 4, CB_END = CB_GN + DM * 4;
static_assert(CB_END <= LDS_FREE, "combine LDS");
__device__ __forceinline__ void fp8x16_acc(f32x4 (&acc)[4], const u32x4 y) {
    const unsigned w[4] = {y.x, y.y, y.z, y.w};
#pragma unroll
    for (int i = 0; i < 4; ++i) { const f32x2 lo = __builtin_amdgcn_cvt_pk_f32_fp8((int)w[i], false), hi = __builtin_amdgcn_cvt_pk_f32_fp8((int)w[i], true); acc[i] += (f32x4){lo.x, lo.y, hi.x, hi.y}; }
}
__device__ __forceinline__ void cb_tables(int l, const Args& a, LAS unsigned char* lds, int t, int nt) {
    const float* mods_l = (const float*)(a.ws + WS_MODS) + (size_t)l * 9 * NMOD; const bool more = l < DEPTH - 1;
    LAS float* Lg2 = (LAS float*)(lds + CB_G2); LAS float* Lsh = (LAS float*)(lds + CB_SH); LAS float* Lsc = (LAS float*)(lds + CB_SC); LAS float* Lgn = (LAS float*)(lds + CB_GN);
    for (int i = t; i < 9 * DM; i += nt) { const int r = i >> 10, k = i & 1023;
        Lg2[i] = mods_l[(size_t)r * NMOD + 5 * DM + k] * YR_INV;
        if (more) { Lsh[i] = mods_l[(size_t)(9 + r) * NMOD + k]; Lsc[i] = mods_l[(size_t)(9 + r) * NMOD + DM + k] + 1.f; } }
    for (int i = t; i < DM; i += nt) Lgn[i] = more ? a.in[I_NMIX][(l + 1) * DM + i] : a.in[I_FN][i];
}
template <bool PRE>
__device__ __forceinline__ void ph_combine(int l, int ntok, const Args& a, LAS unsigned char* lds, int gw, int NGW, int tid) {
    const int lane = tid & 63;
    unsigned char* ws = a.ws;
    const bf16_t* XA = (const bf16_t*)(ws + WS_XA); bf16_t* XB = (bf16_t*)(ws + WS_XB); const unsigned char* YR = (const unsigned char*)(ws + WS_YR);
    const int* tokpos = (const int*)(ws + WS_TOKPOS);
    const float* mods_l = (const float*)(ws + WS_MODS) + (size_t)l * 9 * NMOD;
    const bool more = l < DEPTH - 1;
    LAS float* Lg2 = (LAS float*)(lds + CB_G2); LAS float* Lsh = (LAS float*)(lds + CB_SH); LAS float* Lsc = (LAS float*)(lds + CB_SC); LAS float* Lgn = (LAS float*)(lds + CB_GN);
    if (!PRE) cb_tables(l, a, lds, tid, NTHR);
    __syncthreads();
    bf16_t* HA = (bf16_t*)(ws + WS_HA); unsigned char* HA8 = ws + WS_HA8;
    const int k0 = 16 * lane;
    for (int t0 = gw * 2; t0 < ntok; t0 += NGW * 2) {
        u32x4 y[2][4], xr[2][2];
#pragma unroll
        for (int r = 0; r < 2; ++r) { const int t = t0 + r; const int4 pp = *(const int4*)(tokpos + (size_t)t * 4);
            y[r][0] = *(const u32x4*)(YR + (size_t)pp.x * DM + k0); y[r][1] = *(const u32x4*)(YR + (size_t)pp.y * DM + k0);
            y[r][2] = *(const u32x4*)(YR + (size_t)pp.z * DM + k0); y[r][3] = *(const u32x4*)(YR + (size_t)pp.w * DM + k0);
            xr[r][0] = *(const u32x4*)(XA + (size_t)t * DM + k0); xr[r][1] = *(const u32x4*)(XA + (size_t)t * DM + k0 + 8); }
#pragma unroll
        for (int r = 0; r < 2; ++r) { const int t = t0 + r, bi = tok_bidx(t);
            int kt = k0; asm volatile("" : "+v"(kt));
            f32x4 ff[4] = {{0.f, 0.f, 0.f, 0.f}, {0.f, 0.f, 0.f, 0.f}, {0.f, 0.f, 0.f, 0.f}, {0.f, 0.f, 0.f, 0.f}};
            fp8x16_acc(ff, y[r][0]); fp8x16_acc(ff, y[r][1]); fp8x16_acc(ff, y[r][2]); fp8x16_acc(ff, y[r][3]);
            const unsigned xw[8] = {xr[r][0].x, xr[r][0].y, xr[r][0].z, xr[r][0].w, xr[r][1].x, xr[r][1].y, xr[r][1].z, xr[r][1].w};
            f32x4 v[4]; float ss = 0.f;
#pragma unroll
            for (int j = 0; j < 4; ++j) { const f32x4 xv = {bflo(xw[2 * j]), bfhi(xw[2 * j]), bflo(xw[2 * j + 1]), bfhi(xw[2 * j + 1])};
                v[j] = xv + *(const LAS f32x4*)(Lg2 + bi * DM + kt + 4 * j) * ff[j];
                ss += v[j].x * v[j].x + v[j].y * v[j].y + v[j].z * v[j].z + v[j].w * v[j].w; }
            const float rstd = rsqrtf(wave_sum(ss) * (1.f / DM) + EPS);
            if (more) {
                u32x4 xo[2], ho[2]; unsigned h8[4];
#pragma unroll
                for (int j = 0; j < 4; ++j) { const f32x4 y2 = (v[j] * rstd * *(const LAS f32x4*)(Lgn + kt + 4 * j)) * *(const LAS f32x4*)(Lsc + bi * DM + kt + 4 * j) + *(const LAS f32x4*)(Lsh + bi * DM + kt + 4 * j);
                    xo[j >> 1][(j & 1) * 2] = pk2(v[j].x, v[j].y); xo[j >> 1][(j & 1) * 2 + 1] = pk2(v[j].z, v[j].w);
                    ho[j >> 1][(j & 1) * 2] = pk2(y2.x, y2.y); ho[j >> 1][(j & 1) * 2 + 1] = pk2(y2.z, y2.w); h8[j] = pg8::cvt4_fp8(y2.x, y2.y, y2.z, y2.w); }
                *(u32x4*)(XB + (size_t)t * DM + k0) = xo[0]; *(u32x4*)(XB + (size_t)t * DM + k0 + 8) = xo[1];
                *(u32x4*)(HA + (size_t)t * DM + k0) = ho[0]; *(u32x4*)(HA + (size_t)t * DM + k0 + 8) = ho[1];
                *(u32x4*)(HA8 + (size_t)t * DM + k0) = (u32x4){h8[0], h8[1], h8[2], h8[3]};
            } else {
#pragma unroll
                for (int j = 0; j < 4; ++j) *(f32x4*)(a.out + (size_t)t * DM + k0 + 4 * j) = v[j] * rstd * *(const LAS f32x4*)(Lgn + kt + 4 * j);
            } }
    }
    __syncthreads();
}

constexpr int PH_PER_LAYER = 10, N_PHASES = 1 + DEPTH * PH_PER_LAYER;
#if MK_ONE_LAUNCH
#define GRID_BAR() do { XcdBarrier b_ = bar; asm volatile("" : "+s"(b_.bar), "+s"(b_.x)); xcd_barrier(b_, [](int, int) {}); } while (0)
#define GRID_BAR_W(...) do { XcdBarrier b_ = bar; asm volatile("" : "+s"(b_.bar), "+s"(b_.x)); xcd_barrier(b_, [&](int t_, int nt_) { __VA_ARGS__; }); } while (0)
#define GRID_BAR_P(k) do { if constexpr (p0_slot(k) >= 0) GRID_BAR_W((void)nt_; p0_slot_items(load_args(), lds, wg, p0_slot(k), t_)); else GRID_BAR(); } while (0)
#else
#define GRID_BAR() do {} while (0)
#define GRID_BAR_W(...) do {} while (0)
#define GRID_BAR_P(k) do {} while (0)
#endif
#define IN(k) (lo <= (k) && (k) < hi)
#define BOTH(k) (IN(k) && IN((k) + 1))
#define REPEAT(R) _Pragma("unroll") for (int rp_ = 0; rp_ < (R); ++rp_)
#define GWAVE() (wg * NWAVES + wv)
#define ptid() ptid_w(wv)
template <int LAYER>
__device__ __forceinline__ void layer_phases(LAS unsigned char* lds, unsigned char* lds_raw, const XcdBarrier& bar, int lo, int hi, int wg, int G, int wv) {
        constexpr int l = LAYER, pb = 1 + PH_PER_LAYER * l;
        constexpr bool last = (l == DEPTH - 1);
        constexpr int ntok_l = last ? NLAT : NTOK;

        if (IN(pb + 0) && l == 0) { REPEAT(REP_NORM1) { const Args a = load_args();
                const float* xlat = (l == 0) ? a.in[I_X] : (const float*)(a.ws + WS_XB);
                const float* xctx = (l == 0) ? a.in[I_CTX] : (const float*)(a.ws + WS_XB) + (size_t)NLAT * DM;
                ph_norm1(xlat, xctx, a.in[I_NMIX] + l * DM, (const float*)(a.ws + WS_MODS) + (size_t)l * 9 * NMOD, (bf16_t*)(a.ws + WS_HA), a.ws + WS_HA8, GWAVE(), G * NWAVES, ptid() & 63); }
            if (BOTH(pb + 0)) GRID_BAR_P(pb + 0); }

        if (IN(pb + 1)) {
            const Args a = load_args();
            REPEAT(REP_GEMM) {
            { pg8::Gemm g{a.ws + WS_HA8, a.ws + WS_WIN8 + (size_t)l * IN_W * DM, DM};
                constexpr int G8 = last ? 256 : 208;
                pg8::SchedSub<4> S; S.G = (G == 256) ? G8 : G; S.c = wg; S.first = 0; S.cfirst = last ? 2 : 0; S.nctx = last ? 2 : 4; S.rev = false;
                pg8::EpiStoreBf16 E{(bf16_t*)(a.ws + WS_U), IN_W, W8_INV};
                if (wg < S.G) pg8::gemm_phase<true>(lds, g, S, E, ptid()); }
            { pg8::Gemm g{a.ws + WS_HA, (const bf16_t*)(a.ws + WS_WIN) + (size_t)l * IN_W * DM, DM * 2};
                pg8::SchedSub<6> S; S.G = G; S.c = wg; S.first = 4; S.cfirst = 4; S.nctx = last ? 0 : 6; S.rev = true;
                pg8::EpiStoreBf16 E{(bf16_t*)(a.ws + WS_U), IN_W, 1.f};
                pg8::gemm_phase<false>(lds, g, S, E, ptid()); }
            }
            if (BOTH(pb + 1)) GRID_BAR_P(pb + 1);
        }

        if (IN(pb + 2)) REPEAT(REP_PREP) {
            const Args a = load_args();
            ph_qkv(l, a, lds, wg, ptid());
            ph_conv_tiles(l, a, lds, wg, ptid());
            const bf16_t* U = (const bf16_t*)(a.ws + WS_U); bf16_t* F2 = (bf16_t*)(a.ws + WS_F2);
            fm_tables(lds, ptid());
            if (!last && wg >= 128) fm12_unit<true>(wg - 128, U, F2, lds, ptid());
            for (int u = wg; u < 2048; u += G) fm12_unit<false>(u, U, F2, lds, ptid());
            __syncthreads();
            if (rp_ + 1 == REP_PREP && BOTH(pb + 2)) GRID_BAR_P(pb + 2);
        }

        if (IN(pb + 3)) REPEAT(REP_ATTN) {
            const Args a = load_args();
            const unsigned char* QB = a.ws + WS_QB; const unsigned char* KB = a.ws + WS_KB; const unsigned char* VT = a.ws + WS_VB; bf16_t* MIX = (bf16_t*)(a.ws + WS_MIX);
            const int x = wg & 7, rk = wg >> 3;
            const int nun = (!last && wg < 32) ? 3 : 2;
            for (int i = 0; i < nun; ++i) {
                int b, h, kvh, seq; size_t trow;
                if (i < 2) { const int set = i * 8 + x; b = set >> 1; kvh = set & 1; h = kvh * 2 + (rk >> 4); trow = (size_t)b * SEQ + (rk & 15) * 256; seq = SKV; }
                else { b = wg >> 2; h = wg & 3; kvh = h >> 1; trow = (size_t)NLAT + b * CTXL; seq = CTXL; }
                att8::attn_body<512, MIX_W>(QB + trow * 512 + h * 128, KB + (size_t)(b * 2 + kvh) * SKV * 128, VT + (size_t)(b * 2 + kvh) * SKV * 128, MIX + trow * MIX_W + h * 128, seq, (char*)lds_raw, ptid()); }
            const bf16_t* F2 = (const bf16_t*)(a.ws + WS_F2);
            fm_tables(lds, ptid());
            if (!last && wg >= 192) fm3_unit<true>(wg - 192, F2, MIX, lds, ptid());
            for (int u = wg; u < 1024; u += G) fm3_unit<false>(u, F2, MIX, lds, ptid());
            if (rp_ + 1 == REP_ATTN && BOTH(pb + 3)) GRID_BAR_P(pb + 3);
        }

        if (IN(pb + 4)) {
            const Args a = load_args();
            pg8::Gemm g{a.ws + WS_MIX, (const bf16_t*)(a.ws + WS_WOUT) + (size_t)l * DM * MIX_W, MIX_W * 2};
            pg8::SchedGrid<4> S; S.G = G; S.c = wg; S.nM = ntok_l / 256;
            const float* gate = (const float*)(a.ws + WS_MODS) + (size_t)l * 9 * NMOD + 2 * DM;
            if (l == 0) { pg8::EpiResidual<false> E{a.in[I_X], a.in[I_CTX], (bf16_t*)(a.ws + WS_XA), gate};
                REPEAT(REP_GEMM) pg8::gemm_phase<false>(lds, g, S, E, ptid());
                if (G == NWG && wg >= 32) { const int t_ = ptid(); p0_items(a, lds, (wg - 32) * NWAVES + (t_ >> 6), (NWG - 32) * NWAVES, P0_ITEMS - P0_DEFER, P0_ITEMS, t_); __syncthreads(); }
                else if (G != NWG) { const int t_ = ptid(); p0_items(a, lds, wg * NWAVES + (t_ >> 6), G * NWAVES, P0_ITEMS - P0_DEFER, P0_ITEMS, t_); __syncthreads(); } }
            else { pg8::EpiResidual<true> E{a.ws + WS_XB, a.ws + WS_XB + (size_t)NLAT * DM * 2, (bf16_t*)(a.ws + WS_XA), gate};
                REPEAT(REP_GEMM) pg8::gemm_phase<false>(lds, g, S, E, ptid()); }
            if (BOTH(pb + 4)) GRID_BAR_W(n2_tables(l, load_args(), lds, t_, nt_));
        }

        if (IN(pb + 5)) { REPEAT(REP_N2) { const Args a = load_args(); ph_norm2<MK_ONE_LAUNCH != 0>(l, ntok_l, a, lds, wg, ptid()); __syncthreads(); } if (BOTH(pb + 5)) GRID_BAR_P(pb + 5); }
        if (IN(pb + 6)) { REPEAT(REP_ROUTE) { const Args a = load_args(); ph_route(ntok_l, a, lds, wg, ptid()); __syncthreads(); } if (BOTH(pb + 6)) GRID_BAR_P(pb + 6); }

        if (IN(pb + 7)) {
            const Args a = load_args();
#if MK_ONE_LAUNCH
            const int nMt = __builtin_amdgcn_readfirstlane(((const LAS int*)(lds + LDS_TAB))[LDS_TAB_NMT]);
#else
            const int nMt = moe_tiles(a.ws, lds, ptid());
#endif
            { const int* rowtok = (const int*)(a.ws + WS_ROWTOK); LAS int* ltok = (LAS int*)(lds + LDS_LTOK); const int t_ = ptid();
                const int nun = (nMt * 8 - wg + G - 1) / G;
                for (int idx = t_; idx < nun * 256; idx += NTHR) { int pm, pn; pg8::tile_order<8>((idx >> 8) * G + wg, nMt, pm, pn); ltok[idx] = rowtok[pm * 256 + (idx & 255)]; }
                __syncthreads(); }
            pg8::Gemm g{a.ws + WS_H8, a.ws + WS_WUP + (size_t)l * NE * 2048 * DM, DM};
            pg8::SchedMoe<8, true> S{G, wg, nMt, (const LAS int*)(lds + LDS_TAB), (const LAS int*)(lds + LDS_LTOK)};
            pg8::EpiSwiGLU E{(unsigned char*)(a.ws + WS_ACT), a.in[I_BUP] + (size_t)l * NE * 2048};
            REPEAT(REP_MOE) pg8::gemm_phase<true>(lds, g, S, E, ptid());
            if (BOTH(pb + 7)) GRID_BAR_P(pb + 7);
        }
        if (IN(pb + 8)) {
            const Args a = load_args();
#if MK_ONE_LAUNCH
            const int nMt = __builtin_amdgcn_readfirstlane(((const LAS int*)(lds + LDS_TAB))[LDS_TAB_NMT]);
#else
            const int nMt = moe_tiles(a.ws, lds, ptid());
#endif
            pg8::Gemm g{a.ws + WS_ACT, a.ws + WS_WDN + (size_t)l * NE * DM * DFF, DFF};
            pg8::SchedMoe<4, false> S{G, wg, nMt, (const LAS int*)(lds + LDS_TAB), nullptr};
            pg8::EpiDown E{(unsigned char*)(a.ws + WS_YR), a.in[I_BDN] + (size_t)l * NE * DM, (const float*)(a.ws + WS_ROWW)};
            REPEAT(REP_MOE) pg8::gemm_phase<true>(lds, g, S, E, ptid());
            if (BOTH(pb + 8)) GRID_BAR_W(cb_tables(l, load_args(), lds, t_, nt_));
        }
        if (IN(pb + 9)) { REPEAT(REP_COMB) { const Args a = load_args(); ph_combine<MK_ONE_LAUNCH != 0>(l, ntok_l, a, lds, GWAVE(), G * NWAVES, ptid()); } if (BOTH(pb + 9)) GRID_BAR_P(pb + 9); }
}

__global__ void __launch_bounds__(NTHR, 2) mk_fwd(Args a_kernarg) {
    extern __shared__ __attribute__((aligned(16))) unsigned char lds_raw[];
    LAS unsigned char* lds = (LAS unsigned char*)lds_raw;
    const int wg = blockIdx.x, G = gridDim.x, wv = __builtin_amdgcn_readfirstlane(threadIdx.x >> 6);
    volatile LAS unsigned* lctl = (volatile LAS unsigned*)(lds + LDS_CTL);
    if (threadIdx.x < 64) lctl[threadIdx.x] = 0u;
    __syncthreads();
#if MK_ONE_LAUNCH
    XcdBarrier bar = xcd_barrier_post((unsigned*)(a_kernarg.ws + WS_CTL) + 4096, lctl);
#else
    XcdBarrier bar; bar.bar = nullptr; bar.x = 0; bar.st = nullptr;
#endif
    const int lo = a_kernarg.ph_lo, hi = a_kernarg.ph_hi;
    if (IN(0)) { REPEAT(REP_P0) { const Args a = load_args(); p0_prologue(a, lds, wg, ptid()); __syncthreads(); } if (BOTH(0)) GRID_BAR_P(0); }

    layer_phases<0>(lds, lds_raw, bar, lo, hi, wg, G, wv);
    layer_phases<1>(lds, lds_raw, bar, lo, hi, wg, G, wv);
}

extern "C" void kernel_launch(void* const* d_in, const int* in_sizes, int n_in, void* d_out, int out_size, void* d_ws, size_t ws_size, hipStream_t stream) {
    static int ok = 0;
    if (ok == 0) {
        if (n_in != 24 || in_sizes[0] != NLAT * DM || out_size != NLAT * DM || ws_size < WS_END) {
            fprintf(stderr, "kernel_launch: shape mismatch (n_in %d, in0 %d, out %d, ws %zu; need ws >= %zu)\n", n_in, n_in > 0 ? in_sizes[0] : -1, out_size, ws_size, (size_t)WS_END); ok = -1; return; }
        if (hipFuncSetAttribute((const void*)mk_fwd, hipFuncAttributeMaxDynamicSharedMemorySize, LDS_BYTES) != hipSuccess) { fprintf(stderr, "kernel_launch: hipFuncSetAttribute failed\n"); ok = -1; return; }
        int per_cu = 0;
        if (hipOccupancyMaxActiveBlocksPerMultiprocessor(&per_cu, (const void*)mk_fwd, NTHR, LDS_BYTES) != hipSuccess || per_cu < 1)
            fprintf(stderr, "kernel_launch: note: occupancy query reports %d workgroups per CU\n", per_cu);
        (void)hipGetLastError();
        ok = 1;
    }
    if (ok < 0) return;
    if (hipMemsetAsync((char*)d_ws + WS_CTL, 0, CTL_ZERO_BYTES, stream) != hipSuccess) { fprintf(stderr, "kernel_launch: memset failed\n"); return; }
    Args a{};
    for (int i = 0; i < 24; ++i) a.in[i] = (const float*)d_in[i];
    a.out = (float*)d_out; a.ws = (unsigned char*)d_ws;
#if MK_ONE_LAUNCH
    a.ph_lo = 0; a.ph_hi = N_PHASES;
    hipLaunchKernelGGL(mk_fwd, dim3(NWG), dim3(NTHR), LDS_BYTES, stream, a);
#else
    for (int p = 0; p < N_PHASES; ++p) { a.ph_lo = p; a.ph_hi = p + 1; hipLaunchKernelGGL(mk_fwd, dim3(NWG), dim3(NTHR), LDS_BYTES, stream, a); }
#endif
    const hipError_t le = hipPeekAtLastError();
    if (le != hipSuccess) fprintf(stderr, "kernel_launch: launch failed: %s\n", hipGetErrorName(le));
}
```

```cpp
#include <hip/hip_runtime.h>
#include <cstdio>
#include <cstdint>

#ifndef MK_ONE_LAUNCH
#define MK_ONE_LAUNCH 1
#endif

#ifndef REP_P0
#define REP_P0 1
#endif
#ifndef REP_NORM1
#define REP_NORM1 1
#endif
#ifndef REP_PREP
#define REP_PREP 1
#endif
#ifndef REP_N2
#define REP_N2 1
#endif
#ifndef REP_ROUTE
#define REP_ROUTE 1
#endif
#ifndef REP_COMB
#define REP_COMB 1
#endif
#ifndef REP_GEMM
#define REP_GEMM 1
#endif
#ifndef REP_ATTN
#define REP_ATTN 1
#endif
#ifndef REP_MOE
#define REP_MOE 1
#endif
#define LAS __attribute__((address_space(3)))
#define GAS __attribute__((address_space(1)))
typedef unsigned short bf16_t;
typedef short bf16x8 __attribute__((ext_vector_type(8)));
typedef short s16x4 __attribute__((ext_vector_type(4)));
typedef float f32x2 __attribute__((ext_vector_type(2)));
typedef float f32x4 __attribute__((ext_vector_type(4)));
typedef float f32x8 __attribute__((ext_vector_type(8)));
typedef float f32x16 __attribute__((ext_vector_type(16)));
typedef unsigned u32x2 __attribute__((ext_vector_type(2)));
typedef unsigned u32x4 __attribute__((ext_vector_type(4)));

constexpr int DM = 1024, BATCH = 8, SEQ = 4096, CTXL = 256, DEPTH = 2;
constexpr int NLAT = BATCH * SEQ, NCTX = BATCH * CTXL, NTOK = NLAT + NCTX;
constexpr int IN_W = 2560, MIX_W = 1280, NE = 32, TOPK = 4, DFF = 1024;
constexpr int SKV = CTXL + SEQ;
constexpr int NMOD = 6 * DM;
constexpr int MPAD = (NTOK * TOPK / 256 + NE) * 256;
constexpr float EPS = 1e-6f;
constexpr int NWG = 256, NTHR = 512, NWAVES = 8;

constexpr size_t MiB = 1u << 20;
constexpr size_t WS_CTL = 0, CTL_ZERO_BYTES = 1 * MiB;
constexpr size_t WS_MODS = 1 * MiB;
constexpr size_t WS_CNT = 2 * MiB;
constexpr size_t WS_EOFF = WS_CNT + 64 * 1024;
constexpr size_t WS_TOKE = 3 * MiB;
constexpr size_t WS_TOKP = 4 * MiB;
constexpr size_t WS_TOKPOS = 5 * MiB;
constexpr size_t WS_ROWW = 6 * MiB;
constexpr size_t WS_ROWTOK = 7 * MiB;
constexpr size_t WS_WIN = 8 * MiB;
constexpr size_t WS_WOUT = 18 * MiB;
constexpr size_t WS_WUP = 24 * MiB;
constexpr size_t WS_WDN = 152 * MiB;
constexpr size_t WS_H8 = 216 * MiB;
constexpr size_t WS_HA8 = 252 * MiB;
constexpr size_t WS_WIN8 = 288 * MiB;
constexpr size_t WS_HA = 408 * MiB;
constexpr size_t WS_XA = 476 * MiB;
constexpr size_t WS_XB = 612 * MiB;
constexpr size_t WS_S = 748 * MiB;
constexpr size_t WS_U = WS_S;
constexpr size_t WS_QB = WS_S + 170 * MiB;
constexpr size_t WS_KB = WS_S + 204 * MiB;
constexpr size_t WS_VB = WS_S + 221 * MiB;
constexpr size_t WS_MIX = WS_S + 238 * MiB;
constexpr size_t WS_F2 = WS_S + 323 * MiB;
constexpr int CAPV_LOG = 16;
constexpr size_t WS_ROWTOKV = WS_S + 323 * MiB;
constexpr size_t WS_ROWWV = WS_S + 331 * MiB;
constexpr size_t WS_TOTAL = 8192;
constexpr size_t WS_ACT = WS_S + 360 * MiB;
constexpr size_t WS_YR = WS_S;
constexpr size_t WS_END = WS_S + 648 * MiB;
static_assert(WS_F2 + (size_t)NTOK * 512 * 2 <= WS_ACT && WS_YR + (size_t)MPAD * 1024 * 2 <= WS_ACT && WS_H8 + (size_t)NTOK * 1024 <= WS_HA && WS_WDN + 2ull * 32 * 1024 * 1024 <= WS_H8, "ws map");
constexpr float YR_SCALE = 16.f, YR_INV = 1.f / 16.f;
constexpr float W8_SCALE = 64.f, W8_INV = 1.f / 64.f;

constexpr int LDS_BYTES = 163840;
constexpr int LDS_LTOK = 131072;
constexpr int LDS_TAB = 159744;
constexpr int LDS_TAB_NMT = 700;
constexpr int LDS_TAB_TF = 704, LDS_TAB_TOT = 736;
constexpr int LDS_CTL = 163584;
constexpr int LDS_FREE = 159744;

typedef float f32x2_t_ __attribute__((ext_vector_type(2)));
typedef __bf16 bf16x2_t_ __attribute__((ext_vector_type(2)));
__device__ __forceinline__ unsigned f2bf(float f) { const __bf16 b = (__bf16)f; return (unsigned)__builtin_bit_cast(unsigned short, b); }
__device__ __forceinline__ unsigned pk2(float lo, float hi) { const f32x2_t_ v = {lo, hi}; const bf16x2_t_ b = __builtin_convertvector(v, bf16x2_t_); return __builtin_bit_cast(unsigned, b); }
__device__ __forceinline__ float bf2f(unsigned h) { return __builtin_bit_cast(float, h << 16); }
__device__ __forceinline__ float bflo(unsigned w) { return __builtin_bit_cast(float, w << 16); }
__device__ __forceinline__ float bfhi(unsigned w) { return __builtin_bit_cast(float, w & 0xffff0000u); }
template <int M> __device__ __forceinline__ float xor_swz(float v) { return __builtin_bit_cast(float, __builtin_amdgcn_ds_swizzle(__builtin_bit_cast(int, v), (M << 10) | 0x1f)); }
__device__ __forceinline__ float xor32(float v, bool upper) { auto r = __builtin_amdgcn_permlane32_swap(__float_as_uint(v), __float_as_uint(v), false, false); return __uint_as_float(upper ? r[0] : r[1]); }
__device__ __forceinline__ float wave_sum(float v) {
    v += xor_swz<1>(v); v += xor_swz<2>(v); v += xor_swz<4>(v); v += xor_swz<8>(v); v += xor_swz<16>(v);
    auto r = __builtin_amdgcn_permlane32_swap(__float_as_uint(v), __float_as_uint(v), false, false);
    return __uint_as_float(r[0]) + __uint_as_float(r[1]);
}
__device__ __forceinline__ float sigmoidf_(float x) { return __builtin_amdgcn_rcpf(1.f + __builtin_amdgcn_exp2f(x * -1.4426950408889634f)); }
__device__ __forceinline__ void sincos_rev(float rev, float& sn, float& cs) { const float fr = __builtin_amdgcn_fractf(rev); sn = __builtin_amdgcn_sinf(fr); cs = __builtin_amdgcn_cosf(fr); }
__device__ __forceinline__ int tok_bidx(int t) { return t < NLAT ? (t >> 12) : 8; }
#define LDS_WAIT() asm volatile("s_waitcnt lgkmcnt(0)" ::: "memory")

__device__ __forceinline__ int ptid_w(int wv) { unsigned m = ~0u; asm volatile("" : "+s"(m)); int l = (int)__builtin_amdgcn_mbcnt_hi(m, __builtin_amdgcn_mbcnt_lo(m, 0u)); asm volatile("" : "+v"(l)); return (wv << 6) | l; }

namespace pg8 {
#define PG8_LAS __attribute__((address_space(3)))
constexpr int BM = 256, BK = 64, HALF = 128, HTB = HALF * BK * 2, STAGE_BYTES = 8 * HTB;
constexpr int PRE_OFF = 149504;
__host__ __device__ __forceinline__ int lds_byte(int r, int c) { const int st = (r >> 4) * 2 + (c >> 5), rr = r & 15, cc = c & 31, ob = rr * 64 + cc * 2; return st * 1024 + (ob ^ (((ob >> 9) & 1) << 5)); }
__host__ __device__ __forceinline__ void stage_rc(int b, int& R, int& C) { const int st = b / 1024, sb = b % 1024, swz = sb ^ (((sb >> 9) & 1) << 5); R = (st >> 1) * 16 + swz / 64; C = (st & 1) * 32 + (swz % 64) / 2; }
__host__ __device__ __forceinline__ int perm32(int rho) { const int n = rho >> 4, i = rho & 15; return 8 * (i >> 2) + 4 * n + (i & 3); }
__host__ __device__ __forceinline__ int perm64(int R) { return (R >> 5) * 64 + ((R >> 2) & 3) * 16 + ((R >> 4) & 1) * 4 + (R & 3); }
struct Unit { int pm, pn; };
struct Gemm { const void* A; const void* Bt; int Kb; };
__device__ __forceinline__ unsigned cvt_pk_bf16(float lo, float hi) { unsigned r; asm("v_cvt_pk_bf16_f32 %0, %1, %2" : "=v"(r) : "v"(lo), "v"(hi)); return r; }
typedef int v8i __attribute__((ext_vector_type(8)));
typedef int v4i __attribute__((ext_vector_type(4)));
__device__ __forceinline__ v8i cat8(bf16x8 a, bf16x8 b) { const v4i x = __builtin_bit_cast(v4i, a), y = __builtin_bit_cast(v4i, b); return (v8i){x[0], x[1], x[2], x[3], y[0], y[1], y[2], y[3]}; }
__device__ __forceinline__ unsigned cvt4_fp8(float a, float b, float c, float d) { int r = 0; r = __builtin_amdgcn_cvt_pk_fp8_f32(a, b, r, false); r = __builtin_amdgcn_cvt_pk_fp8_f32(c, d, r, true); return (unsigned)r; }

template <int nN>
__device__ __forceinline__ void tile_order(int L, int nM, int& pm, int& pn) {
    const int nwg = nM * nN; int wgid = L;
    { const int q = nwg >> 3, r = nwg & 7, xcd = wgid & 7, off = wgid >> 3; wgid = (xcd < r ? xcd * (q + 1) : r * (q + 1) + (xcd - r) * q) + off; }
    constexpr int nig = 8 * nN; const int gid = wgid / nig, fm = gid * 8, gsz = (nM - fm) < 8 ? (nM - fm) : 8, rem = wgid - gid * nig;
    if (gsz == 8) { pm = fm + (rem & 7); pn = rem >> 3; } else { pn = rem / gsz; pm = fm + (rem - pn * gsz); }
}

template <bool FP8, class Epi, class Sched>
__device__ __forceinline__ void gemm_phase(PG8_LAS unsigned char* lds, const Gemm g, const Sched& S, const Epi& E, const int tid) {
    const int wid = __builtin_amdgcn_readfirstlane(tid >> 6), lane = tid & 63, wr = wid >> 2, wc = wid & 3, fr = lane & 15, fq = lane >> 4;
    const int Kb = g.Kb, nt = Kb / (BK * 2);
    constexpr bool GATHER = Sched::GATHER;
    unsigned voffA[2], voffB[2]; int rcA[2];
#pragma unroll
    for (int i = 0; i < 2; ++i) { int R, C; stage_rc(tid * 16 + i * 8192, R, C); const int Rb = Epi::PERM == 2 ? perm64(R) : Epi::PERM ? ((R & ~31) + perm32(R & 31)) : R;
        voffA[i] = (unsigned)(R * Kb + C * 2); voffB[i] = (unsigned)(Rb * Kb + C * 2); rcA[i] = (R << 8) | (C * 2); }
    unsigned gc[2][2];
#define PG8_GOFF(uidx) do { if constexpr (GATHER) { _Pragma("unroll") for (int h_ = 0; h_ < 2; ++h_) _Pragma("unroll") for (int i_ = 0; i_ < 2; ++i_) \
        gc[h_][i_] = (unsigned)S.ltok[(uidx) * 256 + h_ * 128 + (rcA[i_] >> 8)] * (unsigned)Kb + (unsigned)(rcA[i_] & 255); } } while (0)
#define PG8_STAGE_A(bufoff, kptr, half) do { if constexpr (GATHER) PG8_STAGE(bufoff, kptr, gc[half]); else PG8_STAGE(bufoff, (kptr) + (half) * hstep, voffA); } while (0)
    const size_t kstep = (size_t)(BK * 2);
    const size_t hstep = (size_t)HALF * Kb;
    const size_t tstep = 2 * hstep;
    const size_t hstepB = Epi::PERM == 2 ? (size_t)8 * Kb : hstep;
    const unsigned ldsw = (unsigned)wid * 1024u;
    const int aoff = lds_byte(wr * 64 + fr, fq * 8), boff = lds_byte(wc * 32 + fr, fq * 8);
#define PG8_SA(b, h) (((b) * 2 + (h)) * HTB)
#define PG8_SB(b, h) ((4 + (b) * 2 + (h)) * HTB)
#define PG8_STAGE(bufoff, gbase, voff) do { _Pragma("unroll") for (int _i = 0; _i < 2; ++_i) { unsigned _vo = (voff)[_i]; asm volatile("" : "+v"(_vo));   \
        __builtin_amdgcn_global_load_lds((const unsigned*)((const char*)(gbase) + _vo), (PG8_LAS unsigned*)(lds + (bufoff) + ldsw + _i * 8192), 16, 0, 0); } } while (0)
#define PG8_LDA(dst, b, h) do { _Pragma("unroll") for (int m = 0; m < 4; ++m) _Pragma("unroll") for (int k = 0; k < 2; ++k) dst[m][k] = *(const PG8_LAS bf16x8*)(lds + PG8_SA(b, h) + aoff + m * 2048 + k * 1024); } while (0)
#define PG8_LDB(dst, b, h) do { _Pragma("unroll") for (int n = 0; n < 2; ++n) _Pragma("unroll") for (int k = 0; k < 2; ++k) dst[n][k] = *(const PG8_LAS bf16x8*)(lds + PG8_SB(b, h) + boff + n * 2048 + k * 1024); } while (0)
#define PG8_MMA(ai, bj, At, Bt) do { __builtin_amdgcn_s_setprio(1); _Pragma("unroll") for (int m = 0; m < 4; ++m) _Pragma("unroll") for (int n = 0; n < 2; ++n) { \
        if constexpr (FP8) acc[ai][bj][m][n] = __builtin_amdgcn_mfma_scale_f32_16x16x128_f8f6f4(cat8(Bt[n][0], Bt[n][1]), cat8(At[m][0], At[m][1]), acc[ai][bj][m][n], 0, 0, 0, 0, 0, 0); \
        else { _Pragma("unroll") for (int k = 0; k < 2; ++k) acc[ai][bj][m][n] = __builtin_amdgcn_mfma_f32_16x16x32_bf16(Bt[n][k], At[m][k], acc[ai][bj][m][n], 0, 0, 0); } } \
        __builtin_amdgcn_s_setprio(0); } while (0)
#define PG8_WAIT_V(n) asm volatile("s_waitcnt vmcnt(" #n ")" ::: "memory")
#define PG8_WAIT_L(n) asm volatile("s_waitcnt lgkmcnt(" #n ")" ::: "memory")
#define PG8_BAR __builtin_amdgcn_s_barrier()
#define PG8_SCHED __builtin_amdgcn_sched_barrier(0)
    Unit cur, nxt; int ui = 0;
    if (!S.next(0, cur)) return;
    f32x4 acc[2][2][4][2];
#pragma unroll
    for (int a = 0; a < 2; ++a)
#pragma unroll
        for (int b = 0; b < 2; ++b)
#pragma unroll
            for (int m = 0; m < 4; ++m)
#pragma unroll
                for (int n = 0; n < 2; ++n) acc[a][b][m][n] = (f32x4){0.f, 0.f, 0.f, 0.f};
    bf16x8 At[4][2], B0[2][2], B1[2][2];
    const char* cA = (const char*)g.A + (GATHER ? (size_t)0 : (size_t)cur.pm * tstep); const char* cB = (const char*)g.Bt + (size_t)cur.pn * tstep;
    PG8_GOFF(0);
    PG8_STAGE(PG8_SB(0, 0), cB, voffB); PG8_STAGE(PG8_SB(0, 1), cB + hstepB, voffB); PG8_STAGE_A(PG8_SA(0, 0), cA, 0); PG8_STAGE_A(PG8_SA(0, 1), cA, 1);
    if (wr == 1) PG8_BAR;
    PG8_WAIT_V(2); PG8_BAR;
    PG8_STAGE(PG8_SB(1, 0), cB + kstep, voffB); PG8_STAGE_A(PG8_SA(1, 0), cA + kstep, 0); PG8_STAGE(PG8_SB(1, 1), cB + hstepB + kstep, voffB);
    PG8_WAIT_V(6); PG8_BAR;
    for (;;) {
        const bool has_next = S.next(ui + 1, nxt);
        const char* nA = (has_next && !GATHER) ? (const char*)g.A + (size_t)nxt.pm * tstep : cA; const char* nB = has_next ? (const char*)g.Bt + (size_t)nxt.pn * tstep : cB;
        if constexpr (Epi::PRE > 0) {
            if (wid < Epi::PRE) { unsigned lo_ = (unsigned)(ptid_w(wid) & 63) * 16u; asm volatile("" : "+v"(lo_));
                __builtin_amdgcn_global_load_lds((const unsigned*)((const char*)E.pre_src(cur, wid) + lo_), (PG8_LAS unsigned*)(lds + PRE_OFF + (ui & 1) * 2048 + wid * 1024), 16, 0, 0); } }
        for (int t = 0; t < nt; t += 2) {
            const bool last = (t == nt - 2);
            const char* a1 = cA + (size_t)(t + 1) * kstep;
            const char* a2 = last ? nA : cA + (size_t)(t + 2) * kstep; const char* b2 = last ? nB : cB + (size_t)(t + 2) * kstep;
            const char* a3 = a2 + kstep; const char* b3 = b2 + kstep;
            PG8_LDB(B0, 0, 0); PG8_LDB(B1, 0, 1); PG8_SCHED; PG8_LDA(At, 0, 0); PG8_STAGE_A(PG8_SA(1, 1), a1, 1); if (last && has_next) PG8_GOFF(ui + 1);
            PG8_WAIT_V(8); PG8_WAIT_L(0); PG8_BAR; PG8_MMA(0, 0, At, B0); PG8_MMA(0, 1, At, B1); PG8_BAR; PG8_SCHED;
            PG8_LDA(At, 0, 1); PG8_STAGE(PG8_SB(0, 0), b2, voffB); PG8_STAGE(PG8_SB(0, 1), b2 + hstepB, voffB); PG8_STAGE_A(PG8_SA(0, 0), a2, 0);
            PG8_WAIT_V(8); PG8_WAIT_L(0); PG8_BAR; PG8_MMA(1, 0, At, B0); PG8_MMA(1, 1, At, B1); PG8_BAR; PG8_SCHED;
            PG8_LDB(B0, 1, 0); PG8_LDB(B1, 1, 1); PG8_SCHED; PG8_LDA(At, 1, 0); PG8_STAGE_A(PG8_SA(0, 1), a2, 1);
            PG8_WAIT_V(8); PG8_WAIT_L(0); PG8_BAR; PG8_MMA(0, 0, At, B0); PG8_MMA(0, 1, At, B1); PG8_BAR; PG8_SCHED;
            PG8_LDA(At, 1, 1); PG8_STAGE(PG8_SB(1, 0), b3, voffB); PG8_STAGE(PG8_SB(1, 1), b3 + hstepB, voffB); PG8_STAGE_A(PG8_SA(1, 0), a3, 0);
            PG8_WAIT_V(8); PG8_WAIT_L(0); PG8_BAR; PG8_MMA(1, 0, At, B0); PG8_MMA(1, 1, At, B1); PG8_BAR; PG8_SCHED;
        }
        if (wr == 0) PG8_BAR;
        { const int l2 = ptid_w(wid) & 63;
            if constexpr (Epi::PRE > 0) E(acc, cur, wr, wc, l2 & 15, l2 >> 4, (const PG8_LAS float*)(lds + PRE_OFF + (ui & 1) * 2048)); else E(acc, cur, wr, wc, l2 & 15, l2 >> 4); }
        if (!has_next) break;
#pragma unroll
        for (int a = 0; a < 2; ++a)
#pragma unroll
            for (int b = 0; b < 2; ++b)
#pragma unroll
                for (int m = 0; m < 4; ++m)
#pragma unroll
                    for (int n = 0; n < 2; ++n) acc[a][b][m][n] = (f32x4){0.f, 0.f, 0.f, 0.f};
        cur = nxt; cA = nA; cB = nB; ++ui;
        if (wr == 1) PG8_BAR;
    }
    PG8_WAIT_V(0);
    PG8_BAR;
#undef PG8_SA
#undef PG8_SB
#undef PG8_STAGE
#undef PG8_STAGE_A
#undef PG8_GOFF
#undef PG8_LDA
#undef PG8_LDB
#undef PG8_MMA
#undef PG8_WAIT_V
#undef PG8_WAIT_L
#undef PG8_BAR
#undef PG8_SCHED
}

struct EpiStoreBf16 {
    static constexpr int PERM = 2, PRE = 0;
    bf16_t* O; int ldc; float sc;
    __device__ __forceinline__ void operator()(const f32x4 (&acc)[2][2][4][2], const Unit& u, int wr, int wc, int fr, int fq) const {
        const int row0 = u.pm * BM + wr * 64 + fr, col0 = u.pn * BM + wc * 64 + 16 * fq;
#pragma unroll
        for (int ai = 0; ai < 2; ++ai)
#pragma unroll
            for (int m = 0; m < 4; ++m) { bf16_t* rowp = O + (size_t)(row0 + ai * HALF + m * 16) * ldc + col0;
#pragma unroll
                for (int bj = 0; bj < 2; ++bj) { const f32x4 v0 = acc[ai][bj][m][0] * sc, v1 = acc[ai][bj][m][1] * sc;
                    u32x4 w; w.x = cvt_pk_bf16(v0[0], v0[1]); w.y = cvt_pk_bf16(v0[2], v0[3]); w.z = cvt_pk_bf16(v1[0], v1[1]); w.w = cvt_pk_bf16(v1[2], v1[3]);
                    *(u32x4*)(rowp + bj * 8) = w; } }
    }
};
template <bool XBF16>
struct EpiResidual {
    static constexpr int PERM = 2, PRE = 0;
    const void* xlat; const void* xctx; bf16_t* out; const float* gate; float sc;
    __device__ __forceinline__ void operator()(const f32x4 (&acc)[2][2][4][2], const Unit& u, int wr, int wc, int fr, int fq) const {
        const int row0 = u.pm * BM + wr * 64 + fr, col0 = u.pn * BM + wc * 64 + 16 * fq;
        const int bidx = (u.pm < NLAT / 256) ? (u.pm >> 4) : 8;
        const float* gp = gate + (size_t)bidx * NMOD + col0;
        f32x4 gv[2][2];
#pragma unroll
        for (int bj = 0; bj < 2; ++bj)
#pragma unroll
            for (int n = 0; n < 2; ++n) gv[bj][n] = *(const f32x4*)(gp + bj * 8 + 4 * n) * sc;
#pragma unroll
        for (int ai = 0; ai < 2; ++ai) {
            u32x4 xb[4][2]; f32x4 xf[4][2][2];
#pragma unroll
            for (int m = 0; m < 4; ++m) { const int row = row0 + ai * HALF + m * 16;
#pragma unroll
                for (int bj = 0; bj < 2; ++bj) {
                    if constexpr (XBF16) { const bf16_t* xr = (row < NLAT ? (const bf16_t*)xlat + (size_t)row * DM : (const bf16_t*)xctx + (size_t)(row - NLAT) * DM) + col0 + bj * 8; xb[m][bj] = *(const u32x4*)xr; }
                    else { const float* xr = (row < NLAT ? (const float*)xlat + (size_t)row * DM : (const float*)xctx + (size_t)(row - NLAT) * DM) + col0 + bj * 8; xf[m][bj][0] = *(const f32x4*)xr; xf[m][bj][1] = *(const f32x4*)(xr + 4); } } }
            __builtin_amdgcn_sched_barrier(0);
#pragma unroll
            for (int m = 0; m < 4; ++m) { const int row = row0 + ai * HALF + m * 16;
                bf16_t* orow = out + (size_t)row * DM + col0;
#pragma unroll
                for (int bj = 0; bj < 2; ++bj) { f32x4 x0, x1;
                    if constexpr (XBF16) { const u32x4 v = xb[m][bj]; x0 = (f32x4){bflo(v.x), bfhi(v.x), bflo(v.y), bfhi(v.y)}; x1 = (f32x4){bflo(v.z), bfhi(v.z), bflo(v.w), bfhi(v.w)}; }
                    else { x0 = xf[m][bj][0]; x1 = xf[m][bj][1]; }
                    const f32x4 v0 = x0 + gv[bj][0] * acc[ai][bj][m][0], v1 = x1 + gv[bj][1] * acc[ai][bj][m][1];
                    u32x4 w; w.x = cvt_pk_bf16(v0[0], v0[1]); w.y = cvt_pk_bf16(v0[2], v0[3]); w.z = cvt_pk_bf16(v1[0], v1[1]); w.w = cvt_pk_bf16(v1[2], v1[3]);
                    *(u32x4*)(orow + bj * 8) = w; } }
            __builtin_amdgcn_sched_barrier(0); }
    }
};
struct EpiSwiGLU {
    static constexpr int PERM = 1, PRE = 1;
    unsigned char* O; const float* bup;
    __device__ __forceinline__ const float* pre_src(const Unit& u, int) const { return bup + (size_t)(u.pn >> 3) * 2048 + (u.pn & 7) * 256; }
    __device__ __forceinline__ void operator()(const f32x4 (&acc)[2][2][4][2], const Unit& u, int wr, int wc, int fr, int fq, const PG8_LAS float* pre) const {
        const int pnl = u.pn & 7;
        const int row0 = u.pm * BM + wr * 64 + fr, ac0 = pnl * 128 + wc * 32 + 8 * fq;
        const PG8_LAS float* bp = pre + 2 * (wc * 32 + 8 * fq);
        f32x4 bb[4];
#pragma unroll
        for (int q = 0; q < 4; ++q) bb[q] = *(const PG8_LAS f32x4*)(bp + 4 * q);
        f32x2 bg[4], bl[4];
#pragma unroll
        for (int p = 0; p < 4; ++p) { bg[p] = (f32x2){bb[p][0], bb[p][2]}; bl[p] = (f32x2){bb[p][1] + 1.f, bb[p][3] + 1.f}; }
        unsigned char* cbase = O + (size_t)(row0 + (fq & 1) * 16) * DFF + (ac0 - 8 * (fq & 1));
#pragma unroll
        for (int ai = 0; ai < 2; ++ai)
#pragma unroll
            for (int mp = 0; mp < 2; ++mp) { u32x2 wq[2];
#pragma unroll
                for (int mi = 0; mi < 2; ++mi) { const int m = 2 * mp + mi;
                    float r[8];
#pragma unroll
                    for (int p = 0; p < 4; ++p) { const int n = p >> 1, i0 = (p & 1) * 2;
                        f32x2 gt = (f32x2){acc[ai][0][m][n][i0], acc[ai][0][m][n][i0 + 1]} * W8_INV + bg[p];
                        f32x2 ln = (f32x2){acc[ai][1][m][n][i0], acc[ai][1][m][n][i0 + 1]} * W8_INV + bl[p];
                        gt.x = fminf(gt.x, 7.f); gt.y = fminf(gt.y, 7.f);
                        ln.x = __builtin_amdgcn_fmed3f(ln.x, -6.f, 8.f); ln.y = __builtin_amdgcn_fmed3f(ln.y, -6.f, 8.f);
                        const f32x2 ex = gt * (-1.702f * 1.4426950408889634f);
                        f32x2 dn = (f32x2){__builtin_amdgcn_exp2f(ex.x), __builtin_amdgcn_exp2f(ex.y)} + 1.f;
                        dn.x = __builtin_amdgcn_rcpf(dn.x); dn.y = __builtin_amdgcn_rcpf(dn.y);
                        const f32x2 rr = (gt * dn) * ln;
                        r[2 * p] = rr.x; r[2 * p + 1] = rr.y; }
                    wq[mi].x = cvt4_fp8(r[0], r[1], r[2], r[3]); wq[mi].y = cvt4_fp8(r[4], r[5], r[6], r[7]); }
                const auto s0 = __builtin_amdgcn_permlane16_swap(wq[0].x, wq[1].x, false, false), s1 = __builtin_amdgcn_permlane16_swap(wq[0].y, wq[1].y, false, false);
                u32x4 w; w.x = s0[0]; w.y = s1[0]; w.z = s0[1]; w.w = s1[1];
                *(u32x4*)(cbase + (size_t)(ai * HALF + mp * 32) * DFF) = w; }
    }
};
struct EpiDown {
    static constexpr int PERM = 2, PRE = 2;
    unsigned char* O; const float* bdn; const float* roww; const PG8_LAS int* tf;
    __device__ __forceinline__ const float* pre_src(const Unit& u, int piece) const { const int e = u.pn >> 2;
        return piece == 0 ? bdn + (size_t)e * DM + (u.pn & 3) * BM : (tf ? roww + ((size_t)e << CAPV_LOG) + (size_t)(u.pm - tf[e]) * BM : roww + (size_t)u.pm * BM); }
    __device__ __forceinline__ void operator()(const f32x4 (&acc)[2][2][4][2], const Unit& u, int wr, int wc, int fr, int fq, const PG8_LAS float* pre) const {
        const int pnl = u.pn & 3;
        const int row0 = u.pm * BM + wr * 64 + fr, col0 = pnl * BM + wc * 64 + 16 * fq;
        const PG8_LAS float* bp = pre + wc * 64 + 16 * fq;
        f32x4 bv[2][2];
#pragma unroll
        for (int bj = 0; bj < 2; ++bj)
#pragma unroll
            for (int n = 0; n < 2; ++n) bv[bj][n] = *(const PG8_LAS f32x4*)(bp + 8 * bj + 4 * n);
        float rwv[2][4];
#pragma unroll
        for (int ai = 0; ai < 2; ++ai)
#pragma unroll
            for (int m = 0; m < 4; ++m) rwv[ai][m] = pre[256 + wr * 64 + fr + ai * HALF + m * 16] * YR_SCALE;
#pragma unroll
        for (int ai = 0; ai < 2; ++ai)
#pragma unroll
            for (int m = 0; m < 4; ++m) { const int row = row0 + ai * HALF + m * 16; const float w_ = rwv[ai][m];
                const f32x4 v0 = (acc[ai][0][m][0] * W8_INV + bv[0][0]) * w_, v1 = (acc[ai][0][m][1] * W8_INV + bv[0][1]) * w_;
                const f32x4 v2 = (acc[ai][1][m][0] * W8_INV + bv[1][0]) * w_, v3 = (acc[ai][1][m][1] * W8_INV + bv[1][1]) * w_;
                u32x4 w; w.x = cvt4_fp8(v0[0], v0[1], v0[2], v0[3]); w.y = cvt4_fp8(v1[0], v1[1], v1[2], v1[3]); w.z = cvt4_fp8(v2[0], v2[1], v2[2], v2[3]); w.w = cvt4_fp8(v3[0], v3[1], v3[2], v3[3]);
                *(u32x4*)(O + (size_t)row * DM + col0) = w; }
    }
};

template <int NS>
struct SchedSub {
    static constexpr bool GATHER = false; const LAS int* ltok = nullptr;
    int G, c, first, cfirst, nctx; bool rev;
    __device__ __forceinline__ bool next(int i, Unit& u) const {
        const int L = i * G + (rev ? G - 1 - c : c);
        if (L < 128 * NS) { int j; tile_order<NS>(L, 128, u.pm, j); u.pn = first + j; return true; }
        const int r = L - 128 * NS; if (r >= 8 * nctx) return false;
        const int q = (nctx == 2) ? (r >> 1) : (nctx == 4) ? (r >> 2) : (r / 6);
        u.pm = 128 + q; u.pn = cfirst + (r - q * nctx); return true;
    }
};
template <int nN>
struct SchedGrid {
    static constexpr bool GATHER = false; const LAS int* ltok = nullptr;
    int G, c, nM;
    __device__ __forceinline__ bool next(int i, Unit& u) const {
        const int L = i * G + c; if (L >= nM * nN) return false;
        tile_order<nN>(L, nM, u.pm, u.pn); return true;
    }
};
template <int nN, bool GATHER_>
struct SchedMoe {
    static constexpr bool GATHER = GATHER_;
    int G, c, nMt; const LAS int* tile_e; const LAS int* ltok;
    __device__ __forceinline__ bool next(int i, Unit& u) const {
        const int L = i * G + c; if (L >= nMt * nN) return false;
        int pm, pn; tile_order<nN>(L, nMt, pm, pn);
        const int e = __builtin_amdgcn_readfirstlane(tile_e[pm]);
        u.pm = pm; u.pn = e * nN + pn; return true;
    }
};
}

namespace att { __device__ __forceinline__ unsigned cvtpk(float lo, float hi) { unsigned r; asm volatile("v_cvt_pk_bf16_f32 %0, %1, %2" : "=v"(r) : "v"(lo), "v"(hi)); return r; } }
namespace att8 {
typedef int v8i __attribute__((ext_vector_type(8)));
typedef int v4i __attribute__((ext_vector_type(4)));
constexpr int NW = 8, QBLK = 32, KVBLK = 64;
constexpr float SCALE = 0.088388347648318440f;
constexpr float QSC = SCALE * 1.4426950408889634f;
constexpr float THR = 3.f;
constexpr float THR2 = THR * 1.4426950408889634f;
constexpr int NSLOT = 4, SLOT = 8192;
constexpr int OFF_K = 0, OFF_V = NSLOT * SLOT, OFF_WS = 2 * NSLOT * SLOT, OFF_OST = OFF_WS + 2048;
static_assert(OFF_OST + 8 * 8704 <= 163840 - 256, "att8 LDS");
__device__ __forceinline__ int crow(int r, int hi) { return (r & 3) + 8 * (r >> 2) + 4 * hi; }
__host__ __device__ __forceinline__ int kpos(int k) { const int kk = k & 31, up = k >> 5, hi = (kk >> 2) & 1, r = (kk & 3) + 4 * (kk >> 3); return 32 * hi + 16 * up + r; }
__device__ __forceinline__ v8i ld32(const char* p) { const v4i a = *(const v4i*)p, b = *(const v4i*)(p + 16); return (v8i){a[0], a[1], a[2], a[3], b[0], b[1], b[2], b[3]}; }
__device__ __forceinline__ f32x16 mma8(v8i a, v8i b, f32x16 c) { return __builtin_amdgcn_mfma_scale_f32_32x32x64_f8f6f4(a, b, c, 0, 0, 0, 0, 0, 0); }

template <bool FIRST>
__device__ __forceinline__ void partialSM(f32x16& p0, f32x16& p1, f32x16& negm, float& alpha) {
  float pmax = p0[0]; for (int r = 1; r < 16; ++r) pmax = fmaxf(pmax, p0[r]); for (int r = 0; r < 16; ++r) pmax = fmaxf(pmax, p1[r]);
  { auto rr = __builtin_amdgcn_permlane32_swap(__float_as_uint(pmax), __float_as_uint(pmax), false, false);
    pmax = fmaxf(__uint_as_float(rr[0]), __uint_as_float(rr[1])); }
  const float d = pmax - 4.f;
  if (!FIRST && __builtin_expect(__all(d <= THR2), 1)) alpha = 1.f;
  else { const float dl = FIRST ? d : fmaxf(d, 0.f); alpha = __builtin_amdgcn_exp2f(-dl);
    for (int r = 0; r < 16; ++r) { p0[r] -= dl; p1[r] -= dl; negm[r] -= dl; } }
  for (int r = 0; r < 16; ++r) p0[r] = __builtin_amdgcn_exp2f(p0[r]);
}
__device__ __forceinline__ void finishA(f32x16& p1) { for (int r = 0; r < 16; ++r) p1[r] = __builtin_amdgcn_exp2f(p1[r]); }
__device__ __forceinline__ void finishB(f32x16& p0, f32x16& p1, v8i& pa, float& lsum) {
  { float t0 = p0[0] + p1[0], t1 = p0[1] + p1[1], t2 = p0[2] + p1[2], t3 = p0[3] + p1[3];
#pragma unroll
    for (int r = 4; r < 16; r += 4) { t0 += p0[r] + p1[r]; t1 += p0[r + 1] + p1[r + 1]; t2 += p0[r + 2] + p1[r + 2]; t3 += p0[r + 3] + p1[r + 3]; }
    lsum += (t0 + t1) + (t2 + t3); }
#pragma unroll
  for (int w = 0; w < 4; ++w) { int a = pa[w], b = pa[4 + w];
    a = __builtin_amdgcn_cvt_pk_fp8_f32(p0[4 * w], p0[4 * w + 1], a, false); a = __builtin_amdgcn_cvt_pk_fp8_f32(p0[4 * w + 2], p0[4 * w + 3], a, true);
    b = __builtin_amdgcn_cvt_pk_fp8_f32(p1[4 * w], p1[4 * w + 1], b, false); b = __builtin_amdgcn_cvt_pk_fp8_f32(p1[4 * w + 2], p1[4 * w + 3], b, true);
    pa[w] = a; pa[4 + w] = b; }
}
struct KFrag { v8i a0, a1, a2, a3; };
__device__ __forceinline__ v8i ld2(const char* p, int o0, int o1) { const v4i a = *(const v4i*)(p + o0), b = *(const v4i*)(p + o1); return (v8i){a[0], a[1], a[2], a[3], b[0], b[1], b[2], b[3]}; }
__device__ __forceinline__ void kf_load(KFrag& f, const char* Ks, const int (&ka)[4]) {
  f.a0 = ld2(Ks, ka[0], ka[1]); f.a1 = ld2(Ks + 4096, ka[0], ka[1]); f.a2 = ld2(Ks, ka[2], ka[3]); f.a3 = ld2(Ks + 4096, ka[2], ka[3]);
}
__device__ __forceinline__ void qkt(f32x16& p0, f32x16& p1, const f32x16& negm, const KFrag& f, const v8i* qr) {
  p0 = mma8(f.a0, qr[0], negm); p1 = mma8(f.a1, qr[0], negm); p0 = mma8(f.a2, qr[1], p0); p1 = mma8(f.a3, qr[1], p1);
}
struct VFrag { v8i b0, b1, b2, b3; };
__device__ __forceinline__ void pv_load(VFrag& f, const char* Vs, const int (&va)[2]) {
  f.b0 = ld2(Vs, va[0], va[1]); f.b1 = ld2(Vs + 2048, va[0], va[1]); f.b2 = ld2(Vs + 4096, va[0], va[1]); f.b3 = ld2(Vs + 6144, va[0], va[1]);
}
__device__ __forceinline__ void pv(f32x16* o, const VFrag& f, v8i pa) {
  o[0] = mma8(pa, f.b0, o[0]); o[1] = mma8(pa, f.b1, o[1]); o[2] = mma8(pa, f.b2, o[2]); o[3] = mma8(pa, f.b3, o[3]);
}
template <int LDQ, int LDO>
__device__ __forceinline__ void attn_body(const unsigned char* __restrict__ Qb, const unsigned char* __restrict__ Kh, const unsigned char* __restrict__ VTh, unsigned char* __restrict__ Ob, int seq, char* lds, const int tid) {
  const int wid = tid >> 6, lane = tid & 63, r32 = lane & 31, hi = lane >> 5;
  char* V_lds = lds + OFF_V; char* K_lds = lds + OFF_K;
  float* ws = (float*)(lds + OFF_WS) + wid * 64; float* al_l = ws + 32;
  f32x16 o[4] = {}; float lsum = 0.f; v8i qr[2]; f32x16 negm;
#pragma unroll
  for (int r = 0; r < 16; ++r) negm[r] = 0.f;
  { const char* Qw = (const char*)Qb + (long)(wid * QBLK + r32) * LDQ + 32 * hi;
#pragma unroll
    for (int st = 0; st < 2; ++st) qr[st] = ld32(Qw + 64 * st); }
  unsigned kgoff, vgoff;
  { const int kr = wid * 8 + (lane >> 3), vr = wid * 16 + (lane >> 2);
    kgoff = (unsigned)(kr * 128 + (((lane & 7) ^ ((kr >> 1) & 7)) << 4)); vgoff = (unsigned)(vr * 64 + (((lane & 3) ^ ((vr >> 2) & 3)) << 4)); }
  int ka[4], va[2];
  { const int xk = (r32 >> 1) & 7, xv = (r32 >> 2) & 3;
#pragma unroll
    for (int c = 0; c < 4; ++c) ka[c] = r32 * 128 + (((4 * (c >> 1) + 2 * hi + (c & 1)) ^ xk) << 4);
#pragma unroll
    for (int c = 0; c < 2; ++c) va[c] = r32 * 64 + (((2 * hi + c) ^ xv) << 4); }
  const unsigned ldsw = (unsigned)__builtin_amdgcn_readfirstlane(wid) * 1024u;
#define DMA(t) do { const int t_ = (t); const unsigned so_ = (unsigned)(t_ & (NSLOT - 1)) * SLOT + ldsw; unsigned ko_ = kgoff, vo_ = vgoff; asm volatile("" : "+v"(ko_), "+v"(vo_)); \
    __builtin_amdgcn_global_load_lds((const unsigned*)(Kh + (size_t)t_ * SLOT + ko_), (LAS unsigned*)(lds + OFF_K + so_), 16, 0, 0); \
    __builtin_amdgcn_global_load_lds((const unsigned*)(VTh + (size_t)t_ * SLOT + vo_), (LAS unsigned*)(lds + OFF_V + so_), 16, 0, 0); } while (0)
#define WAITV2() asm volatile("s_waitcnt vmcnt(2)" ::: "memory")
#define BARX() __builtin_amdgcn_s_barrier()
#define RESC(a) do { if (__any((a) < 1.f)) { if (hi == 0) al_l[r32] = (a); asm volatile("s_waitcnt lgkmcnt(0)" ::: "memory"); \
    lsum *= (a); for (int r = 0; r < 16; ++r) { const float f_ = al_l[crow(r, hi)]; for (int d = 0; d < 4; ++d) o[d][r] *= f_; } } } while (0)
#define SBAR8() __builtin_amdgcn_sched_barrier(0)
  f32x16 pA0, pA1, pB0, pB1; float alA, alB; v8i pa = {}; const int NT = seq / KVBLK;
  DMA(0); DMA(1); WAITV2(); BARX();
  KFrag kf; kf_load(kf, K_lds, ka); qkt(pA0, pA1, negm, kf, qr); partialSM<true>(pA0, pA1, negm, alA);
  DMA(2 < NT ? 2 : NT - 1); WAITV2(); BARX();
  VFrag vf;
#define STEP(pN0, pN1, pO0, pO1, jj, alN) do { const int j_ = (jj); \
    SBAR8(); kf_load(kf, K_lds + (j_ & (NSLOT - 1)) * SLOT, ka); SBAR8(); \
    finishA(pO1); SBAR8(); \
    qkt(pN0, pN1, negm, kf, qr); SBAR8(); \
    pv_load(vf, V_lds + ((j_ - 1) & (NSLOT - 1)) * SLOT, va); SBAR8(); \
    finishB(pO0, pO1, pa, lsum); SBAR8(); \
    DMA(j_ + 2 < NT ? j_ + 2 : NT - 1); SBAR8();     \
    pv(o, vf, pa); partialSM<false>(pN0, pN1, negm, alN); \
    RESC(alN); WAITV2(); BARX(); } while (0)
  for (int j = 1; j + 1 < NT; j += 2) {
    STEP(pB0, pB1, pA0, pA1, j, alB);
    STEP(pA0, pA1, pB0, pB1, j + 1, alA);
  }
  STEP(pB0, pB1, pA0, pA1, NT - 1, alB);
  pv_load(vf, V_lds + ((NT - 1) & (NSLOT - 1)) * SLOT, va);
  finishA(pB1); finishB(pB0, pB1, pa, lsum); SBAR8();
  pv(o, vf, pa);
#undef STEP
  float rli[16];
  { auto rr = __builtin_amdgcn_permlane32_swap(__float_as_uint(lsum), __float_as_uint(lsum), false, false);
    const float rl = __builtin_amdgcn_rcpf(__uint_as_float(rr[0]) + __uint_as_float(rr[1]));
    if (hi == 0) al_l[r32] = rl; asm volatile("s_waitcnt lgkmcnt(0)" ::: "memory");
#pragma unroll
    for (int r = 0; r < 16; ++r) rli[r] = al_l[crow(r, hi)]; }
  { char* ost = lds + OFF_OST + wid * (32 * 144);
#pragma unroll
    for (int r = 0; r < 16; ++r) { const int orow = crow(r, hi);
#pragma unroll
      for (int d0 = 0; d0 < 4; ++d0) *(unsigned char*)(ost + orow * 144 + d0 * 32 + r32) = (unsigned char)__builtin_amdgcn_cvt_pk_fp8_f32(o[d0][r] * rli[r], 0.f, 0, false); }
    asm volatile("s_waitcnt lgkmcnt(0)" ::: "memory");
    unsigned char* Ow = Ob + (long)(wid * QBLK) * LDO;
#pragma unroll
    for (int i = 0; i < 4; ++i) { const int idx = lane + 64 * i, row = idx >> 3, ch = idx & 7;
      *(u32x4*)(Ow + (long)row * LDO + ch * 16) = *(const u32x4*)(ost + row * 144 + ch * 16); } }
  asm volatile("s_waitcnt vmcnt(0)" ::: "memory");
  __syncthreads();
#undef DMA
#undef WAITV2
#undef BARX
#undef RESC
#undef SBAR8
}
}

#define XB_TMO      128
#define XB_XCNT(j)  (256  + 64 * (j))
#define XB_XSUB(j)  (1280 + 64 * (j))
#define XB_XGEN(j)  (2304 + 64 * (j))
#define XB_TOP      3328
#define XB_TOPGEN   3392
#define XCD_BAR_WORDS 3456
#define XB_SPIN_CAP (1u << 18)
__device__ __forceinline__ unsigned xb_ld(unsigned* p)              { return __hip_atomic_load(p, __ATOMIC_RELAXED, __HIP_MEMORY_SCOPE_AGENT); }
__device__ __forceinline__ unsigned xb_add(unsigned* p, unsigned v) { return __hip_atomic_fetch_add(p, v, __ATOMIC_RELAXED, __HIP_MEMORY_SCOPE_AGENT); }
__device__ __forceinline__ unsigned xb_xcc_id() { return (unsigned)__builtin_amdgcn_s_getreg((3 << 11) | 20) & 0xFu; }
#define XB_SPIN(cond, bar) do { unsigned _sp = 0; while (cond) { __builtin_amdgcn_s_sleep(1); \
    if ((++_sp & 255u) == 0u) { if (xb_ld(&(bar)[XB_TMO])) break; if (_sp > XB_SPIN_CAP) { atomicAdd(&(bar)[XB_TMO], 1u); break; } } } } while (0)
struct XcdBarrier { unsigned* bar; unsigned x; volatile LAS unsigned* st; };
__device__ __forceinline__ XcdBarrier xcd_barrier_post(unsigned* bar, volatile LAS unsigned* st) {
    XcdBarrier b; b.bar = bar; b.x = xb_xcc_id(); b.st = st;
    if (threadIdx.x == 0) (void)xb_add(&bar[XB_XCNT(b.x)], 1u);
    return b;
}
__device__ __forceinline__ void xcd_barrier_complete(unsigned* bar, unsigned x, unsigned& nloc, unsigned& nx) {
    const unsigned G = gridDim.x * gridDim.y * gridDim.z;
    unsigned sum, cnt, mine, sp = 0u;
    for (;;) {
        sum = 0u; cnt = 0u; mine = 0u;
#pragma unroll
        for (unsigned j = 0; j < 16; ++j) { const unsigned c = xb_ld(&bar[XB_XCNT(j)]); sum += c; cnt += (c > 0u) ? 1u : 0u; mine = (j == x) ? c : mine; }
        if (sum == G) break;
        __builtin_amdgcn_s_sleep(1);
        if ((++sp & 255u) == 0u) { if (xb_ld(&bar[XB_TMO])) break; if (sp > XB_SPIN_CAP) { atomicAdd(&bar[XB_TMO], 1u); break; } }
    }
    nloc = mine > 0u ? mine : 1u; nx = cnt > 0u ? cnt : 1u;
}
template <class Work>
__device__ __forceinline__ void xcd_barrier(const XcdBarrier& b, Work work) {
    asm volatile("s_waitcnt vmcnt(0)" ::: "memory");
    __syncthreads();
    if (threadIdx.x >= 64) work((int)threadIdx.x - 64, (int)blockDim.x - 64);
    if (threadIdx.x == 0) {
        unsigned* bar = b.bar;
        __builtin_amdgcn_s_waitcnt(0);
        __builtin_amdgcn_fence(__ATOMIC_ACQUIRE, "agent");
        unsigned nloc = b.st[0], nx = b.st[1];
        if (nloc == 0u) { xcd_barrier_complete(bar, b.x, nloc, nx); b.st[0] = nloc; b.st[1] = nx; }
        const unsigned old = xb_add(&bar[XB_XSUB(b.x)], 1u);
        const unsigned gen = old / nloc;
        if (old + 1u == (gen + 1u) * nloc) {
            __builtin_amdgcn_fence(__ATOMIC_RELEASE, "agent");
            asm volatile("s_waitcnt vmcnt(0)" ::: "memory");
            const unsigned og = xb_add(&bar[XB_TOP], 1u);
            const unsigned tg = og / nx;
            if (og + 1u == (tg + 1u) * nx) xb_add(&bar[XB_TOPGEN], 1u);
            else XB_SPIN(xb_ld(&bar[XB_TOPGEN]) == tg, bar);
            xb_add(&bar[XB_XGEN(b.x)], 1u);
            asm volatile("s_waitcnt vmcnt(0)" ::: "memory");
        } else {
            XB_SPIN(xb_ld(&bar[XB_XGEN(b.x)]) == gen, bar);
            asm volatile("s_waitcnt vmcnt(0)" ::: "memory");
        }
    }
    __syncthreads();
}

__device__ __forceinline__ unsigned char* opq(unsigned char* p) { asm volatile("" : "+s"(p)); return p; }
struct Args { const float* in[24]; float* out; unsigned char* ws; int ph_lo, ph_hi; };
__device__ __forceinline__ Args load_args() {
#if defined(__HIP_DEVICE_COMPILE__)
    auto kp = __builtin_amdgcn_kernarg_segment_ptr();
    asm volatile("" : "+s"(kp));
    return *(const __attribute__((address_space(4))) Args*)kp;
#else
    return Args{};
#endif
}
enum { I_X = 0, I_C, I_CTX, I_CCTX, I_WMOD, I_BMOD, I_NMIX, I_NFFN, I_WIN, I_QN, I_KN, I_SCW, I_CDW, I_CDB, I_CLG, I_CLB, I_WOUT, I_RW, I_RB, I_WUP, I_BUP, I_WDN, I_BDN, I_FN };

__device__ __forceinline__ void p0_mods_unit(int unit, const float* w_mod, const float* b_mod, float* mods, const LAS float* act, LAS float* red, int tid) {
    const int l = unit / 384, col0 = (unit % 384) * 16, col = tid & 15, kg = tid >> 4;
    float acc[9];
#pragma unroll
    for (int r = 0; r < 9; ++r) acc[r] = 0.f;
    const float* wp = w_mod + ((size_t)l * DM + kg * 32) * NMOD + col0 + col;
#pragma unroll 16
    for (int k = 0; k < 32; ++k) { const float w = wp[(size_t)k * NMOD];
#pragma unroll
        for (int r = 0; r < 9; ++r) acc[r] += act[r * DM + kg * 32 + k] * w; }
#pragma unroll
    for (int r = 0; r < 9; ++r) red[(kg * 9 + r) * 16 + col] = acc[r];
    __syncthreads();
    if (tid < 9 * 16) { const int r = tid >> 4, cc = tid & 15; float sm = 0.f;
#pragma unroll
        for (int g = 0; g < 32; ++g) sm += red[(g * 9 + r) * 16 + cc];
        mods[((size_t)l * 9 + r) * NMOD + col0 + cc] = sm + b_mod[(size_t)l * NMOD + col0 + cc]; }
    __syncthreads();
}
struct MapId { __device__ __forceinline__ int operator()(int n) const { return n; } };
struct MapUp { __device__ __forceinline__ int operator()(int n) const { const int a = n >> 1, j = n & 1; return ((a >> 7) << 8) + (j << 7) + (a & 127); } };
template <class NMap>
__device__ __forceinline__ void p0_transpose_item8(const float* W, int K, int N, unsigned char* WT, LAS float* scr, int kb, int nb, int lane, NMap nmap, int KD = 0) {
    if (KD == 0) KD = K;
    const int k0 = 64 * kb, n0 = 64 * nb;
    { const int kq = lane >> 4, n4 = (lane & 15) * 4;
#pragma unroll
        for (int i = 0; i < 16; ++i) { const f32x4 v = __builtin_nontemporal_load((const f32x4*)(W + (size_t)(k0 + 4 * i + kq) * N + n0 + n4));
            LAS float* d = scr + (4 * i + kq) * 65 + n4; d[0] = v.x; d[1] = v.y; d[2] = v.z; d[3] = v.w; } }
    LDS_WAIT(); asm volatile("" ::: "memory");
    const int c = lane & 3, rs = lane >> 2;
#pragma unroll
    for (int j = 0; j < 4; ++j) { const int nl = rs + 16 * j; const LAS float* s = scr + (16 * c) * 65 + nl;
        u32x4 o;
        o.x = pg8::cvt4_fp8(s[0 * 65] * W8_SCALE, s[1 * 65] * W8_SCALE, s[2 * 65] * W8_SCALE, s[3 * 65] * W8_SCALE); o.y = pg8::cvt4_fp8(s[4 * 65] * W8_SCALE, s[5 * 65] * W8_SCALE, s[6 * 65] * W8_SCALE, s[7 * 65] * W8_SCALE);
        o.z = pg8::cvt4_fp8(s[8 * 65] * W8_SCALE, s[9 * 65] * W8_SCALE, s[10 * 65] * W8_SCALE, s[11 * 65] * W8_SCALE); o.w = pg8::cvt4_fp8(s[12 * 65] * W8_SCALE, s[13 * 65] * W8_SCALE, s[14 * 65] * W8_SCALE, s[15 * 65] * W8_SCALE);
        __builtin_nontemporal_store(o, (u32x4*)(WT + (size_t)nmap(n0 + nl) * KD + k0 + 16 * c)); }
    LDS_WAIT(); asm volatile("" ::: "memory");
}
template <class NMap>
__device__ __forceinline__ void p0_transpose_item(const float* W, int K, int N, bf16_t* WT, LAS float* scr, int kb, int nb, int lane, NMap nmap, float sc = 1.f) {
    const int k0 = 64 * kb, n0 = 64 * nb;
    { const int kq = lane >> 4, n4 = (lane & 15) * 4;
#pragma unroll
        for (int i = 0; i < 16; ++i) { const f32x4 v = __builtin_nontemporal_load((const f32x4*)(W + (size_t)(k0 + 4 * i + kq) * N + n0 + n4));
            LAS float* d = scr + (4 * i + kq) * 65 + n4; d[0] = v.x; d[1] = v.y; d[2] = v.z; d[3] = v.w; } }
    LDS_WAIT(); asm volatile("" ::: "memory");
    const int c = lane & 7, rs = lane >> 3;
#pragma unroll
    for (int j = 0; j < 8; ++j) { const int nl = rs + 8 * j; const LAS float* s = scr + (8 * c) * 65 + nl;
        u32x4 o; o.x = pk2(s[0 * 65] * sc, s[1 * 65] * sc); o.y = pk2(s[2 * 65] * sc, s[3 * 65] * sc); o.z = pk2(s[4 * 65] * sc, s[5 * 65] * sc); o.w = pk2(s[6 * 65] * sc, s[7 * 65] * sc);
        __builtin_nontemporal_store(o, (u32x4*)(WT + (size_t)nmap(n0 + nl) * K + k0 + 8 * c)); }
    LDS_WAIT(); asm volatile("" ::: "memory");
}
constexpr int P0_IT_IN = 16 * 40, P0_IT_IN8 = 16 * 16, P0_IT_OUT = 0, P0_IT_OUT8 = 20 * 16, P0_IT_UP = 16 * 32, P0_IT_DN = 16 * 16, P0_IT_LAYER = P0_IT_IN + P0_IT_IN8 + P0_IT_OUT + P0_IT_OUT8 + NE * P0_IT_UP + NE * P0_IT_DN;
constexpr int P0_ITEMS = DEPTH * P0_IT_LAYER, P0_DEFER = MK_ONE_LAUNCH ? 384 : NE * P0_IT_DN;
constexpr int P0_WPB = 7, P0_IPW = 2  , P0_SLOTN = NWG * P0_WPB * P0_IPW, P0_NSLOT = MK_ONE_LAUNCH ? 12 : 0, P0_CNT = MK_ONE_LAUNCH ? 1024 : P0_ITEMS - P0_DEFER;
__host__ __device__ constexpr int p0_slot_raw(int k) { return k <= 4 ? k : k == 6 ? 5 : k == 8 ? 6 : k == 10 ? 7 : k == 12 ? 8 : k == 13 ? 9 : k == 14 ? 10 : k == 16 ? 11 : -1; }
__host__ __device__ constexpr int p0_slot(int k) { return p0_slot_raw(k) < P0_NSLOT ? p0_slot_raw(k) : -1; }

__device__ __forceinline__ void p0_items(const Args& a, LAS unsigned char* lds, int gw, int NGW, int it_lo, int it_hi, int tid);
__device__ __forceinline__ void p0_prologue(const Args& a, LAS unsigned char* lds, int wg, int tid) {
    const int lane = tid & 63, wave = tid >> 6;
    unsigned char* ws = a.ws;
    {
        LAS float* act = (LAS float*)lds; LAS float* red = (LAS float*)(lds + 9 * DM * 4);
        for (int i = tid; i < 9 * DM; i += NTHR) { const int r = i >> 10, k = i & 1023; const float v = (r < 8) ? a.in[I_C][r * DM + k] : a.in[I_CCTX][k]; act[i] = v * sigmoidf_(v); }
        __syncthreads();
        for (int u = wg; u < 768; u += NWG) p0_mods_unit(u, a.in[I_WMOD], a.in[I_BMOD], (float*)(ws + WS_MODS), act, red, tid);
    }
    p0_items(a, lds, wg * NWAVES + wave, NWG * NWAVES, 0, P0_CNT, tid);
}
__device__ __forceinline__ void p0_items(const Args& a, LAS unsigned char* lds, int gw, int NGW, int it_lo, int it_hi, int tid) {
    const int lane = tid & 63, wave = tid >> 6;
    unsigned char* ws = a.ws;
    LAS float* scr = (LAS float*)(lds + wave * 16640);
    constexpr int IT_IN = P0_IT_IN, IT_IN8 = P0_IT_IN8, IT_OUT = P0_IT_OUT, IT_OUT8 = P0_IT_OUT8, IT_UP = P0_IT_UP, IT_DN = P0_IT_DN, IT_LAYER = P0_IT_LAYER;
    for (int it = it_lo + gw; it < it_hi; it += NGW) {
        const int l = it / IT_LAYER; int r = it % IT_LAYER;
        if (r < IT_IN) { p0_transpose_item(a.in[I_WIN] + (size_t)l * DM * IN_W, DM, IN_W, (bf16_t*)(ws + WS_WIN) + (size_t)l * IN_W * DM, scr, r / 40, r % 40, lane, MapId()); continue; } r -= IT_IN;
        if (r < IT_IN8) { p0_transpose_item8(a.in[I_WIN] + (size_t)l * DM * IN_W, DM, IN_W, (unsigned char*)(ws + WS_WIN8) + (size_t)l * IN_W * DM, scr, r / 16, r % 16, lane, MapId()); continue; } r -= IT_IN8;
        if (r < IT_OUT) { p0_transpose_item(a.in[I_WOUT] + (size_t)l * MIX_W * DM, MIX_W, DM, (bf16_t*)(ws + WS_WOUT) + (size_t)l * DM * MIX_W, scr, 8 + r / 16, r % 16, lane, MapId(), W8_SCALE); continue; } r -= IT_OUT;
        if (r < IT_OUT8) { p0_transpose_item8(a.in[I_WOUT] + (size_t)l * MIX_W * DM, MIX_W, DM, (unsigned char*)(ws + WS_WOUT) + (size_t)l * DM * MIX_W, scr, r / 16, r % 16, lane, MapId()); continue; } r -= IT_OUT8;
        if (r < NE * IT_UP) { const int e = r / IT_UP, q = r % IT_UP;
            p0_transpose_item8(a.in[I_WUP] + ((size_t)l * NE + e) * DM * 2048, DM, 2048, (unsigned char*)(ws + WS_WUP) + ((size_t)l * NE + e) * 2048 * DM, scr, q / 32, q % 32, lane, MapUp()); continue; } r -= NE * IT_UP;
        { const int e = r / IT_DN, q = r % IT_DN;
            p0_transpose_item8(a.in[I_WDN] + ((size_t)l * NE + e) * DFF * DM, DFF, DM, (unsigned char*)(ws + WS_WDN) + ((size_t)l * NE + e) * DM * DFF, scr, q / 16, q % 16, lane, MapId()); }
    }
}

__device__ __forceinline__ void p0_slot_items(const Args& a, LAS unsigned char* lds, int wg, int slot, int t) {
    constexpr int ipw[12] = {3, 2, 3, 2, 3, 2, 2, 2, 3, 2, 2, 2};
    int cum = 0;
#pragma unroll
    for (int i = 0; i < 12; ++i) if (i < slot) cum += ipw[i];
    const int w = t >> 6, per = NWG * P0_WPB;
    const int lo_ = P0_CNT + cum * per, hi_ = lo_ + ipw[slot] * per;
    if (w < P0_WPB) p0_items(a, lds, wg * P0_WPB + w, per, lo_, hi_ < P0_ITEMS - P0_DEFER ? hi_ : P0_ITEMS - P0_DEFER, t);
}
static_assert(!MK_ONE_LAUNCH || P0_CNT + 28 * NWG * P0_WPB >= P0_ITEMS - P0_DEFER, "p0 slots");

__device__ __forceinline__ void ph_norm1(const float* xlat, const float* xctx, const float* gain, const float* mods_l, bf16_t* HA, unsigned char* HA8, int gw, int NGW, int lane) {
    const int k0 = 16 * lane;
    for (int t0 = gw * 2; t0 < NTOK; t0 += NGW * 2) {
        f32x4 v[2][4]; float ss[2];
#pragma unroll
        for (int r = 0; r < 2; ++r) { const int t = t0 + r; const float* xr = (t < NLAT) ? xlat + (size_t)t * DM : xctx + (size_t)(t - NLAT) * DM;
#pragma unroll
            for (int j = 0; j < 4; ++j) v[r][j] = *(const f32x4*)(xr + k0 + 4 * j); }
#pragma unroll
        for (int r = 0; r < 2; ++r) { float q = 0.f;
#pragma unroll
            for (int j = 0; j < 4; ++j) q += v[r][j].x * v[r][j].x + v[r][j].y * v[r][j].y + v[r][j].z * v[r][j].z + v[r][j].w * v[r][j].w;
            ss[r] = q; }
#pragma unroll
        for (int r = 0; r < 2; ++r) { const int t = t0 + r; const float* mp = mods_l + (size_t)tok_bidx(t) * NMOD;
            const float rstd = rsqrtf(wave_sum(ss[r]) * (1.f / DM) + EPS);
            u32x4 ho[2]; unsigned h8[4];
#pragma unroll
            for (int j = 0; j < 4; ++j) { const int k = k0 + 4 * j;
                const f32x4 g = *(const f32x4*)(gain + k), sh = *(const f32x4*)(mp + k), sc = *(const f32x4*)(mp + DM + k);
                const f32x4 y = (v[r][j] * rstd * g) * (sc + 1.f) + sh;
                ho[j >> 1][(j & 1) * 2] = pk2(y.x, y.y); ho[j >> 1][(j & 1) * 2 + 1] = pk2(y.z, y.w); h8[j] = pg8::cvt4_fp8(y.x, y.y, y.z, y.w); }
            *(u32x4*)(HA + (size_t)t * DM + k0) = ho[0]; *(u32x4*)(HA + (size_t)t * DM + k0 + 8) = ho[1];
            *(u32x4*)(HA8 + (size_t)t * DM + k0) = (u32x4){h8[0], h8[1], h8[2], h8[3]}; }
    }
}

__device__ __forceinline__ u32x2 qk_row(u32x4 X, const float (&g)[8], const float (&gp)[8], bool rot, float sgn, const LAS f32x2* rp) {
    float x[8] = {bflo(X.x), bfhi(X.x), bflo(X.y), bfhi(X.y), bflo(X.z), bfhi(X.z), bflo(X.w), bfhi(X.w)};
    float ss = 0.f;
#pragma unroll
    for (int i = 0; i < 8; ++i) ss += x[i] * x[i];
    ss += xor_swz<1>(ss); ss += xor_swz<2>(ss); ss += xor_swz<4>(ss); ss += xor_swz<8>(ss);
    const float rstd = rsqrtf(ss * (1.f / 128.f) + EPS);
    u32x4 P;
    P.x = (unsigned)__builtin_amdgcn_ds_swizzle((int)X.x, (4 << 10) | 0x1f); P.y = (unsigned)__builtin_amdgcn_ds_swizzle((int)X.y, (4 << 10) | 0x1f);
    P.z = (unsigned)__builtin_amdgcn_ds_swizzle((int)X.z, (4 << 10) | 0x1f); P.w = (unsigned)__builtin_amdgcn_ds_swizzle((int)X.w, (4 << 10) | 0x1f);
    const float px[8] = {bflo(P.x), bfhi(P.x), bflo(P.y), bfhi(P.y), bflo(P.z), bfhi(P.z), bflo(P.w), bfhi(P.w)};
    float o[8];
    if (rot) {
#pragma unroll
        for (int i = 0; i < 8; ++i) { const f32x2 cssn = rp[i]; o[i] = (x[i] * rstd * g[i]) * cssn.x + sgn * (px[i] * rstd * gp[i]) * cssn.y; }
    } else {
#pragma unroll
        for (int i = 0; i < 8; ++i) o[i] = x[i] * rstd * g[i];
    }
    u32x2 r; r.x = pg8::cvt4_fp8(o[0], o[1], o[2], o[3]); r.y = pg8::cvt4_fp8(o[4], o[5], o[6], o[7]); return r;
}
__device__ __forceinline__ void ph_qkv(int l, const Args& a, LAS unsigned char* lds, int wg, int tid) {
    const int lane = tid & 63, wave = tid >> 6;
    unsigned char* ws = a.ws;
    const bf16_t* U = (const bf16_t*)(ws + WS_U);
    unsigned char* QB = ws + WS_QB; unsigned char* KB = ws + WS_KB; unsigned char* VT = ws + WS_VB;
    LAS f32x2* rope = (LAS f32x2*)lds;
    for (int i = tid; i < 64 * 32; i += NTHR) { const int p = i >> 5, f = i & 31;
        const float inv = __builtin_amdgcn_exp2f(-(float)f * (2.0f / 64.0f) * 13.287712379549449f);
        float sn, cs; sincos_rev((float)p * inv * 0.15915494309189535f, sn, cs); rope[i] = (f32x2){cs, sn}; }
    __syncthreads();
    const bool last = (l == DEPTH - 1);
    const int j16 = lane & 15, d0 = j16 * 8, axis = j16 >> 3, fi0 = (j16 & 3) * 8;
    const float sgn = ((j16 >> 2) & 1) ? 1.f : -1.f;
    const float* qn = a.in[I_QN] + l * 128; const float* kn = a.in[I_KN] + l * 128;
    float qg[8], qgp[8], kg[8], kgp[8];
#pragma unroll
    for (int i = 0; i < 8; ++i) { qg[i] = qn[d0 + i] * att8::QSC; qgp[i] = qn[(d0 ^ 32) + i] * att8::QSC; kg[i] = kn[d0 + i]; kgp[i] = kn[(d0 ^ 32) + i]; }
#pragma unroll 2
    for (int t = wg * NWAVES + wave; t < NTOK; t += NWG * NWAVES) {
        const bool isctx = t >= NLAT;
        const int b = isctx ? (t - NLAT) >> 8 : t >> 12, sp = isctx ? (t - NLAT) & 255 : t & 4095, krow = isctx ? sp : CTXL + sp;
        const bool doq = !(last && isctx);
        const bf16_t* up = U + (size_t)t * IN_W;
        u32x4 A = {0u, 0u, 0u, 0u}; if (doq) A = *(const u32x4*)(up + 8 * lane);
        u32x4 B = {0u, 0u, 0u, 0u}; if (lane < 32) B = *(const u32x4*)(up + 512 + 8 * lane);
        const LAS f32x2* rp = rope + (axis ? (sp & 63) : (sp >> 6)) * 32 + fi0;
        const u32x2 qo = qk_row(A, qg, qgp, !isctx, sgn, rp);
        if (doq) *(u32x2*)(QB + (size_t)t * 512 + 8 * lane) = qo;
        const u32x2 ko = qk_row(B, kg, kgp, !isctx, sgn, rp);
        if (lane < 32) *(u32x2*)(KB + ((size_t)(b * 2 + (lane >> 4)) * SKV + krow) * 128 + d0) = ko;
    }
    __syncthreads();
    LAS unsigned char* T = (LAS unsigned char*)lds;
    for (int u = wg; u < BATCH * 2 * (SKV / 64); u += NWG) {
        const int b = u / (2 * (SKV / 64)), rem = u % (2 * (SKV / 64)), kvh = rem / (SKV / 64), tile = rem % (SKV / 64);
        { const int key = tid & 63, dch = (tid >> 6) * 16, kr = tile * 64 + key;
            const size_t tok = (kr < CTXL) ? (size_t)NLAT + b * CTXL + kr : (size_t)b * SEQ + (kr - CTXL);
            const bf16_t* src = U + tok * IN_W + 768 + kvh * 128 + dch;
            const u32x4 v0 = *(const u32x4*)src, v1 = *(const u32x4*)(src + 8);
            const unsigned w0 = pg8::cvt4_fp8(bflo(v0.x), bfhi(v0.x), bflo(v0.y), bfhi(v0.y)), w1 = pg8::cvt4_fp8(bflo(v0.z), bfhi(v0.z), bflo(v0.w), bfhi(v0.w));
            const unsigned w2 = pg8::cvt4_fp8(bflo(v1.x), bfhi(v1.x), bflo(v1.y), bfhi(v1.y)), w3 = pg8::cvt4_fp8(bflo(v1.z), bfhi(v1.z), bflo(v1.w), bfhi(v1.w));
            LAS unsigned char* dst = T + dch * 64 + att8::kpos(key);
#pragma unroll
            for (int i = 0; i < 4; ++i) { dst[(i) * 64] = (unsigned char)(w0 >> (8 * i)); dst[(4 + i) * 64] = (unsigned char)(w1 >> (8 * i)); dst[(8 + i) * 64] = (unsigned char)(w2 >> (8 * i)); dst[(12 + i) * 64] = (unsigned char)(w3 >> (8 * i)); } }
        __syncthreads();
        *(u32x4*)(VT + ((size_t)(b * 2 + kvh) * (SKV / 64) + tile) * 8192 + tid * 16) = *(const LAS u32x4*)(T + tid * 16);
        __syncthreads();
    }
}

constexpr int CVT = 64, CV_ROWS = CVT + 30;
constexpr int CV_GLU = 0, CV_D = 49152, CV_END = CV_D + CVT * 256 * 4;
static_assert(CV_ROWS * 128 * 4 <= CV_D && CV_END <= LDS_FREE, "conv LDS");
__device__ __forceinline__ void ph_conv_tiles(int l, const Args& a, LAS unsigned char* lds, int wg, int tid) {
    unsigned char* ws = a.ws;
    const bf16_t* U = (const bf16_t*)(ws + WS_U); bf16_t* MIX = (bf16_t*)(ws + WS_MIX);
    const float* cdw = a.in[I_CDW] + (size_t)l * 31 * 256; const float* cdb = a.in[I_CDB] + l * 256;
    const float* clg = a.in[I_CLG] + l * 256; const float* clb = a.in[I_CLB] + l * 256; const float* scw = a.in[I_SCW] + (size_t)l * 3 * 256;
    LAS unsigned* glu = (LAS unsigned*)(lds + CV_GLU);
    LAS float* dbuf = (LAS float*)(lds + CV_D);
    const int cp = tid & 127, tg = tid >> 7;
    const int hw = tid >> 5, l32 = tid & 31;
    f32x2 w[31];
#pragma unroll
    for (int j = 0; j < 31; ++j) w[j] = *(const f32x2*)(cdw + j * 256 + 2 * cp);
    const f32x2 cbias = *(const f32x2*)(cdb + 2 * cp);
    const int ntiles = (l == DEPTH - 1) ? NLAT / CVT : NTOK / CVT;
    u32x4 ra[6], rg[6];
#define CV_LOAD(TT) do { const int t0_ = (TT) * CVT; const bool ic_ = t0_ >= NLAT; const int sq_ = ic_ ? (t0_ - NLAT) & 255 : t0_ & 4095, sl_ = ic_ ? CTXL : SEQ; \
        _Pragma("unroll") for (int i = 0; i < 6; ++i) { const int id = tid + NTHR * i, j = id >> 5, c8 = (id & 31) * 8, sj = sq_ - 15 + j; \
            ra[i] = (u32x4){0u, 0u, 0u, 0u}; rg[i] = ra[i]; \
            if (id < CV_ROWS * 32 && sj >= 0 && sj < sl_) { const bf16_t* up = U + (size_t)(t0_ - 15 + j) * IN_W + 2048 + c8; ra[i] = *(const u32x4*)up; rg[i] = *(const u32x4*)(up + 256); } } } while (0)
    if (wg < ntiles) CV_LOAD(wg);
    for (int tt = wg; tt < ntiles; tt += NWG) {
        const int t0 = tt * CVT; const bool isctx = t0 >= NLAT;
        const int s0p = isctx ? (t0 - NLAT) & 255 : t0 & 4095, slen = isctx ? CTXL : SEQ;
#pragma unroll
        for (int i = 0; i < 6; ++i) { const int id = tid + NTHR * i;
            if (id < CV_ROWS * 32) { u32x4 o;
                o.x = pk2(bflo(ra[i].x) * sigmoidf_(bflo(rg[i].x)), bfhi(ra[i].x) * sigmoidf_(bfhi(rg[i].x))); o.y = pk2(bflo(ra[i].y) * sigmoidf_(bflo(rg[i].y)), bfhi(ra[i].y) * sigmoidf_(bfhi(rg[i].y)));
                o.z = pk2(bflo(ra[i].z) * sigmoidf_(bflo(rg[i].z)), bfhi(ra[i].z) * sigmoidf_(bfhi(rg[i].z))); o.w = pk2(bflo(ra[i].w) * sigmoidf_(bflo(rg[i].w)), bfhi(ra[i].w) * sigmoidf_(bfhi(rg[i].w)));
                *(LAS u32x4*)(glu + id * 4) = o; } }
        __syncthreads();
        if (tt + NWG < ntiles) CV_LOAD(tt + NWG);
        {
            f32x2 acc[16];
#pragma unroll
            for (int o = 0; o < 16; ++o) acc[o] = cbias;
#pragma unroll
            for (int jj = 0; jj < 46; ++jj) { const unsigned gv = glu[(tg * 16 + jj) * 128 + cp]; const f32x2 v = {bflo(gv), bfhi(gv)};
#pragma unroll
                for (int o = 0; o < 16; ++o) { const int k = jj - o; if (k >= 0 && k < 31) acc[o] += w[k] * v; } }
#pragma unroll
            for (int o = 0; o < 16; ++o) *(LAS f32x2*)(dbuf + (tg * 16 + o) * 256 + 2 * cp) = acc[o];
        }
        {
            const int c8 = (tid & 31) * 8;
#pragma unroll
            for (int q = 0; q < 4; ++q) { const int tl = (tid >> 5) + 16 * q, sj = s0p + tl; const bf16_t* up = U + (size_t)(t0 + tl) * IN_W + c8;
                u32x4 cv[3], xv[3];
#pragma unroll
                for (int d = 0; d < 3; ++d) { cv[d] = (u32x4){0u, 0u, 0u, 0u}; xv[d] = cv[d];
                    if (sj + d - 1 >= 0 && sj + d - 1 < slen) { cv[d] = *(const u32x4*)(up + (d - 1) * IN_W + 1280); xv[d] = *(const u32x4*)(up + (d - 1) * IN_W + 1536); } }
                const u32x4 bv = *(const u32x4*)(up + 1024);
                const f32x4 w0a = *(const f32x4*)(scw + c8), w0b = *(const f32x4*)(scw + c8 + 4), w1a = *(const f32x4*)(scw + 256 + c8), w1b = *(const f32x4*)(scw + 256 + c8 + 4), w2a = *(const f32x4*)(scw + 512 + c8), w2b = *(const f32x4*)(scw + 512 + c8 + 4);
                const float wt[3][8] = {{w0a.x, w0a.y, w0a.z, w0a.w, w0b.x, w0b.y, w0b.z, w0b.w}, {w1a.x, w1a.y, w1a.z, w1a.w, w1b.x, w1b.y, w1b.z, w1b.w}, {w2a.x, w2a.y, w2a.z, w2a.w, w2b.x, w2b.y, w2b.z, w2b.w}};
                float acc[8];
#pragma unroll
                for (int i = 0; i < 8; ++i) acc[i] = 0.f;
#pragma unroll
                for (int d = 0; d < 3; ++d) { const unsigned cw[4] = {cv[d].x, cv[d].y, cv[d].z, cv[d].w}, xw[4] = {xv[d].x, xv[d].y, xv[d].z, xv[d].w};
#pragma unroll
                    for (int i = 0; i < 4; ++i) { acc[2 * i] += wt[d][2 * i] * (bflo(cw[i]) * bflo(xw[i])); acc[2 * i + 1] += wt[d][2 * i + 1] * (bfhi(cw[i]) * bfhi(xw[i])); } }
                const unsigned bw[4] = {bv.x, bv.y, bv.z, bv.w}; u32x4 o;
                o.x = pk2(bflo(bw[0]) * acc[0], bfhi(bw[0]) * acc[1]); o.y = pk2(bflo(bw[1]) * acc[2], bfhi(bw[1]) * acc[3]); o.z = pk2(bflo(bw[2]) * acc[4], bfhi(bw[2]) * acc[5]); o.w = pk2(bflo(bw[3]) * acc[6], bfhi(bw[3]) * acc[7]);
                (void)o; u32x2 o8; o8.x = pg8::cvt4_fp8(bflo(bw[0]) * acc[0], bfhi(bw[0]) * acc[1], bflo(bw[1]) * acc[2], bfhi(bw[1]) * acc[3]); o8.y = pg8::cvt4_fp8(bflo(bw[2]) * acc[4], bfhi(bw[2]) * acc[5], bflo(bw[3]) * acc[6], bfhi(bw[3]) * acc[7]);
                *(u32x2*)((unsigned char*)MIX + (size_t)(t0 + tl) * MIX_W + 512 + c8) = o8; }
        }
        __syncthreads();
#pragma unroll
        for (int q = 0; q < 4; ++q) { const int tok = hw * 4 + q;
            const f32x4 v0 = *(const LAS f32x4*)(dbuf + tok * 256 + l32 * 8), v1 = *(const LAS f32x4*)(dbuf + tok * 256 + l32 * 8 + 4);
            float sm = (v0.x + v0.y + v0.z + v0.w) + (v1.x + v1.y + v1.z + v1.w);
            sm += xor_swz<1>(sm); sm += xor_swz<2>(sm); sm += xor_swz<4>(sm); sm += xor_swz<8>(sm); sm += xor_swz<16>(sm);
            const float mean = sm * (1.f / 256.f);
            const f32x4 d0 = v0 - mean, d1 = v1 - mean;
            float vs = (d0.x * d0.x + d0.y * d0.y + d0.z * d0.z + d0.w * d0.w) + (d1.x * d1.x + d1.y * d1.y + d1.z * d1.z + d1.w * d1.w);
            vs += xor_swz<1>(vs); vs += xor_swz<2>(vs); vs += xor_swz<4>(vs); vs += xor_swz<8>(vs); vs += xor_swz<16>(vs);
            const float rstd = rsqrtf(vs * (1.f / 256.f) + EPS);
            const f32x4 g0 = *(const f32x4*)(clg + l32 * 8), g1 = *(const f32x4*)(clg + l32 * 8 + 4), b0 = *(const f32x4*)(clb + l32 * 8), b1 = *(const f32x4*)(clb + l32 * 8 + 4);
            f32x4 y0 = d0 * rstd * g0 + b0, y1 = d1 * rstd * g1 + b1;
            y0.x *= sigmoidf_(y0.x); y0.y *= sigmoidf_(y0.y); y0.z *= sigmoidf_(y0.z); y0.w *= sigmoidf_(y0.w);
            y1.x *= sigmoidf_(y1.x); y1.y *= sigmoidf_(y1.y); y1.z *= sigmoidf_(y1.z); y1.w *= sigmoidf_(y1.w);
            u32x4 o; o.x = pk2(y0.x, y0.y); o.y = pk2(y0.z, y0.w); o.z = pk2(y1.x, y1.y); o.w = pk2(y1.z, y1.w);
            (void)o; u32x2 o8; o8.x = pg8::cvt4_fp8(y0.x, y0.y, y0.z, y0.w); o8.y = pg8::cvt4_fp8(y1.x, y1.y, y1.z, y1.w);
            *(u32x2*)((unsigned char*)MIX + (size_t)(t0 + tok) * MIX_W + 1024 + l32 * 8) = o8; }
    }
#undef CV_LOAD
    __syncthreads();
}

constexpr int FM_LD = 72;
constexpr int FM_WC = 0, FM_WS = 9216, FM_WSN = 18432, FM_X = 27648, FM_GRE = 36864, FM_GIM = 46080, FM_AT = 27648  , FM_OUT = 55296  , FM_OUT3 = 64512  , FM_TW = FM_OUT3 + 2 * 9216  , FM_END = FM_TW + 1024;
__device__ __forceinline__ void fm_tables(LAS unsigned char* lds, int tid) {
    LAS bf16_t* Wc = (LAS bf16_t*)(lds + FM_WC); LAS bf16_t* Ws = (LAS bf16_t*)(lds + FM_WS); LAS bf16_t* Wsn = (LAS bf16_t*)(lds + FM_WSN);
    for (int i = tid; i < 4096; i += NTHR) { const int r = i >> 6, c = i & 63; float sn, cs; sincos_rev((float)((r * c) & 63) * (1.f / 64.f), sn, cs);
        Wc[r * FM_LD + c] = (bf16_t)f2bf(cs); Ws[r * FM_LD + c] = (bf16_t)f2bf(sn); Wsn[r * FM_LD + c] = (bf16_t)f2bf(-sn); }
    __syncthreads();
}
template <bool BSWZ = false>
__device__ __forceinline__ void fm_mm(f32x16& acc, const LAS bf16_t* A, int ar0, const LAS bf16_t* Bt, int br0, int lane) {
    const int r = lane & 31, h = lane >> 5;
#pragma unroll
    for (int k0 = 0; k0 < 64; k0 += 16) {
        const int kg = (k0 >> 3) + h, kb = BSWZ ? ((kg ^ (((br0 + r) >> 3) & 7)) << 3) : (kg << 3);
        const bf16x8 av = *(const LAS bf16x8*)(A + (ar0 + r) * FM_LD + k0 + 8 * h), bv = *(const LAS bf16x8*)(Bt + (br0 + r) * FM_LD + kb);
        acc = __builtin_amdgcn_mfma_f32_32x32x16_bf16(av, bv, acc, 0, 0, 0); }
}
__device__ __forceinline__ int fm_crow(int reg, int h) { return (reg & 3) + 8 * (reg >> 2) + 4 * h; }
template <bool CTXM>
__device__ __forceinline__ u32x4 fm12_load(int unit, const bf16_t* U, int tid) {
    int b, g, s2;
    if (!CTXM) { b = unit >> 8; g = (unit >> 6) & 3; s2 = unit & 63; } else { b = unit >> 4; g = (unit >> 2) & 3; s2 = unit & 3; }
    const int s1 = tid >> 3, c8 = (tid & 7) * 8;
    const size_t tok = CTXM ? (size_t)NLAT + b * CTXL + (s1 >> 4) * 64 + s2 * 16 + (s1 & 15) : (size_t)b * SEQ + s1 * 64 + s2;
    return *(const u32x4*)(U + tok * IN_W + 1792 + g * 64 + c8);
}
template <bool CTXM>
__device__ __forceinline__ void fm12_unit(int unit, const u32x4 xin, bf16_t* F2, LAS unsigned char* lds, int tid) {
    const LAS bf16_t* Wc = (const LAS bf16_t*)(lds + FM_WC); const LAS bf16_t* Ws = (const LAS bf16_t*)(lds + FM_WS); const LAS bf16_t* Wsn = (const LAS bf16_t*)(lds + FM_WSN);
    LAS bf16_t* X = (LAS bf16_t*)(lds + FM_X); LAS bf16_t* Gre = (LAS bf16_t*)(lds + FM_GRE); LAS bf16_t* Gim = (LAS bf16_t*)(lds + FM_GIM);
    int b, g, s2;
    if (!CTXM) { b = unit >> 8; g = (unit >> 6) & 3; s2 = unit & 63; } else { b = unit >> 4; g = (unit >> 2) & 3; s2 = unit & 3; }
    const int lane = tid & 63, wave = tid >> 6, r = lane & 31, h = lane >> 5, part = wave >> 2, tr = (wave >> 1) & 1, tc = wave & 1;
    { const int s1 = tid >> 3, c8 = (tid & 7) * 8;
        *(LAS u32x4*)(X + s1 * FM_LD + c8) = xin; }
    __syncthreads();
    {
        f32x16 acc = {};
        fm_mm(acc, X, tr * 32, part ? Wsn : Wc, tc * 32, lane);
        LAS bf16_t* GT = part ? Gim : Gre;
#pragma unroll
        for (int q = 0; q < 4; ++q) { u32x2 o; o.x = pk2(acc[4 * q], acc[4 * q + 1]); o.y = pk2(acc[4 * q + 2], acc[4 * q + 3]);
            *(LAS u32x2*)(GT + (tc * 32 + r) * FM_LD + tr * 32 + 8 * q + 4 * h) = o; }
    }
    __syncthreads();
    if constexpr (!CTXM) {
    {
        f32x16 acc = {};
        fm_mm(acc, Wc, tr * 32, part ? Gim : Gre, tc * 32, lane);
        fm_mm(acc, part ? Wsn : Ws, tr * 32, part ? Gre : Gim, tc * 32, lane);
        LAS bf16_t* OUT = (LAS bf16_t*)(lds + FM_OUT) + part * 64 * FM_LD;
#pragma unroll
        for (int reg = 0; reg < 16; ++reg) OUT[(tr * 32 + fm_crow(reg, h)) * FM_LD + tc * 32 + r] = (bf16_t)f2bf(acc[reg]);
    }
    __syncthreads();
#pragma unroll
    for (int i = 0; i < 2; ++i) { const int c = tid + NTHR * i, k1 = c >> 4, pt = (c >> 3) & 1, mch = (c & 7) * 8;
        *(u32x4*)(F2 + ((((size_t)(b * 4 + g) * 64 + k1) * 64 + s2) * 2 + pt) * 64 + mch) = *(const LAS u32x4*)((LAS bf16_t*)(lds + FM_OUT) + (pt * 64 + k1) * FM_LD + mch); }
    } else {
        const int k1 = tid >> 7, s2l = (tid >> 3) & 15, m0 = (tid & 7) * 8;
        float re[8], im[8];
#pragma unroll
        for (int q = 0; q < 8; ++q) { re[q] = 0.f; im[q] = 0.f; }
#pragma unroll
        for (int s1 = 0; s1 < 4; ++s1) { const int idx = (16 * s1 * k1) & 63; const float wr = bf2f(Wc[FM_LD + idx]), wi = bf2f(Ws[FM_LD + idx]);
#pragma unroll
            for (int q = 0; q < 8; ++q) { const float gr = bf2f(Gre[(m0 + q) * FM_LD + s1 * 16 + s2l]), gi = bf2f(Gim[(m0 + q) * FM_LD + s1 * 16 + s2l]); re[q] += wr * gr + wi * gi; im[q] += wr * gi - wi * gr; } }
        bf16_t* dst = F2 + (size_t)NLAT * 512 + ((((size_t)(b * 4 + g) * 4 + k1) * 64 + s2 * 16 + s2l) * 2) * 64 + m0;
        u32x4 o; o.x = pk2(re[0], re[1]); o.y = pk2(re[2], re[3]); o.z = pk2(re[4], re[5]); o.w = pk2(re[6], re[7]); *(u32x4*)dst = o;
        o.x = pk2(im[0], im[1]); o.y = pk2(im[2], im[3]); o.z = pk2(im[4], im[5]); o.w = pk2(im[6], im[7]); *(u32x4*)(dst + 64) = o;
    }
}
struct Fm3In { u32x4 rv[2], iv[2]; };
template <bool CTXM>
__device__ __forceinline__ void fm3_load(Fm3In& f, int unit, const bf16_t* F2, int tid) {
    constexpr int N1 = CTXM ? 4 : 64;
    int b, g, kp;
    if (!CTXM) { b = unit >> 7; g = (unit >> 5) & 3; kp = unit & 31; } else { b = unit >> 3; g = (unit >> 1) & 3; kp = unit & 1; }
    const bf16_t* F2b = F2 + (CTXM ? (size_t)NLAT * 512 : 0);
    const int s2 = tid >> 3, mch = tid & 7;
#pragma unroll
    for (int ki = 0; ki < 2; ++ki) { const bf16_t* img = F2b + (((size_t)(b * 4 + g) * N1 + kp * 2 + ki) * 64) * 128;
        f.rv[ki] = *(const u32x4*)(img + s2 * 128 + mch * 8); f.iv[ki] = *(const u32x4*)(img + s2 * 128 + 64 + mch * 8); }
}
template <bool CTXM>
__device__ __forceinline__ void fm3_unit(int unit, const Fm3In& fin, bf16_t* MIX, LAS unsigned char* lds, int tid) {
    const LAS bf16_t* Wc = (const LAS bf16_t*)(lds + FM_WC); const LAS bf16_t* Ws = (const LAS bf16_t*)(lds + FM_WS);
    LAS bf16_t* AT = (LAS bf16_t*)(lds + FM_AT);
    constexpr int N1 = CTXM ? 4 : 64; constexpr float NRM = CTXM ? (1.f / 128.f) : (1.f / 512.f);
    int b, g, kp;
    if (!CTXM) { b = unit >> 7; g = (unit >> 5) & 3; kp = unit & 31; } else { b = unit >> 3; g = (unit >> 1) & 3; kp = unit & 1; }
    const size_t tok0 = CTXM ? (size_t)NLAT + b * CTXL : (size_t)b * SEQ;
    const int lane = tid & 63, wave = tid >> 6, r = lane & 31, h = lane >> 5;
    LAS f32x2* tw = (LAS f32x2*)(lds + FM_TW);
    if (tid < 128) { const int ki = tid >> 6, s2 = tid & 63; float sn, cs; sincos_rev((float)(s2 * (kp * 2 + ki)) * (1.f / (64.f * N1)), sn, cs); tw[tid] = (f32x2){cs, sn}; }
    __syncthreads();
#pragma unroll
    for (int ki = 0; ki < 2; ++ki) {
        const int s2 = tid >> 3, mch = tid & 7;
        const u32x4 rv = fin.rv[ki], iv = fin.iv[ki];
        const f32x2 t = tw[ki * 64 + s2]; const float cs = t.x, sn = t.y;
        const float re[8] = {bflo(rv.x), bfhi(rv.x), bflo(rv.y), bfhi(rv.y), bflo(rv.z), bfhi(rv.z), bflo(rv.w), bfhi(rv.w)};
        const float im[8] = {bflo(iv.x), bfhi(iv.x), bflo(iv.y), bfhi(iv.y), bflo(iv.z), bfhi(iv.z), bflo(iv.w), bfhi(iv.w)};
        const int col = (((s2 >> 3) ^ mch) << 3) | (s2 & 7);
        LAS bf16_t* are = AT + (ki * 2 + 0) * 64 * FM_LD + (mch * 8) * FM_LD + col; LAS bf16_t* aim = AT + (ki * 2 + 1) * 64 * FM_LD + (mch * 8) * FM_LD + col;
#pragma unroll
        for (int q = 0; q < 8; ++q) { are[q * FM_LD] = (bf16_t)f2bf(re[q] * cs + im[q] * sn); aim[q * FM_LD] = (bf16_t)f2bf(im[q] * cs - re[q] * sn); }
    }
    __syncthreads();
    { const int ki = wave >> 2, tr = (wave >> 1) & 1, tc = wave & 1;
        f32x16 acc = {};
        fm_mm<true>(acc, Wc, tr * 32, AT + (ki * 2 + 0) * 64 * FM_LD, tc * 32, lane);
        fm_mm<true>(acc, Ws, tr * 32, AT + (ki * 2 + 1) * 64 * FM_LD, tc * 32, lane);
        LAS bf16_t* OUT = (LAS bf16_t*)(lds + FM_OUT3) + ki * 64 * FM_LD;
#pragma unroll
        for (int reg = 0; reg < 16; ++reg) OUT[(tr * 32 + fm_crow(reg, h)) * FM_LD + tc * 32 + r] = (bf16_t)f2bf(acc[reg] * NRM);
    }
    __syncthreads();
#pragma unroll
    for (int i = 0; i < 2; ++i) { const int c = tid + NTHR * i, ki = c >> 9, k2 = (c >> 3) & 63, mch = (c & 7) * 8;
        const u32x4 v = *(const LAS u32x4*)((LAS bf16_t*)(lds + FM_OUT3) + (ki * 64 + k2) * FM_LD + mch);
        u32x2 o8; o8.x = pg8::cvt4_fp8(bflo(v.x), bfhi(v.x), bflo(v.y), bfhi(v.y)); o8.y = pg8::cvt4_fp8(bflo(v.z), bfhi(v.z), bflo(v.w), bfhi(v.w));
        *(u32x2*)((unsigned char*)MIX + (tok0 + kp * 2 + ki + N1 * k2) * MIX_W + 768 + g * 64 + mch) = o8; }
    __syncthreads();
}

constexpr int N2_LE = 114688, N2_LP = N2_LE + 640 * 4;
constexpr int N2_SSQ = 0, N2_PART = 1024, N2_LG = N2_PART + 8 * 32 * 33 * 4, N2_HIST = N2_LG + 32 * 33 * 4, N2_TA = 40960, N2_TB = N2_TA + 9 * DM * 4, N2_END = N2_TB + 9 * DM * 4;
static_assert(N2_HIST + 128 <= N2_TA && N2_END <= LDS_FREE, "norm2 LDS");
__device__ __forceinline__ void hilo8(const float (&v)[8], bf16x8& hi, bf16x8& lo) {
    u32x4 H, L;
#pragma unroll
    for (int j = 0; j < 4; ++j) { const unsigned hw = pk2(v[2 * j], v[2 * j + 1]); H[j] = hw; L[j] = pk2(v[2 * j] - bflo(hw), v[2 * j + 1] - bfhi(hw)); }
    hi = __builtin_bit_cast(bf16x8, H); lo = __builtin_bit_cast(bf16x8, L);
}
__device__ __forceinline__ void n2_tables(int l, const Args& a, LAS unsigned char* lds, int t, int nt) {
    const float* mods_l = (const float*)(a.ws + WS_MODS) + (size_t)l * 9 * NMOD; const float* gain = a.in[I_NFFN] + l * DM;
    LAS float* TA = (LAS float*)(lds + N2_TA); LAS float* TB = (LAS float*)(lds + N2_TB); LAS int* hist = (LAS int*)(lds + N2_HIST);
    if (t < NE) hist[t] = 0;
    for (int i = t; i < 9 * DM; i += nt) { const int rr = i >> 10, k = i & 1023; TA[i] = gain[k] * (1.f + mods_l[(size_t)rr * NMOD + 4 * DM + k]); TB[i] = mods_l[(size_t)rr * NMOD + 3 * DM + k]; }
}
template <bool PRE>
__device__ __forceinline__ void ph_norm2(int l, int ntok, const Args& a, LAS unsigned char* lds, int wg, int tid) {
    const int lane = tid & 63, wave = tid >> 6, r = lane & 31, h = lane >> 5;
    unsigned char* ws = a.ws;
    const bf16_t* XA = (const bf16_t*)(ws + WS_XA); unsigned char* H8 = (unsigned char*)(ws + WS_H8);
    const float* mods_l = (const float*)(ws + WS_MODS) + (size_t)l * 9 * NMOD;
    const float* gain = a.in[I_NFFN] + l * DM; const float* rw = a.in[I_RW] + (size_t)l * DM * NE; const float* rb = a.in[I_RB] + l * NE;
    int* tok_e = (int*)(ws + WS_TOKE); float* tok_p = (float*)(ws + WS_TOKP); int* counts = (int*)(ws + WS_CNT);
    LAS float* ssq = (LAS float*)(lds + N2_SSQ); LAS float* part = (LAS float*)(lds + N2_PART); LAS float* lg = (LAS float*)(lds + N2_LG); LAS int* hist = (LAS int*)(lds + N2_HIST);
    LAS float* TA = (LAS float*)(lds + N2_TA); LAS float* TB = (LAS float*)(lds + N2_TB);
    if (!PRE) n2_tables(l, a, lds, tid, NTHR);
    bf16x8 Bhi[8], Blo[8];
#pragma unroll
    for (int s = 0; s < 8; ++s) { float v[8];
#pragma unroll
        for (int j = 0; j < 8; ++j) v[j] = rw[(size_t)(128 * wave + 16 * s + 8 * h + j) * NE + r];
        hilo8(v, Bhi[s], Blo[s]); }
    __syncthreads();
    const int ntile = ntok / 32;
    u32x4 xraw[8];
    if (wg < ntile) { const bf16_t* xr0 = XA + (size_t)(wg * 32 + r) * DM + 128 * wave + 8 * h;
#pragma unroll
        for (int s = 0; s < 8; ++s) xraw[s] = *(const u32x4*)(xr0 + 16 * s); }
    for (int tile = wg; tile < ntile; tile += NWG) {
        const int t = tile * 32 + r;
        f32x4 xv[8][2]; float ss = 0.f;
#pragma unroll
        for (int s = 0; s < 8; ++s) { xv[s][0] = (f32x4){bflo(xraw[s].x), bfhi(xraw[s].x), bflo(xraw[s].y), bfhi(xraw[s].y)}; xv[s][1] = (f32x4){bflo(xraw[s].z), bfhi(xraw[s].z), bflo(xraw[s].w), bfhi(xraw[s].w)}; }
        if (tile + NWG < ntile) { const bf16_t* xrn = XA + (size_t)((tile + NWG) * 32 + r) * DM + 128 * wave + 8 * h;
#pragma unroll
            for (int s = 0; s < 8; ++s) xraw[s] = *(const u32x4*)(xrn + 16 * s); }
#pragma unroll
        for (int s = 0; s < 8; ++s) ss += (xv[s][0].x * xv[s][0].x + xv[s][0].y * xv[s][0].y + xv[s][0].z * xv[s][0].z + xv[s][0].w * xv[s][0].w) + (xv[s][1].x * xv[s][1].x + xv[s][1].y * xv[s][1].y + xv[s][1].z * xv[s][1].z + xv[s][1].w * xv[s][1].w);
        { auto rr = __builtin_amdgcn_permlane32_swap(__float_as_uint(ss), __float_as_uint(ss), false, false); ss = __uint_as_float(rr[0]) + __uint_as_float(rr[1]); }
        if (h == 0) ssq[wave * 32 + r] = ss;
        __syncthreads();
        float tot = 0.f;
#pragma unroll
        for (int w = 0; w < 8; ++w) tot += ssq[w * 32 + r];
        const float rstd = rsqrtf(tot * (1.f / DM) + EPS);
        f32x16 acc = {};
        const LAS float* ta = TA + tok_bidx(tile * 32) * DM + 128 * wave + 8 * h; const LAS float* tb = TB + tok_bidx(tile * 32) * DM + 128 * wave + 8 * h;
#pragma unroll
        for (int s = 0; s < 8; ++s) {
            const f32x4 y0 = (xv[s][0] * rstd) * *(const LAS f32x4*)(ta + 16 * s) + *(const LAS f32x4*)(tb + 16 * s), y1 = (xv[s][1] * rstd) * *(const LAS f32x4*)(ta + 16 * s + 4) + *(const LAS f32x4*)(tb + 16 * s + 4);
            const float v[8] = {y0.x, y0.y, y0.z, y0.w, y1.x, y1.y, y1.z, y1.w};
            u32x2 o8; o8.x = pg8::cvt4_fp8(v[0], v[1], v[2], v[3]); o8.y = pg8::cvt4_fp8(v[4], v[5], v[6], v[7]);
            *(u32x2*)(H8 + (size_t)t * DM + 128 * wave + 16 * s + 8 * h) = o8;
            bf16x8 ahi, alo; hilo8(v, ahi, alo);
            acc = __builtin_amdgcn_mfma_f32_32x32x16_bf16(ahi, Bhi[s], acc, 0, 0, 0);
            acc = __builtin_amdgcn_mfma_f32_32x32x16_bf16(alo, Bhi[s], acc, 0, 0, 0);
            acc = __builtin_amdgcn_mfma_f32_32x32x16_bf16(ahi, Blo[s], acc, 0, 0, 0); }
#pragma unroll
        for (int reg = 0; reg < 16; ++reg) part[(wave * 32 + fm_crow(reg, h)) * 33 + r] = acc[reg];
        __syncthreads();
#pragma unroll
        for (int q = 0; q < 2; ++q) { const int idx = tid + NTHR * q, tk = idx >> 5, e = idx & 31; float sm = rb[e];
#pragma unroll
            for (int w = 0; w < 8; ++w) sm += part[(w * 32 + tk) * 33 + e];
            lg[tk * 33 + e] = sm; }
        __syncthreads();
#pragma unroll
        for (int q = 0; q < 2; ++q) { const int tk = wave * 4 + q * 2 + h;
            float v = lg[tk * 33 + r]; float bv[4]; int be[4];
#pragma unroll
            for (int j = 0; j < 4; ++j) { float m = v;
                m = fmaxf(m, xor_swz<1>(m)); m = fmaxf(m, xor_swz<2>(m)); m = fmaxf(m, xor_swz<4>(m)); m = fmaxf(m, xor_swz<8>(m)); m = fmaxf(m, xor_swz<16>(m));
                const unsigned long long bal = __ballot(v == m); const unsigned mine = (unsigned)(bal >> (32 * h));
                const int idx = __builtin_ctz(mine);
                bv[j] = m; be[j] = idx; if (r == idx) v = -3.0e38f; }
            if (r == 0) { const float e1 = __expf(bv[1] - bv[0]), e2 = __expf(bv[2] - bv[0]), e3 = __expf(bv[3] - bv[0]); const float inv = __builtin_amdgcn_rcpf(1.f + e1 + e2 + e3);
                const int tt = tile * 32 + tk;
#if !MK_ONE_LAUNCH
                *(int4*)(tok_e + (size_t)tt * 4) = make_int4(be[0], be[1], be[2], be[3]);
                *(float4*)(tok_p + (size_t)tt * 4) = make_float4(inv, e1 * inv, e2 * inv, e3 * inv);
#else
                (void)tt; (void)tok_e; (void)tok_p;
#endif
                { const int li = (((tile - wg) / NWG) * 32 + tk) * 4; LAS int* le = (LAS int*)(lds + N2_LE); LAS float* lp = (LAS float*)(lds + N2_LP);
                    le[li] = be[0]; le[li + 1] = be[1]; le[li + 2] = be[2]; le[li + 3] = be[3]; lp[li] = inv; lp[li + 1] = e1 * inv; lp[li + 2] = e2 * inv; lp[li + 3] = e3 * inv; }
#pragma unroll
                for (int j = 0; j < 4; ++j) atomicAdd((int*)&hist[be[j]], 1); } }
    }
    __syncthreads();
#if MK_ONE_LAUNCH
    { unsigned* total = (unsigned*)(ws + WS_CTL + WS_TOTAL) + l * NE;
        if (tid < NE) hist[tid] = (int)__hip_atomic_fetch_add(&total[tid], (unsigned)hist[tid], __ATOMIC_RELAXED, __HIP_MEMORY_SCOPE_AGENT);
        __syncthreads();
        if (wave == 0) { const LAS int* le = (const LAS int*)(lds + N2_LE); const LAS float* lp = (const LAS float*)(lds + N2_LP);
            int* tokpos = (int*)(ws + WS_TOKPOS); int* rowtokv = (int*)(ws + WS_ROWTOKV); float* rowwv = (float*)(ws + WS_ROWWV);
            const int nas = ((ntile - wg + NWG - 1) / NWG) * 128;
            for (int ch = 0; ch < nas; ch += 64) { const int aidx = ch + lane; const bool valid = aidx < nas;
                const int e = valid ? le[aidx] : -1;
                unsigned long long m = __ballot(valid);
#pragma unroll
                for (int b = 0; b < 5; ++b) { const bool bit = (e >> b) & 1; const unsigned long long bb = __ballot(bit); m &= bit ? bb : ~bb; }
                const int rank = (int)__builtin_amdgcn_mbcnt_hi((unsigned)(m >> 32), __builtin_amdgcn_mbcnt_lo((unsigned)m, 0u));
                const int rs = hist[valid ? e : 0];
                if (valid && rank == 0) hist[e] = rs + __popcll(m);
                if (valid) { const int tokn = (wg + NWG * (aidx >> 7)) * 32 + ((aidx >> 2) & 31); const int v = (e << CAPV_LOG) | (rs + rank);
                    tokpos[(size_t)tokn * 4 + (aidx & 3)] = v; rowwv[v] = lp[aidx]; rowtokv[v] = tokn; } } } }
#else
    if (tid < NE) counts[wg * NE + tid] = hist[tid];
#endif
}

constexpr int RT_PSUM = 0, RT_PPRE = 2048, RT_TOT = 4096, RT_BASE = 4224, RT_OFF = 4352, RT_POS = 4608;
__device__ __forceinline__ void ph_route(int ntok, const Args& a, LAS unsigned char* lds, int wg, int tid) {
    const int lane = tid & 63, wave = tid >> 6;
    unsigned char* ws = a.ws;
    const int* counts = (const int*)(ws + WS_CNT); int* eoff = (int*)(ws + WS_EOFF);
    const int* tok_e = (const int*)(ws + WS_TOKE); const float* tok_p = (const float*)(ws + WS_TOKP); int* tokpos = (int*)(ws + WS_TOKPOS); float* roww = (float*)(ws + WS_ROWW);
    int* rowtok = (int*)(ws + WS_ROWTOK);
    LAS int* psum = (LAS int*)(lds + RT_PSUM); LAS int* ppre = (LAS int*)(lds + RT_PPRE); LAS int* tot = (LAS int*)(lds + RT_TOT); LAS int* base = (LAS int*)(lds + RT_BASE); LAS int* off = (LAS int*)(lds + RT_OFF); LAS int* posb = (LAS int*)(lds + RT_POS);
    { const int e = tid & 31, part = tid >> 5; int s = 0, pre = 0;
        for (int w = part * 16; w < part * 16 + 16; ++w) { const int c = counts[w * NE + e]; if (w < wg) pre += c; s += c; }
        psum[part * 32 + e] = s; ppre[part * 32 + e] = pre; }
    __syncthreads();
    if (tid < NE) { int s = 0, pre = 0;
        for (int p = 0; p < 16; ++p) { s += psum[p * 32 + tid]; pre += ppre[p * 32 + tid]; }
        tot[tid] = s; base[tid] = pre; }
    __syncthreads();
    if (tid == 0) { int o = 0; for (int e = 0; e < NE; ++e) { off[e] = o; o += (tot[e] + 255) & ~255; } off[NE] = o; }
    __syncthreads();
    if (wg == 0 && tid <= NE) eoff[tid] = off[tid];
    { LAS int* tab = (LAS int*)(lds + LDS_TAB); const int nMt_ = off[NE] >> 8;
        for (int i = tid; i < nMt_; i += NTHR) { const int row = i << 8; int e = 0;
            for (int q = 1; q < NE; ++q) if (off[q] <= row) e = q;
            tab[i] = e; }
        if (tid == 0) tab[LDS_TAB_NMT] = nMt_; }
    const int ntile = ntok / 32, ntw = (ntile - wg + NWG - 1) / NWG, nas = ntw * 128;
#define RT_TOK(ai) ((wg + NWG * ((ai) >> 7)) * 32 + (((ai) >> 2) & 31))
    if (wave == 0) {
        constexpr int MAXCH = 10; static_assert((NTOK / 32 + NWG - 1) / NWG * 128 <= MAXCH * 64, "route chunks");
        if (lane < NE) posb[lane] = off[lane] + base[lane];
        int ev[MAXCH]; float pw[MAXCH];
#pragma unroll
        for (int k = 0; k < MAXCH; ++k) { const int aidx = 64 * k + lane; const bool valid = aidx < nas; const size_t gi = valid ? (size_t)RT_TOK(aidx) * 4 + (aidx & 3) : 0;
            ev[k] = valid ? tok_e[gi] : -1; pw[k] = valid ? tok_p[gi] : 0.f; }
#pragma unroll
        for (int k = 0; k < MAXCH; ++k) if (64 * k < nas) {
            const int e = ev[k], aidx = 64 * k + lane; const bool valid = e >= 0;
            unsigned long long m = __ballot(valid);
#pragma unroll
            for (int b = 0; b < 5; ++b) { const bool bit = (e >> b) & 1; const unsigned long long bb = __ballot(bit); m &= bit ? bb : ~bb; }
            const int rank = (int)__builtin_amdgcn_mbcnt_hi((unsigned)(m >> 32), __builtin_amdgcn_mbcnt_lo((unsigned)m, 0u));
            const int rs = posb[valid ? e : 0];
            if (valid && rank == 0) posb[e] = rs + __popcll(m);
            if (valid) { const size_t gi = (size_t)RT_TOK(aidx) * 4 + (aidx & 3); const int pos = rs + rank; tokpos[gi] = pos; roww[pos] = pw[k]; rowtok[pos] = RT_TOK(aidx); } }
    }
    if (wg < NE) { const int p0 = off[wg] + tot[wg], p1 = off[wg + 1]; for (int p = p0 + tid; p < p1; p += NTHR) rowtok[p] = 0; }
#undef RT_TOK
}
__device__ __forceinline__ int moe_tiles(const unsigned char* ws, LAS unsigned char* lds, int tid) {
    const int* eoff = (const int*)(ws + WS_EOFF); LAS int* tab = (LAS int*)(lds + LDS_TAB);
    const int total = eoff[NE];
    const int nMt = total >> 8;
    for (int i = tid; i < nMt; i += NTHR) { const int row = i << 8; int e = 0;
        for (int q = 1; q < NE; ++q) if (eoff[q] <= row) e = q;
        tab[i] = e; }
    __syncthreads();
    return __builtin_amdgcn_readfirstlane(nMt);
}

__device__ __forceinline__ f32x4 fp8x4_to_f32(unsigned w) {
    const f32x2 lo = __builtin_amdgcn_cvt_pk_f32_fp8((int)w, false), hi = __builtin_amdgcn_cvt_pk_f32_fp8((int)w, true);
    return (f32x4){lo.x, lo.y, hi.x, hi.y};
}
constexpr int CB_G2 = 0, CB_SH = 9 * DM * 4, CB_SC = 2 * 9 * DM * 4, CB_GN = 3 * 9 * DM * 4, CB_END = CB_GN + DM * 4;
static_assert(CB_END <= LDS_FREE, "combine LDS");
__device__ __forceinline__ void fp8x16_acc(f32x4 (&acc)[4], const u32x4 y) {
    const unsigned w[4] = {y.x, y.y, y.z, y.w};
#pragma unroll
    for (int i = 0; i < 4; ++i) { const f32x2 lo = __builtin_amdgcn_cvt_pk_f32_fp8((int)w[i], false), hi = __builtin_amdgcn_cvt_pk_f32_fp8((int)w[i], true); acc[i] += (f32x4){lo.x, lo.y, hi.x, hi.y}; }
}
__device__ __forceinline__ void cb_tables(int l, const Args& a, LAS unsigned char* lds, int t, int nt) {
    const float* mods_l = (const float*)(a.ws + WS_MODS) + (size_t)l * 9 * NMOD; const bool more = l < DEPTH - 1;
    LAS float* Lg2 = (LAS float*)(lds + CB_G2); LAS float* Lsh = (LAS float*)(lds + CB_SH); LAS float* Lsc = (LAS float*)(lds + CB_SC); LAS float* Lgn = (LAS float*)(lds + CB_GN);
    for (int i = t; i < 9 * DM; i += nt) { const int r = i >> 10, k = i & 1023;
        Lg2[i] = mods_l[(size_t)r * NMOD + 5 * DM + k] * YR_INV;
        if (more) { Lsh[i] = mods_l[(size_t)(9 + r) * NMOD + k]; Lsc[i] = mods_l[(size_t)(9 + r) * NMOD + DM + k] + 1.f; } }
    for (int i = t; i < DM; i += nt) Lgn[i] = more ? a.in[I_NMIX][(l + 1) * DM + i] : a.in[I_FN][i];
}
template <bool PRE>
__device__ __forceinline__ void ph_combine(int l, int ntok, const Args& a, LAS unsigned char* lds, int gw, int NGW, int tid) {
    const int lane = tid & 63;
    unsigned char* ws = a.ws;
    const bf16_t* XA = (const bf16_t*)(ws + WS_XA); bf16_t* XB = (bf16_t*)(ws + WS_XB); const unsigned char* YR = (const unsigned char*)(ws + WS_YR);
    const int* tokpos = (const int*)(ws + WS_TOKPOS);
    const float* mods_l = (const float*)(ws + WS_MODS) + (size_t)l * 9 * NMOD;
    const bool more = l < DEPTH - 1;
    LAS float* Lg2 = (LAS float*)(lds + CB_G2); LAS float* Lsh = (LAS float*)(lds + CB_SH); LAS float* Lsc = (LAS float*)(lds + CB_SC); LAS float* Lgn = (LAS float*)(lds + CB_GN);
    if (!PRE) cb_tables(l, a, lds, tid, NTHR);
    __syncthreads();
    bf16_t* HA = (bf16_t*)(ws + WS_HA); unsigned char* HA8 = ws + WS_HA8;
    const int k0 = 16 * lane;
    for (int t0 = gw * 2; t0 < ntok; t0 += NGW * 2) {
        u32x4 y[2][4], xr[2][2];
#pragma unroll
        for (int r = 0; r < 2; ++r) { const int t = t0 + r; int4 pp = *(const int4*)(tokpos + (size_t)t * 4);
#if MK_ONE_LAUNCH
            { const LAS int* tf = (const LAS int*)(lds + LDS_TAB) + LDS_TAB_TF;
                pp.x = tf[pp.x >> CAPV_LOG] * 256 + (pp.x & ((1 << CAPV_LOG) - 1)); pp.y = tf[pp.y >> CAPV_LOG] * 256 + (pp.y & ((1 << CAPV_LOG) - 1));
                pp.z = tf[pp.z >> CAPV_LOG] * 256 + (pp.z & ((1 << CAPV_LOG) - 1)); pp.w = tf[pp.w >> CAPV_LOG] * 256 + (pp.w & ((1 << CAPV_LOG) - 1)); }
#endif
            y[r][0] = *(const u32x4*)(YR + (size_t)pp.x * DM + k0); y[r][1] = *(const u32x4*)(YR + (size_t)pp.y * DM + k0);
            y[r][2] = *(const u32x4*)(YR + (size_t)pp.z * DM + k0); y[r][3] = *(const u32x4*)(YR + (size_t)pp.w * DM + k0);
            xr[r][0] = *(const u32x4*)(XA + (size_t)t * DM + k0); xr[r][1] = *(const u32x4*)(XA + (size_t)t * DM + k0 + 8); }
#pragma unroll
        for (int r = 0; r < 2; ++r) { const int t = t0 + r, bi = tok_bidx(t);
            int kt = k0; asm volatile("" : "+v"(kt));
            f32x4 ff[4] = {{0.f, 0.f, 0.f, 0.f}, {0.f, 0.f, 0.f, 0.f}, {0.f, 0.f, 0.f, 0.f}, {0.f, 0.f, 0.f, 0.f}};
            fp8x16_acc(ff, y[r][0]); fp8x16_acc(ff, y[r][1]); fp8x16_acc(ff, y[r][2]); fp8x16_acc(ff, y[r][3]);
            const unsigned xw[8] = {xr[r][0].x, xr[r][0].y, xr[r][0].z, xr[r][0].w, xr[r][1].x, xr[r][1].y, xr[r][1].z, xr[r][1].w};
            f32x4 v[4]; float ss = 0.f;
#pragma unroll
            for (int j = 0; j < 4; ++j) { const f32x4 xv = {bflo(xw[2 * j]), bfhi(xw[2 * j]), bflo(xw[2 * j + 1]), bfhi(xw[2 * j + 1])};
                v[j] = xv + *(const LAS f32x4*)(Lg2 + bi * DM + kt + 4 * j) * ff[j];
                ss += v[j].x * v[j].x + v[j].y * v[j].y + v[j].z * v[j].z + v[j].w * v[j].w; }
            const float rstd = rsqrtf(wave_sum(ss) * (1.f / DM) + EPS);
            if (more) {
                u32x4 xo[2], ho[2]; unsigned h8[4];
#pragma unroll
                for (int j = 0; j < 4; ++j) { const f32x4 y2 = (v[j] * rstd * *(const LAS f32x4*)(Lgn + kt + 4 * j)) * *(const LAS f32x4*)(Lsc + bi * DM + kt + 4 * j) + *(const LAS f32x4*)(Lsh + bi * DM + kt + 4 * j);
                    xo[j >> 1][(j & 1) * 2] = pk2(v[j].x, v[j].y); xo[j >> 1][(j & 1) * 2 + 1] = pk2(v[j].z, v[j].w);
                    ho[j >> 1][(j & 1) * 2] = pk2(y2.x, y2.y); ho[j >> 1][(j & 1) * 2 + 1] = pk2(y2.z, y2.w); h8[j] = pg8::cvt4_fp8(y2.x, y2.y, y2.z, y2.w); }
                *(u32x4*)(XB + (size_t)t * DM + k0) = xo[0]; *(u32x4*)(XB + (size_t)t * DM + k0 + 8) = xo[1];
                *(u32x4*)(HA + (size_t)t * DM + k0) = ho[0]; *(u32x4*)(HA + (size_t)t * DM + k0 + 8) = ho[1];
                *(u32x4*)(HA8 + (size_t)t * DM + k0) = (u32x4){h8[0], h8[1], h8[2], h8[3]};
            } else {
#pragma unroll
                for (int j = 0; j < 4; ++j) *(f32x4*)(a.out + (size_t)t * DM + k0 + 4 * j) = v[j] * rstd * *(const LAS f32x4*)(Lgn + kt + 4 * j);
            } }
    }
    __syncthreads();
}

constexpr int PH_PER_LAYER = 10, N_PHASES = 1 + DEPTH * PH_PER_LAYER;
#if MK_ONE_LAUNCH
#define GRID_BAR() do { XcdBarrier b_ = bar; asm volatile("" : "+s"(b_.bar), "+s"(b_.x)); xcd_barrier(b_, [](int, int) {}); } while (0)
#define GRID_BAR_W(...) do { XcdBarrier b_ = bar; asm volatile("" : "+s"(b_.bar), "+s"(b_.x)); xcd_barrier(b_, [&](int t_, int nt_) { __VA_ARGS__; }); } while (0)
#define GRID_BAR_P(k) do { if constexpr (p0_slot(k) >= 0) GRID_BAR_W((void)nt_; p0_slot_items(load_args(), lds, wg, p0_slot(k), t_)); else GRID_BAR(); } while (0)
#else
#define GRID_BAR() do {} while (0)
#define GRID_BAR_W(...) do {} while (0)
#define GRID_BAR_P(k) do {} while (0)
#endif
#define IN(k) (lo <= (k) && (k) < hi)
#define BOTH(k) (IN(k) && IN((k) + 1))
#define REPEAT(R) _Pragma("unroll") for (int rp_ = 0; rp_ < (R); ++rp_)
#define GWAVE() (wg * NWAVES + wv)
#define ptid() ptid_w(wv)
template <int LAYER>
__device__ __forceinline__ void layer_phases(LAS unsigned char* lds, unsigned char* lds_raw, const XcdBarrier& bar, int lo, int hi, int wg, int G, int wv) {
        constexpr int l = LAYER, pb = 1 + PH_PER_LAYER * l;
        constexpr bool last = (l == DEPTH - 1);
        constexpr int ntok_l = last ? NLAT : NTOK;

        if (IN(pb + 0) && l == 0) { REPEAT(REP_NORM1) { const Args a = load_args();
                const float* xlat = (l == 0) ? a.in[I_X] : (const float*)(a.ws + WS_XB);
                const float* xctx = (l == 0) ? a.in[I_CTX] : (const float*)(a.ws + WS_XB) + (size_t)NLAT * DM;
                ph_norm1(xlat, xctx, a.in[I_NMIX] + l * DM, (const float*)(a.ws + WS_MODS) + (size_t)l * 9 * NMOD, (bf16_t*)(a.ws + WS_HA), a.ws + WS_HA8, GWAVE(), G * NWAVES, ptid() & 63); }
            if (BOTH(pb + 0)) GRID_BAR_P(pb + 0); }

        if (IN(pb + 1)) {
            const Args a = load_args();
            REPEAT(REP_GEMM) {
            { pg8::Gemm g{a.ws + WS_HA8, a.ws + WS_WIN8 + (size_t)l * IN_W * DM, DM};
                constexpr int G8 = last ? 256 : 208;
                pg8::SchedSub<4> S; S.G = (G == 256) ? G8 : G; S.c = wg; S.first = 0; S.cfirst = last ? 2 : 0; S.nctx = last ? 2 : 4; S.rev = false;
                pg8::EpiStoreBf16 E{(bf16_t*)(a.ws + WS_U), IN_W, W8_INV};
                if (wg < S.G) pg8::gemm_phase<true>(lds, g, S, E, ptid()); }
            { pg8::Gemm g{a.ws + WS_HA, (const bf16_t*)(a.ws + WS_WIN) + (size_t)l * IN_W * DM, DM * 2};
                pg8::SchedSub<6> S; S.G = G; S.c = wg; S.first = 4; S.cfirst = 4; S.nctx = last ? 0 : 6; S.rev = true;
                pg8::EpiStoreBf16 E{(bf16_t*)(a.ws + WS_U), IN_W, 1.f};
                pg8::gemm_phase<false>(lds, g, S, E, ptid()); }
            }
            if (BOTH(pb + 1)) GRID_BAR_P(pb + 1);
        }

        if (IN(pb + 2)) REPEAT(REP_PREP) {
            const Args a = load_args();
            ph_qkv(l, a, lds, wg, ptid());
            ph_conv_tiles(l, a, lds, wg, ptid());
            const bf16_t* U = (const bf16_t*)(a.ws + WS_U); bf16_t* F2 = (bf16_t*)(a.ws + WS_F2);
            fm_tables(lds, ptid());
            if (!last && wg >= 128) { const int t_ = ptid(); fm12_unit<true>(wg - 128, fm12_load<true>(wg - 128, U, t_), F2, lds, t_); }
            { const int t_ = ptid(); u32x4 xcur = {0u, 0u, 0u, 0u}; if (wg < 2048) xcur = fm12_load<false>(wg, U, t_);
                for (int u = wg; u < 2048; u += G) { u32x4 xn = {0u, 0u, 0u, 0u}; if (u + G < 2048) xn = fm12_load<false>(u + G, U, t_);
                    fm12_unit<false>(u, xcur, F2, lds, t_); xcur = xn; } }
            __syncthreads();
            if (rp_ + 1 == REP_PREP && BOTH(pb + 2)) GRID_BAR_P(pb + 2);
        }

        if (IN(pb + 3)) REPEAT(REP_ATTN) {
            const Args a = load_args();
            const unsigned char* QB = a.ws + WS_QB; const unsigned char* KB = a.ws + WS_KB; const unsigned char* VT = a.ws + WS_VB; bf16_t* MIX = (bf16_t*)(a.ws + WS_MIX);
            const int x = wg & 7, rk = wg >> 3;
            const int nun = (!last && wg < 32) ? 3 : 2;
            for (int i = 0; i < nun; ++i) {
                int b, h, kvh, seq; size_t trow;
                if (i < 2) { const int set = i * 8 + x; b = set >> 1; kvh = set & 1; h = kvh * 2 + (rk >> 4); trow = (size_t)b * SEQ + (rk & 15) * 256; seq = SKV; }
                else { b = wg >> 2; h = wg & 3; kvh = h >> 1; trow = (size_t)NLAT + b * CTXL; seq = CTXL; }
                att8::attn_body<512, MIX_W>(QB + trow * 512 + h * 128, KB + (size_t)(b * 2 + kvh) * SKV * 128, VT + (size_t)(b * 2 + kvh) * SKV * 128, (unsigned char*)MIX + trow * MIX_W + h * 128, seq, (char*)lds_raw, ptid()); }
            const bf16_t* F2 = (const bf16_t*)(a.ws + WS_F2);
            fm_tables(lds, ptid());
            if (!last && wg >= 192) { const int t_ = ptid(); Fm3In fc; fm3_load<true>(fc, wg - 192, F2, t_); fm3_unit<true>(wg - 192, fc, MIX, lds, t_); }
            { const int t_ = ptid(); Fm3In fa, fb; if (wg < 1024) fm3_load<false>(fa, wg, F2, t_);
                for (int u = wg; u < 1024; u += 2 * G) {
                    if (u + G < 1024) fm3_load<false>(fb, u + G, F2, t_);
                    fm3_unit<false>(u, fa, MIX, lds, t_);
                    if (u + G < 1024) { if (u + 2 * G < 1024) fm3_load<false>(fa, u + 2 * G, F2, t_); fm3_unit<false>(u + G, fb, MIX, lds, t_); } } }
            if (rp_ + 1 == REP_ATTN && BOTH(pb + 3)) GRID_BAR_P(pb + 3);
        }

        if (IN(pb + 4)) {
            const Args a = load_args();
            pg8::Gemm g0{a.ws + WS_MIX, a.ws + WS_WOUT + (size_t)l * DM * MIX_W, MIX_W};
            pg8::SchedGrid<4> S; S.G = G; S.c = wg; S.nM = ntok_l / 256;
            const float* gate = (const float*)(a.ws + WS_MODS) + (size_t)l * 9 * NMOD + 2 * DM;
            if (l == 0) { pg8::EpiResidual<false> E{a.in[I_X], a.in[I_CTX], (bf16_t*)(a.ws + WS_XA), gate, W8_INV};
                REPEAT(REP_GEMM) pg8::gemm_phase<true>(lds, g0, S, E, ptid());
                if (G == NWG && wg >= 32) { const int t_ = ptid(); p0_items(a, lds, (wg - 32) * NWAVES + (t_ >> 6), (NWG - 32) * NWAVES, P0_ITEMS - P0_DEFER, P0_ITEMS, t_); __syncthreads(); }
                else if (G != NWG) { const int t_ = ptid(); p0_items(a, lds, wg * NWAVES + (t_ >> 6), G * NWAVES, P0_ITEMS - P0_DEFER, P0_ITEMS, t_); __syncthreads(); } }
            else { pg8::EpiResidual<true> E{a.ws + WS_XB, a.ws + WS_XB + (size_t)NLAT * DM * 2, (bf16_t*)(a.ws + WS_XA), gate, W8_INV};
                REPEAT(REP_GEMM) pg8::gemm_phase<true>(lds, g0, S, E, ptid()); }
            if (BOTH(pb + 4)) GRID_BAR_W(n2_tables(l, load_args(), lds, t_, nt_));
        }

        if (IN(pb + 5)) { REPEAT(REP_N2) { const Args a = load_args(); ph_norm2<MK_ONE_LAUNCH != 0>(l, ntok_l, a, lds, wg, ptid()); __syncthreads(); } if (BOTH(pb + 5)) GRID_BAR_P(pb + 5); }
#if !MK_ONE_LAUNCH
        if (IN(pb + 6)) { REPEAT(REP_ROUTE) { const Args a = load_args(); ph_route(ntok_l, a, lds, wg, ptid()); __syncthreads(); } if (BOTH(pb + 6)) GRID_BAR_P(pb + 6); }
#endif

        if (IN(pb + 7)) {
            const Args a = load_args();
#if MK_ONE_LAUNCH
            { LAS int* tab = (LAS int*)(lds + LDS_TAB); const unsigned* total = (const unsigned*)(a.ws + WS_CTL + WS_TOTAL) + l * NE; const int t_ = ptid();
                if (t_ < NE) tab[LDS_TAB_TOT + t_] = (int)total[t_];
                __syncthreads();
                if (t_ == 0) { int o = 0; for (int e = 0; e < NE; ++e) { tab[LDS_TAB_TF + e] = o; o += (tab[LDS_TAB_TOT + e] + 255) >> 8; } tab[LDS_TAB_NMT] = o; }
                __syncthreads();
                const int n_ = tab[LDS_TAB_NMT];
                for (int i = t_; i < n_; i += NTHR) { int e = 0; for (int q = 1; q < NE; ++q) if (tab[LDS_TAB_TF + q] <= i) e = q; tab[i] = e; }
                __syncthreads(); }
            const int nMt = __builtin_amdgcn_readfirstlane(((const LAS int*)(lds + LDS_TAB))[LDS_TAB_NMT]);
            { const int* rowtokv = (const int*)(a.ws + WS_ROWTOKV); LAS int* ltok = (LAS int*)(lds + LDS_LTOK); const LAS int* tab = (const LAS int*)(lds + LDS_TAB); const int t_ = ptid();
                const int nun = (nMt * 8 - wg + G - 1) / G;
                for (int idx = t_; idx < nun * 256; idx += NTHR) { int pm, pn; pg8::tile_order<8>((idx >> 8) * G + wg, nMt, pm, pn);
                    const int e = tab[pm], vp = (pm - tab[LDS_TAB_TF + e]) * 256 + (idx & 255);
                    ltok[idx] = vp < tab[LDS_TAB_TOT + e] ? rowtokv[((size_t)e << CAPV_LOG) + vp] : 0; }
                __syncthreads(); }
#else
            const int nMt = moe_tiles(a.ws, lds, ptid());
            { const int* rowtok = (const int*)(a.ws + WS_ROWTOK); LAS int* ltok = (LAS int*)(lds + LDS_LTOK); const int t_ = ptid();
                const int nun = (nMt * 8 - wg + G - 1) / G;
                for (int idx = t_; idx < nun * 256; idx += NTHR) { int pm, pn; pg8::tile_order<8>((idx >> 8) * G + wg, nMt, pm, pn); ltok[idx] = rowtok[pm * 256 + (idx & 255)]; }
                __syncthreads(); }
#endif
            pg8::Gemm g{a.ws + WS_H8, a.ws + WS_WUP + (size_t)l * NE * 2048 * DM, DM};
            pg8::SchedMoe<8, true> S{G, wg, nMt, (const LAS int*)(lds + LDS_TAB), (const LAS int*)(lds + LDS_LTOK)};
            pg8::EpiSwiGLU E{(unsigned char*)(a.ws + WS_ACT), a.in[I_BUP] + (size_t)l * NE * 2048};
            REPEAT(REP_MOE) pg8::gemm_phase<true>(lds, g, S, E, ptid());
            if (BOTH(pb + 7)) GRID_BAR_P(pb + 7);
        }
        if (IN(pb + 8)) {
            const Args a = load_args();
#if MK_ONE_LAUNCH
            const int nMt = __builtin_amdgcn_readfirstlane(((const LAS int*)(lds + LDS_TAB))[LDS_TAB_NMT]);
#else
            const int nMt = moe_tiles(a.ws, lds, ptid());
#endif
            pg8::Gemm g{a.ws + WS_ACT, a.ws + WS_WDN + (size_t)l * NE * DM * DFF, DFF};
            pg8::SchedMoe<4, false> S{G, wg, nMt, (const LAS int*)(lds + LDS_TAB), nullptr};
#if MK_ONE_LAUNCH
            pg8::EpiDown E{(unsigned char*)(a.ws + WS_YR), a.in[I_BDN] + (size_t)l * NE * DM, (const float*)(a.ws + WS_ROWWV), (const LAS int*)(lds + LDS_TAB) + LDS_TAB_TF};
#else
            pg8::EpiDown E{(unsigned char*)(a.ws + WS_YR), a.in[I_BDN] + (size_t)l * NE * DM, (const float*)(a.ws + WS_ROWW), nullptr};
#endif
            REPEAT(REP_MOE) pg8::gemm_phase<true>(lds, g, S, E, ptid());
            if (BOTH(pb + 8)) GRID_BAR_W(cb_tables(l, load_args(), lds, t_, nt_));
        }
        if (IN(pb + 9)) { REPEAT(REP_COMB) { const Args a = load_args(); ph_combine<MK_ONE_LAUNCH != 0>(l, ntok_l, a, lds, GWAVE(), G * NWAVES, ptid()); } if (BOTH(pb + 9)) GRID_BAR_P(pb + 9); }
}

__global__ void __launch_bounds__(NTHR, 2) mk_fwd(Args a_kernarg) {
    extern __shared__ __attribute__((aligned(16))) unsigned char lds_raw[];
    LAS unsigned char* lds = (LAS unsigned char*)lds_raw;
    const int wg = blockIdx.x, G = gridDim.x, wv = __builtin_amdgcn_readfirstlane(threadIdx.x >> 6);
    volatile LAS unsigned* lctl = (volatile LAS unsigned*)(lds + LDS_CTL);
    if (threadIdx.x < 64) lctl[threadIdx.x] = 0u;
    __syncthreads();
#if MK_ONE_LAUNCH
    XcdBarrier bar = xcd_barrier_post((unsigned*)(a_kernarg.ws + WS_CTL) + 4096, lctl);
#else
    XcdBarrier bar; bar.bar = nullptr; bar.x = 0; bar.st = nullptr;
#endif
    const int lo = a_kernarg.ph_lo, hi = a_kernarg.ph_hi;
    if (IN(0)) { REPEAT(REP_P0) { const Args a = load_args(); p0_prologue(a, lds, wg, ptid()); __syncthreads(); } if (BOTH(0)) GRID_BAR_P(0); }

    layer_phases<0>(lds, lds_raw, bar, lo, hi, wg, G, wv);
    layer_phases<1>(lds, lds_raw, bar, lo, hi, wg, G, wv);
}

extern "C" void kernel_launch(void* const* d_in, const int* in_sizes, int n_in, void* d_out, int out_size, void* d_ws, size_t ws_size, hipStream_t stream) {
    static int ok = 0;
    if (ok == 0) {
        if (n_in != 24 || in_sizes[0] != NLAT * DM || out_size != NLAT * DM || ws_size < WS_END) {
            fprintf(stderr, "kernel_launch: shape mismatch (n_in %d, in0 %d, out %d, ws %zu; need ws >= %zu)\n", n_in, n_in > 0 ? in_sizes[0] : -1, out_size, ws_size, (size_t)WS_END); ok = -1; return; }
        if (hipFuncSetAttribute((const void*)mk_fwd, hipFuncAttributeMaxDynamicSharedMemorySize, LDS_BYTES) != hipSuccess) { fprintf(stderr, "kernel_launch: hipFuncSetAttribute failed\n"); ok = -1; return; }
        int per_cu = 0;
        if (hipOccupancyMaxActiveBlocksPerMultiprocessor(&per_cu, (const void*)mk_fwd, NTHR, LDS_BYTES) != hipSuccess || per_cu < 1)
            fprintf(stderr, "kernel_launch: note: occupancy query reports %d workgroups per CU\n", per_cu);
        (void)hipGetLastError();
        ok = 1;
    }
    if (ok < 0) return;
    if (hipMemsetAsync((char*)d_ws + WS_CTL, 0, CTL_ZERO_BYTES, stream) != hipSuccess) { fprintf(stderr, "kernel_launch: memset failed\n"); return; }
    Args a{};
    for (int i = 0; i < 24; ++i) a.in[i] = (const float*)d_in[i];
    a.out = (float*)d_out; a.ws = (unsigned char*)d_ws;
#if MK_ONE_LAUNCH
    a.ph_lo = 0; a.ph_hi = N_PHASES;
    hipLaunchKernelGGL(mk_fwd, dim3(NWG), dim3(NTHR), LDS_BYTES, stream, a);
#else
    for (int p = 0; p < N_PHASES; ++p) { a.ph_lo = p; a.ph_hi = p + 1; hipLaunchKernelGGL(mk_fwd, dim3(NWG), dim3(NTHR), LDS_BYTES, stream, a); }
#endif
    const hipError_t le = hipPeekAtLastError();
    if (le != hipSuccess) fprintf(stderr, "kernel_launch: launch failed: %s\n", hipGetErrorName(le));
}
```
